# Optimizing an MI355X kernel written in HIP

```python
import jax, jax.numpy as jnp
from jax import lax
import numpy as np

D_MODEL = 2048
BATCH = 4
SEQ = 8192
DEPTH = 1

GRID_W = 64
Q_BLOCK = 128
ROPE_THETA = 10000.0
EPS = 1e-6

A_HEADS = 8
A_KV_HEADS = 2
A_HEAD_DIM = 128
A_GROUP = A_HEADS // A_KV_HEADS
A_WIDTH = A_HEADS * A_HEAD_DIM
B_HEADS = 8
B_QK_DIM = 64
B_V_DIM = 2 * B_QK_DIM
B_WIDTH = B_HEADS * B_V_DIM
A_Q_COLS = A_HEADS * A_HEAD_DIM
A_KV_COLS = A_KV_HEADS * A_HEAD_DIM
B_QK_COLS = B_HEADS * 2 * B_QK_DIM
B_V_COLS = B_HEADS * B_V_DIM
IN_COLS = A_Q_COLS + 2 * A_KV_COLS + 2 * B_QK_COLS + B_V_COLS
N_BRANCHES = 2
N_GROUPS = 4
EXPERTS_PER_GROUP = 8
N_EXPERTS = N_GROUPS * EXPERTS_PER_GROUP
TOP_K = 2
EXPERT_FF = D_MODEL // 4
MOE_BLOCK = 128

kernel_name = "hybrid_gated_axialgqa_diffattn_hmoe"


def rmsnorm(x, g):
    xf = x.astype(jnp.float32)
    xf = xf * lax.rsqrt(jnp.mean(xf * xf, axis=-1, keepdims=True) + EPS)
    return xf.astype(x.dtype) * g


def rope_angles(pos, dim):
    inv = ROPE_THETA ** (-jnp.arange(0, dim, 2, dtype=jnp.float32) / dim)
    ang = pos.astype(jnp.float32)[:, None] * inv[None, :]
    return jnp.cos(ang), jnp.sin(ang)


def apply_rope(x, cos, sin):
    half = x.shape[-1] // 2
    xf = x.astype(jnp.float32)
    x1, x2 = xf[..., :half], xf[..., half:]
    out = jnp.concatenate([x1 * cos - x2 * sin, x2 * cos + x1 * sin], axis=-1)
    return out.astype(x.dtype)


def axial_gqa(q, k, v, q_g, k_g, rows, cols):
    q = rmsnorm(q, q_g)
    k = rmsnorm(k, k_g)
    half = A_HEAD_DIM // 2
    cr, sr = rope_angles(rows, half)
    cc, sc = rope_angles(cols, half)
    bc = lambda t: t[None, :, None, :]

    def axial(t):
        return jnp.concatenate([apply_rope(t[..., :half], bc(cr), bc(sr)),
                                apply_rope(t[..., half:], bc(cc), bc(sc))], axis=-1)

    q, k = axial(q), axial(k)
    b, s = q.shape[0], q.shape[1]
    nb = s // Q_BLOCK
    qb = q.reshape(b, nb, Q_BLOCK, A_KV_HEADS, A_GROUP, A_HEAD_DIM).transpose(1, 0, 2, 3, 4, 5)
    scale = A_HEAD_DIM ** -0.5

    def block(qi):
        sc_ = jnp.einsum('bqkgd,bskd->bkgqs', qi, k, preferred_element_type=jnp.float32) * scale
        p = jax.nn.softmax(sc_, axis=-1).astype(v.dtype)
        return jnp.einsum('bkgqs,bskd->bqkgd', p, v)

    o = lax.map(block, qb)
    return o.transpose(1, 0, 2, 3, 4, 5).reshape(b, s, A_WIDTH)


def diff_attention(q, k, v, lam, lam_init, subln_g, pos):
    c, s_ = rope_angles(pos, B_QK_DIM)
    bc = lambda t: t[None, :, None, None, :]
    q = apply_rope(q, bc(c), bc(s_))
    k = apply_rope(k, bc(c), bc(s_))
    b, s = q.shape[0], q.shape[1]
    nb = s // Q_BLOCK
    qb = q.reshape(b, nb, Q_BLOCK, B_HEADS, 2, B_QK_DIM).transpose(1, 0, 2, 3, 4, 5)
    scale = B_QK_DIM ** -0.5

    def block(qi):
        sc_ = jnp.einsum('bqhcd,bshcd->bhcqs', qi, k, preferred_element_type=jnp.float32) * scale
        p = jax.nn.softmax(sc_, axis=-1)
        a = (p[:, :, 0] - lam * p[:, :, 1]).astype(v.dtype)
        return jnp.einsum('bhqs,bshe->bqhe', a, v)

    o = lax.map(block, qb)
    o = o.transpose(1, 0, 2, 3, 4).reshape(b, s, B_HEADS, B_V_DIM)
    o = rmsnorm(o, subln_g) * (1.0 - lam_init)
    return o.reshape(b, s, B_WIDTH)


def hier_moe(h, w_rg, w_re, w1, w3, w2):
    b, s, d = h.shape
    t = b * s
    hf = h.reshape(t, d)
    g_logits = jnp.matmul(hf, w_rg).astype(jnp.float32)
    g_prob = jax.nn.softmax(g_logits, axis=-1)
    g_idx = jnp.argmax(g_logits, axis=-1).astype(jnp.int32)
    g_w = jnp.take_along_axis(g_prob, g_idx[:, None], axis=-1)
    e_logits = jnp.matmul(hf, w_re).astype(jnp.float32).reshape(t, N_GROUPS, EXPERTS_PER_GROUP)
    e_in_group = jnp.take_along_axis(e_logits, g_idx[:, None, None], axis=1)[:, 0]
    top_v, top_i = lax.top_k(e_in_group, TOP_K)
    e_w = jax.nn.softmax(top_v, axis=-1) * g_w
    expert = g_idx[:, None] * EXPERTS_PER_GROUP + top_i.astype(jnp.int32)

    n_assign = t * TOP_K
    e_flat = expert.reshape(n_assign)
    tok_flat = jnp.repeat(jnp.arange(t, dtype=jnp.int32), TOP_K)
    w_flat = e_w.reshape(n_assign)
    order = jnp.argsort(e_flat)
    e_sorted, tok_sorted, w_sorted = e_flat[order], tok_flat[order], w_flat[order]
    counts = jnp.bincount(e_flat, length=N_EXPERTS).astype(jnp.int32)
    offsets = jnp.cumsum(counts) - counts
    padded = ((counts + MOE_BLOCK - 1) // MOE_BLOCK) * MOE_BLOCK
    padded_ends = jnp.cumsum(padded)
    padded_offsets = padded_ends - padded
    rank = jnp.arange(n_assign, dtype=jnp.int32) - offsets[e_sorted]
    pos = padded_offsets[e_sorted] + rank
    n_blocks = -(-n_assign // MOE_BLOCK) + N_EXPERTS
    p_len = n_blocks * MOE_BLOCK
    buf_tok = jnp.full((p_len,), t, jnp.int32).at[pos].set(tok_sorted)
    buf_w = jnp.zeros((p_len,), jnp.float32).at[pos].set(w_sorted)
    block_start = jnp.arange(n_blocks, dtype=jnp.int32) * MOE_BLOCK
    block_expert = jnp.clip(jnp.searchsorted(padded_ends, block_start, side='right'),
                            0, N_EXPERTS - 1).astype(jnp.int32)
    x_pad = jnp.concatenate([hf, jnp.zeros((1, d), hf.dtype)], axis=0)

    def run(args):
        tok, wt, e = args
        xb = x_pad[tok]
        u = jax.nn.silu(xb @ w1[e]) * (xb @ w3[e])
        return (u @ w2[e]) * wt[:, None].astype(hf.dtype)

    out = lax.map(run, (buf_tok.reshape(n_blocks, MOE_BLOCK),
                        buf_w.reshape(n_blocks, MOE_BLOCK), block_expert))
    y = jnp.zeros((t + 1, d), hf.dtype).at[buf_tok].add(out.reshape(p_len, d))
    return y[:t].reshape(b, s, d)


def setup_inputs(seed: int = 0) -> dict:
    key = jax.random.key(seed)
    ks = jax.random.split(key, 24)
    f32 = jnp.float32
    nrm = lambda k, shape, scale: jax.random.normal(k, shape, f32) * scale
    gain = lambda k, shape: 1.0 + 0.01 * jax.random.normal(k, shape, f32)
    L, D = DEPTH, D_MODEL
    return {
        "x": jax.random.normal(ks[0], (BATCH, SEQ, D), f32),
        "g_mix": gain(ks[1], (L, D)),
        "w_in": nrm(ks[2], (L, D, IN_COLS), D ** -0.5),
        "q_norm_a": gain(ks[3], (L, A_HEAD_DIM)),
        "k_norm_a": gain(ks[4], (L, A_HEAD_DIM)),
        "lam_q1": nrm(ks[5], (L, B_QK_DIM), 0.1),
        "lam_k1": nrm(ks[6], (L, B_QK_DIM), 0.1),
        "lam_q2": nrm(ks[7], (L, B_QK_DIM), 0.1),
        "lam_k2": nrm(ks[8], (L, B_QK_DIM), 0.1),
        "subln_b": gain(ks[9], (L, B_V_DIM)),
        "w_branch_a": nrm(ks[10], (L, A_WIDTH, D), A_WIDTH ** -0.5),
        "w_branch_b": nrm(ks[11], (L, B_WIDTH, D), B_WIDTH ** -0.5),
        "w_gate": nrm(ks[12], (L, D, N_BRANCHES * D), D ** -0.5),
        "b_gate": nrm(ks[13], (L, N_BRANCHES * D), 0.01),
        "w_out": nrm(ks[14], (L, D, D), D ** -0.5),
        "g_ffn": gain(ks[15], (L, D)),
        "w_router_group": nrm(ks[16], (L, D, N_GROUPS), D ** -0.5),
        "w_router_expert": nrm(ks[17], (L, D, N_EXPERTS), D ** -0.5),
        "w_e_gate": nrm(ks[18], (L, N_EXPERTS, D, EXPERT_FF), D ** -0.5),
        "w_e_up": nrm(ks[19], (L, N_EXPERTS, D, EXPERT_FF), D ** -0.5),
        "w_e_down": nrm(ks[20], (L, N_EXPERTS, EXPERT_FF, D), EXPERT_FF ** -0.5),
        "g_final": gain(ks[21], (D,)),
    }


def reference(x, g_mix, w_in, q_norm_a, k_norm_a, lam_q1, lam_k1, lam_q2, lam_k2, subln_b,
              w_branch_a, w_branch_b, w_gate, b_gate, w_out, g_ffn, w_router_group,
              w_router_expert, w_e_gate, w_e_up, w_e_down, g_final):
    b, s, _ = x.shape
    ROWS = s // GRID_W
    pos = jnp.arange(s, dtype=jnp.int32)
    rows = jnp.repeat(jnp.arange(ROWS, dtype=jnp.int32), GRID_W)
    cols = jnp.tile(jnp.arange(GRID_W, dtype=jnp.int32), ROWS)
    split_at = [A_Q_COLS, A_Q_COLS + A_KV_COLS, A_Q_COLS + 2 * A_KV_COLS,
                A_Q_COLS + 2 * A_KV_COLS + B_QK_COLS, A_Q_COLS + 2 * A_KV_COLS + 2 * B_QK_COLS]
    for l in range(DEPTH):
        lam_init = 0.8 - 0.6 * float(np.exp(-0.3 * l))
        h = rmsnorm(x, g_mix[l])
        proj = h @ w_in[l]
        qa, ka, va, qb, kb, vb = jnp.split(proj, split_at, axis=-1)
        qa = qa.reshape(b, s, A_HEADS, A_HEAD_DIM)
        ka = ka.reshape(b, s, A_KV_HEADS, A_HEAD_DIM)
        va = va.reshape(b, s, A_KV_HEADS, A_HEAD_DIM)
        qb = qb.reshape(b, s, B_HEADS, 2, B_QK_DIM)
        kb = kb.reshape(b, s, B_HEADS, 2, B_QK_DIM)
        vb = vb.reshape(b, s, B_HEADS, B_V_DIM)
        o_a = axial_gqa(qa, ka, va, q_norm_a[l], k_norm_a[l], rows, cols)
        lam = (jnp.exp(jnp.sum(lam_q1[l].astype(jnp.float32) * lam_k1[l].astype(jnp.float32)))
               - jnp.exp(jnp.sum(lam_q2[l].astype(jnp.float32) * lam_k2[l].astype(jnp.float32)))
               + lam_init)
        o_b = diff_attention(qb, kb, vb, lam, lam_init, subln_b[l], pos)
        gates = jax.nn.sigmoid((h @ w_gate[l] + b_gate[l]).astype(jnp.float32)).astype(x.dtype)
        g_a, g_b = jnp.split(gates, N_BRANCHES, axis=-1)
        merged = g_a * (o_a @ w_branch_a[l]) + g_b * (o_b @ w_branch_b[l])
        x = x + merged @ w_out[l]
        x = x + hier_moe(rmsnorm(x, g_ffn[l]), w_router_group[l], w_router_expert[l],
                         w_e_gate[l], w_e_up[l], w_e_down[l])
    return rmsnorm(x, g_final)
```

```cpp
#include <hip/hip_runtime.h>
#include <cstdio>
#include <cstdint>
#include <cmath>

namespace pg8 {
#define PG8_LAS __attribute__((address_space(3)))
typedef unsigned short bf16_t;
typedef short bf16x8 __attribute__((ext_vector_type(8)));
typedef float f32x4 __attribute__((ext_vector_type(4)));
typedef unsigned u32x4 __attribute__((ext_vector_type(4)));
constexpr int BM = 256, BK = 64, HALF = 128, HTB = HALF * BK * 2  , STAGE_BYTES = 8 * HTB, NXCD = 8, WGM = 8;

__host__ __device__ __forceinline__ int lds_byte(int r, int c) { const int st = (r >> 4) * 2 + (c >> 5), rr = r & 15, cc = c & 31, ob = rr * 64 + cc * 2; return st * 1024 + (ob ^ (((ob >> 9) & 1) << 5)); }
__host__ __device__ __forceinline__ void stage_rc(int b, int& R, int& C) { const int st = b / 1024, sb = b % 1024, swz = sb ^ (((sb >> 9) & 1) << 5); R = (st >> 1) * 16 + swz / 64; C = (st & 1) * 32 + (swz % 64) / 2; }
__host__ __device__ __forceinline__ int perm32(int rho) { const int n = rho >> 4, i = rho & 15; return 8 * (i >> 2) + 4 * n + (i & 3); }

struct Unit { int pm, pn; long bofs; };
struct Gemm { const bf16_t* A; const bf16_t* Bt; int M, N, K; };

struct StaticOrder {
    int nM, nN, nwg, G, c;
    __host__ __device__ void init(int M, int N, int G_, int c_) { nM = M / BM; nN = N / BM; nwg = nM * nN; G = G_; c = c_; }
    __host__ __device__ bool next(int i, Unit& u) const {
        const long L = (long)i * G + c; if (L >= nwg) return false;
        int wgid = (int)L; { const int q = nwg / NXCD, r = nwg % NXCD, xcd = wgid % NXCD, off = wgid / NXCD; wgid = (xcd < r ? xcd * (q + 1) : r * (q + 1) + (xcd - r) * q) + off; }
        const int nig = WGM * nN, gid = wgid / nig, fm = gid * WGM, gsz = (nM - fm) < WGM ? (nM - fm) : WGM;
        u.pm = fm + ((wgid % nig) % gsz); u.pn = (wgid % nig) / gsz; u.bofs = 0; return true;
    }
    __device__ __forceinline__ void a_ready(const Unit&) const {}
    __device__ __forceinline__ void done(const Unit&) const {}
};

__device__ __forceinline__ unsigned cvt_pk_bf16(float lo, float hi) { unsigned r; asm volatile("v_cvt_pk_bf16_f32 %0, %1, %2" : "=v"(r) : "v"(lo), "v"(hi)); return r; }
typedef float f32x2 __attribute__((ext_vector_type(2)));

__device__ __forceinline__ float bf_lo(unsigned w) { return __uint_as_float(w << 16); }
__device__ __forceinline__ float bf_hi(unsigned w) { return __uint_as_float(w & 0xffff0000u); }
__device__ __forceinline__ float sigmoid_f(float x) { return __builtin_amdgcn_rcpf(1.0f + __builtin_amdgcn_exp2f(-1.4426950408889634f * x)); }

struct EpiP1 {
    static constexpr bool PERM = true, AFTER_DRAIN = false;
    bf16_t *QA, *KA, *VA, *QB, *KB, *VB, *GT; const float* bgate;
    __device__ __forceinline__ void operator()(const f32x4 (&acc)[2][2][4][2], const Unit& u, int wr, int wc, int fr, int fq) const {
        const int pn = u.pn; bf16_t* base; int ld, colt; bool gate = false;
        if (pn < 4)       { base = QA; ld = 1024; colt = pn * 256; }
        else if (pn == 4) { base = KA; ld = 256;  colt = 0; }
        else if (pn == 5) { base = VA; ld = 256;  colt = 0; }
        else if (pn < 10) { base = QB; ld = 1024; colt = (pn - 6) * 256; }
        else if (pn < 14) { base = KB; ld = 1024; colt = (pn - 10) * 256; }
        else if (pn < 18) { base = VB; ld = 1024; colt = (pn - 14) * 256; }
        else              { base = GT; ld = 4096; colt = (pn - 18) * 256; gate = true; }
        const int row0 = u.pm * BM + wr * 64 + fr, col0 = colt + wc * 32 + 8 * fq;
        f32x4 bv[2][2];
#pragma unroll
        for (int bj = 0; bj < 2; ++bj)
#pragma unroll
            for (int n = 0; n < 2; ++n) bv[bj][n] = gate ? *(const f32x4*)(bgate + col0 + bj * HALF + 4 * n) : (f32x4){0.f, 0.f, 0.f, 0.f};
#pragma unroll
        for (int ai = 0; ai < 2; ++ai)
#pragma unroll
            for (int m = 0; m < 4; ++m) { bf16_t* rowp = base + (size_t)(row0 + ai * HALF + m * 16) * ld + col0;
#pragma unroll
                for (int bj = 0; bj < 2; ++bj) { f32x4 v0 = acc[ai][bj][m][0] + bv[bj][0], v1 = acc[ai][bj][m][1] + bv[bj][1];
                    if (gate) {
#pragma unroll
                        for (int e = 0; e < 4; ++e) { v0[e] = sigmoid_f(v0[e]); v1[e] = sigmoid_f(v1[e]); } }
                    u32x4 w; w.x = cvt_pk_bf16(v0[0], v0[1]); w.y = cvt_pk_bf16(v0[2], v0[3]); w.z = cvt_pk_bf16(v1[0], v1[1]); w.w = cvt_pk_bf16(v1[2], v1[3]);
                    *(u32x4*)(rowp + bj * HALF) = w; } }
    }
};

struct EpiGateA {
    static constexpr bool PERM = true, AFTER_DRAIN = false;
    const bf16_t* GT; float* MA;
    __device__ __forceinline__ void operator()(const f32x4 (&acc)[2][2][4][2], const Unit& u, int wr, int wc, int fr, int fq) const {
        const int row0 = u.pm * BM + wr * 64 + fr, col0 = u.pn * BM + wc * 32 + 8 * fq;
#pragma unroll
        for (int ai = 0; ai < 2; ++ai)
#pragma unroll
            for (int m = 0; m < 4; ++m) { const size_t r = (size_t)(row0 + ai * HALF + m * 16);
#pragma unroll
                for (int bj = 0; bj < 2; ++bj) { const u32x4 g = *(const u32x4*)(GT + r * 4096 + col0 + bj * HALF);
                    f32x4 v0 = acc[ai][bj][m][0], v1 = acc[ai][bj][m][1];
                    v0[0] *= bf_lo(g.x); v0[1] *= bf_hi(g.x); v0[2] *= bf_lo(g.y); v0[3] *= bf_hi(g.y);
                    v1[0] *= bf_lo(g.z); v1[1] *= bf_hi(g.z); v1[2] *= bf_lo(g.w); v1[3] *= bf_hi(g.w);
                    float* o = MA + r * 2048 + col0 + bj * HALF; *(f32x4*)o = v0; *(f32x4*)(o + 4) = v1; }
                if (m & 1) asm volatile("" ::: "memory"); }
    }
};
struct EpiGateB {
    static constexpr bool PERM = true, AFTER_DRAIN = false;
    const bf16_t* GT; const float* MA; bf16_t* MG;
    __device__ __forceinline__ void operator()(const f32x4 (&acc)[2][2][4][2], const Unit& u, int wr, int wc, int fr, int fq) const {
        const int row0 = u.pm * BM + wr * 64 + fr, col0 = u.pn * BM + wc * 32 + 8 * fq;
#pragma unroll
        for (int ai = 0; ai < 2; ++ai)
#pragma unroll
            for (int m = 0; m < 4; ++m) { const size_t r = (size_t)(row0 + ai * HALF + m * 16);
#pragma unroll
                for (int bj = 0; bj < 2; ++bj) { const u32x4 g = *(const u32x4*)(GT + r * 4096 + 2048 + col0 + bj * HALF);
                    const float* mp = MA + r * 2048 + col0 + bj * HALF; const f32x4 a0 = *(const f32x4*)mp, a1 = *(const f32x4*)(mp + 4);
                    f32x4 v0 = acc[ai][bj][m][0], v1 = acc[ai][bj][m][1];
                    v0[0] = a0[0] + v0[0] * bf_lo(g.x); v0[1] = a0[1] + v0[1] * bf_hi(g.x); v0[2] = a0[2] + v0[2] * bf_lo(g.y); v0[3] = a0[3] + v0[3] * bf_hi(g.y);
                    v1[0] = a1[0] + v1[0] * bf_lo(g.z); v1[1] = a1[1] + v1[1] * bf_hi(g.z); v1[2] = a1[2] + v1[2] * bf_lo(g.w); v1[3] = a1[3] + v1[3] * bf_hi(g.w);
                    u32x4 w; w.x = cvt_pk_bf16(v0[0], v0[1]); w.y = cvt_pk_bf16(v0[2], v0[3]); w.z = cvt_pk_bf16(v1[0], v1[1]); w.w = cvt_pk_bf16(v1[2], v1[3]);
                    *(u32x4*)(MG + r * 2048 + col0 + bj * HALF) = w; }
                if (m & 1) asm volatile("" ::: "memory"); }
    }
};
struct EpiOut {
    static constexpr bool PERM = false, AFTER_DRAIN = false;
    const float* X; float* X1; float* SSQ;
    __device__ __forceinline__ void operator()(const f32x4 (&acc)[2][2][4][2], const Unit& u, int wr, int wc, int fr, int fq) const {
        const int row0 = u.pm * BM + wr * 64 + fr, col0 = u.pn * BM + wc * 32 + 4 * fq;
#pragma unroll
        for (int ai = 0; ai < 2; ++ai)
#pragma unroll
            for (int m = 0; m < 4; ++m) { const size_t r = (size_t)(row0 + ai * HALF + m * 16); float s = 0.f;
#pragma unroll
                for (int bj = 0; bj < 2; ++bj)
#pragma unroll
                    for (int n = 0; n < 2; ++n) { const size_t off = r * 2048 + col0 + bj * HALF + n * 16;
                        const f32x4 v = *(const f32x4*)(X + off) + acc[ai][bj][m][n]; *(f32x4*)(X1 + off) = v;
                        s += (v[0] * v[0] + v[1] * v[1]) + (v[2] * v[2] + v[3] * v[3]); }
                s += __shfl_xor(s, 16); s += __shfl_xor(s, 32);
                if (fq == 0) SSQ[r * 32 + u.pn * 4 + wc] = s;
                if (m & 1) asm volatile("" ::: "memory"); }
    }
};
struct EpiG1 {
    static constexpr bool PERM = true, AFTER_DRAIN = false;
    bf16_t* U;
    __device__ __forceinline__ void operator()(const f32x4 (&acc)[2][2][4][2], const Unit& u, int wr, int wc, int fr, int fq) const {
        const int row0 = u.pm * BM + wr * 64 + fr, col0 = u.pn * HALF + wc * 32 + 8 * fq;
#pragma unroll
        for (int ai = 0; ai < 2; ++ai)
#pragma unroll
            for (int m = 0; m < 4; ++m) { f32x4 v0, v1;
#pragma unroll
                for (int e = 0; e < 4; ++e) { const float g0 = acc[ai][0][m][0][e], g1 = acc[ai][0][m][1][e];
                    v0[e] = g0 * sigmoid_f(g0) * acc[ai][1][m][0][e]; v1[e] = g1 * sigmoid_f(g1) * acc[ai][1][m][1][e]; }
                u32x4 w; w.x = cvt_pk_bf16(v0[0], v0[1]); w.y = cvt_pk_bf16(v0[2], v0[3]); w.z = cvt_pk_bf16(v1[0], v1[1]); w.w = cvt_pk_bf16(v1[2], v1[3]);
                *(u32x4*)(U + (size_t)(row0 + ai * HALF + m * 16) * 512 + col0) = w; }
    }
};
struct EpiG2 {
    static constexpr bool PERM = true, AFTER_DRAIN = false;
    bf16_t* YC; const float* ROWW;
    __device__ __forceinline__ void operator()(const f32x4 (&acc)[2][2][4][2], const Unit& u, int wr, int wc, int fr, int fq) const {
        const int row0 = u.pm * BM + wr * 64 + fr, col0 = u.pn * BM + wc * 32 + 8 * fq;
#pragma unroll
        for (int ai = 0; ai < 2; ++ai)
#pragma unroll
            for (int m = 0; m < 4; ++m) { const size_t r = (size_t)(row0 + ai * HALF + m * 16); const float wt = ROWW[r];
#pragma unroll
                for (int bj = 0; bj < 2; ++bj) { const f32x4 v0 = acc[ai][bj][m][0] * wt, v1 = acc[ai][bj][m][1] * wt;
                    u32x4 w; w.x = cvt_pk_bf16(v0[0], v0[1]); w.y = cvt_pk_bf16(v0[2], v0[3]); w.z = cvt_pk_bf16(v1[0], v1[1]); w.w = cvt_pk_bf16(v1[2], v1[3]);
                    *(u32x4*)(YC + r * 2048 + col0 + bj * HALF) = w; } }
    }
};
template <int NT, long BSTRIDE  > struct MoeOrder {
    const PG8_LAS int* tab; int G, c;
    __device__ __forceinline__ bool next(int i, Unit& u) const {
        const int P = tab[64]; const long L = (long)i * G + c; if (L >= (long)P * NT) return false;
        const int p = (int)(L / NT); int e = 0;
#pragma unroll 1
        for (int k = 1; k < 32; ++k) if (tab[32 + k] <= p) e = k;
        u.pm = p; u.pn = (int)(L % NT); u.bofs = (long)e * BSTRIDE; return true;
    }
    __device__ __forceinline__ void a_ready(const Unit&) const {}
    __device__ __forceinline__ void done(const Unit&) const {}
};

template <class Epi, class Sched, bool ALIGN_EPI = false, bool SP2 = false>
__device__ __forceinline__ void gemm_phase(PG8_LAS unsigned char* lds, const Gemm g, const Sched& S, const Epi& E) {
    const int tid = threadIdx.x, wid = __builtin_amdgcn_readfirstlane(tid >> 6), lane = tid & 63, wr = wid >> 2, wc = wid & 3, fr = lane & 15, fq = lane >> 4;
    const int K = g.K, nt = K / BK;
    unsigned voffA[2], voffB[2];
#pragma unroll
    for (int i = 0; i < 2; ++i) { int R, C; stage_rc(tid * 16 + i * 8192, R, C); const int Rb = Epi::PERM ? ((R & ~31) + perm32(R & 31)) : R;
        voffA[i] = (unsigned)(R * K + C) * 2u; voffB[i] = (unsigned)(Rb * K + C) * 2u; }
    const size_t kstep = (size_t)(BK * 2);
    const size_t hstep = (size_t)HALF * K * 2;
    const size_t tstep = 2 * hstep;
    const unsigned ldsw = (unsigned)wid * 1024u;
    const int aoff = lds_byte(wr * 64 + fr, fq * 8), boff = lds_byte(wc * 32 + fr, fq * 8);
#define PG8_SA(b, h) (((b) * 2 + (h)) * HTB)
#define PG8_SB(b, h) ((4 + (b) * 2 + (h)) * HTB)
#define PG8_STAGE(bufoff, gbase, voff) do { _Pragma("unroll") for (int _i = 0; _i < 2; ++_i) \
        __builtin_amdgcn_global_load_lds((const unsigned*)((const char*)(gbase) + (voff)[_i]), (PG8_LAS unsigned*)(lds + (bufoff) + ldsw + _i * 8192), 16, 0, 0); } while (0)
#define PG8_LDA(dst, b, h) do { _Pragma("unroll") for (int m = 0; m < 4; ++m) _Pragma("unroll") for (int k = 0; k < 2; ++k) dst[m][k] = *(const PG8_LAS bf16x8*)(lds + PG8_SA(b, h) + aoff + m * 2048 + k * 1024); } while (0)
#define PG8_LDB(dst, b, h) do { _Pragma("unroll") for (int n = 0; n < 2; ++n) _Pragma("unroll") for (int k = 0; k < 2; ++k) dst[n][k] = *(const PG8_LAS bf16x8*)(lds + PG8_SB(b, h) + boff + n * 2048 + k * 1024); } while (0)
#define PG8_MMA(ai, bj, At, Bt) do { __builtin_amdgcn_s_setprio(1); _Pragma("unroll") for (int m = 0; m < 4; ++m) _Pragma("unroll") for (int n = 0; n < 2; ++n) _Pragma("unroll") for (int k = 0; k < 2; ++k) \
        acc[ai][bj][m][n] = __builtin_amdgcn_mfma_f32_16x16x32_bf16(Bt[n][k], At[m][k], acc[ai][bj][m][n], 0, 0, 0); __builtin_amdgcn_s_setprio(0); } while (0)
#define PG8_WAIT_V(n) asm volatile("s_waitcnt vmcnt(" #n ")" ::: "memory")
#define PG8_WAIT_L(n) asm volatile("s_waitcnt lgkmcnt(" #n ")" ::: "memory")
#define PG8_BAR __builtin_amdgcn_s_barrier()
#define PG8_SCHED __builtin_amdgcn_sched_barrier(0)
    Unit cur, nxt; int ui = 0;
    if (!S.next(0, cur)) return;
    f32x4 acc[2][2][4][2];
#pragma unroll
    for (int a = 0; a < 2; ++a)
#pragma unroll
        for (int b = 0; b < 2; ++b)
#pragma unroll
            for (int m = 0; m < 4; ++m)
#pragma unroll
                for (int n = 0; n < 2; ++n) acc[a][b][m][n] = (f32x4){0.f, 0.f, 0.f, 0.f};
    bf16x8 At[4][2], B0[2][2], B1[2][2];
    const char* cA = (const char*)g.A + (size_t)cur.pm * tstep; const char* cB = (const char*)g.Bt + (size_t)cur.pn * tstep + cur.bofs;
    S.a_ready(cur);
    if constexpr (SP2) {
        PG8_STAGE(PG8_SB(0, 0), cB, voffB); PG8_STAGE(PG8_SB(0, 1), cB + hstep, voffB); PG8_STAGE(PG8_SA(0, 0), cA, voffA); PG8_STAGE(PG8_SA(0, 1), cA + hstep, voffA);
        if (wr == 1) PG8_BAR;
        PG8_WAIT_V(2); PG8_BAR;
        PG8_STAGE(PG8_SB(1, 0), cB + kstep, voffB); PG8_STAGE(PG8_SA(1, 0), cA + kstep, voffA); PG8_STAGE(PG8_SB(1, 1), cB + hstep + kstep, voffB);
        PG8_WAIT_V(6); PG8_BAR;
    } else {
        PG8_STAGE(PG8_SB(0, 0), cB, voffB); PG8_STAGE(PG8_SA(0, 0), cA, voffA); PG8_STAGE(PG8_SB(0, 1), cB + hstep, voffB); PG8_STAGE(PG8_SA(0, 1), cA + hstep, voffA);
        if (wr == 1) PG8_BAR;
        PG8_WAIT_V(4); PG8_BAR;
        PG8_STAGE(PG8_SB(1, 0), cB + kstep, voffB); PG8_STAGE(PG8_SA(1, 0), cA + kstep, voffA); PG8_STAGE(PG8_SB(1, 1), cB + hstep + kstep, voffB);
        PG8_WAIT_V(6); PG8_BAR;
    }
    for (;;) {
        const bool has_next = S.next(ui + 1, nxt);
        const char* nA = has_next ? (const char*)g.A + (size_t)nxt.pm * tstep : cA; const char* nB = has_next ? (const char*)g.Bt + (size_t)nxt.pn * tstep + nxt.bofs : cB;
        for (int t = 0; t < nt; t += 2) {
            const bool last = (t == nt - 2);
            const char* a1 = cA + (size_t)(t + 1) * kstep;
            const char* a2 = last ? nA : cA + (size_t)(t + 2) * kstep; const char* b2 = last ? nB : cB + (size_t)(t + 2) * kstep;
            const char* a3 = a2 + kstep; const char* b3 = b2 + kstep;
            if (last && has_next) S.a_ready(nxt);
            if constexpr (SP2) {
            PG8_LDB(B0, 0, 0); PG8_LDB(B1, 0, 1); PG8_SCHED; PG8_LDA(At, 0, 0); PG8_STAGE(PG8_SA(1, 1), a1 + hstep, voffA);
            PG8_WAIT_V(8); PG8_WAIT_L(0); PG8_BAR; PG8_MMA(0, 0, At, B0); PG8_MMA(0, 1, At, B1); PG8_BAR; PG8_SCHED;
            PG8_LDA(At, 0, 1); PG8_STAGE(PG8_SB(0, 0), b2, voffB); PG8_STAGE(PG8_SB(0, 1), b2 + hstep, voffB); PG8_STAGE(PG8_SA(0, 0), a2, voffA);
            PG8_WAIT_V(8); PG8_WAIT_L(0); PG8_BAR; PG8_MMA(1, 0, At, B0); PG8_MMA(1, 1, At, B1); PG8_BAR; PG8_SCHED;
            PG8_LDB(B0, 1, 0); PG8_LDB(B1, 1, 1); PG8_SCHED; PG8_LDA(At, 1, 0); PG8_STAGE(PG8_SA(0, 1), a2 + hstep, voffA);
            PG8_WAIT_V(8); PG8_WAIT_L(0); PG8_BAR; PG8_MMA(0, 0, At, B0); PG8_MMA(0, 1, At, B1); PG8_BAR; PG8_SCHED;
            PG8_LDA(At, 1, 1); PG8_STAGE(PG8_SB(1, 0), b3, voffB); PG8_STAGE(PG8_SB(1, 1), b3 + hstep, voffB); PG8_STAGE(PG8_SA(1, 0), a3, voffA);
            PG8_WAIT_V(8); PG8_WAIT_L(0); PG8_BAR; PG8_MMA(1, 0, At, B0); PG8_MMA(1, 1, At, B1); PG8_BAR; PG8_SCHED;
            } else {
            PG8_LDB(B0, 0, 0); PG8_SCHED; PG8_LDA(At, 0, 0); PG8_STAGE(PG8_SA(1, 1), a1 + hstep, voffA);
            PG8_WAIT_L(8); PG8_BAR; PG8_WAIT_L(0); PG8_MMA(0, 0, At, B0); PG8_BAR; PG8_SCHED;
            PG8_LDB(B1, 0, 1); PG8_STAGE(PG8_SB(0, 0), b2, voffB);
            PG8_BAR; PG8_WAIT_L(0); PG8_MMA(0, 1, At, B1); PG8_BAR;
            PG8_LDA(At, 0, 1); PG8_STAGE(PG8_SA(0, 0), a2, voffA);
            PG8_BAR; PG8_WAIT_L(0); PG8_MMA(1, 0, At, B0); PG8_BAR; PG8_SCHED;
            PG8_STAGE(PG8_SB(0, 1), b2 + hstep, voffB);
            PG8_WAIT_V(6); PG8_BAR; PG8_MMA(1, 1, At, B1); PG8_BAR;
            PG8_LDB(B0, 1, 0); PG8_SCHED; PG8_LDA(At, 1, 0); PG8_STAGE(PG8_SA(0, 1), a2 + hstep, voffA);
            PG8_WAIT_L(8); PG8_BAR; PG8_WAIT_L(0); PG8_MMA(0, 0, At, B0); PG8_BAR; PG8_SCHED;
            PG8_LDB(B1, 1, 1); PG8_STAGE(PG8_SB(1, 0), b3, voffB);
            PG8_BAR; PG8_WAIT_L(0); PG8_MMA(0, 1, At, B1); PG8_BAR;
            PG8_LDA(At, 1, 1); PG8_STAGE(PG8_SA(1, 0), a3, voffA);
            PG8_BAR; PG8_WAIT_L(0); PG8_MMA(1, 0, At, B0); PG8_BAR; PG8_SCHED;
            PG8_STAGE(PG8_SB(1, 1), b3 + hstep, voffB);
            PG8_WAIT_V(6); PG8_BAR; PG8_MMA(1, 1, At, B1); PG8_BAR;
            }
        }
        if constexpr (ALIGN_EPI) { if (wr == 0) PG8_BAR; }
        if constexpr (!Epi::AFTER_DRAIN) { E(acc, cur, wr, wc, fr, fq); S.done(cur); }
        if (!has_next) break;
#pragma unroll
        for (int a = 0; a < 2; ++a)
#pragma unroll
            for (int b = 0; b < 2; ++b)
#pragma unroll
                for (int m = 0; m < 4; ++m)
#pragma unroll
                    for (int n = 0; n < 2; ++n) acc[a][b][m][n] = (f32x4){0.f, 0.f, 0.f, 0.f};
        cur = nxt; cA = nA; cB = nB; ++ui;
        if constexpr (ALIGN_EPI) { if (wr == 1) PG8_BAR; }
    }
    PG8_WAIT_V(0);
    if constexpr (!ALIGN_EPI) { if (wr == 0) PG8_BAR; }
    PG8_BAR;
    if constexpr (Epi::AFTER_DRAIN) { E.fused(acc, cur, wr, wc, fr, fq, lds, wid, lane); S.done(cur); }
#undef PG8_SA
#undef PG8_SB
#undef PG8_STAGE
#undef PG8_LDA
#undef PG8_LDB
#undef PG8_MMA
#undef PG8_WAIT_V
#undef PG8_WAIT_L
#undef PG8_BAR
#undef PG8_SCHED
}
}

namespace att {
typedef unsigned short bf16;
using bf16x8 = __attribute__((ext_vector_type(8))) short;
using s16x4  = __attribute__((ext_vector_type(4))) short;
using f32x16 = __attribute__((ext_vector_type(16))) float;
using u32x4  = __attribute__((ext_vector_type(4))) unsigned;
constexpr int NW = 8, QBLK = 32, KVBLK = 64, DV = 128;
constexpr int SHM_V = KVBLK * DV * 2;
constexpr int OFF_V = 0, OFF_K = 2 * SHM_V, OFF_STASH = 65536;
constexpr float THR = 8.f;
#define ATT_SBAR() __builtin_amdgcn_sched_barrier(0)
template <int DQK> __device__ __forceinline__ int kswz(int row, int colB) { return row * (DQK * 2) + (colB ^ ((row & 7) << 4)); }
__device__ __forceinline__ int crow(int r, int hi) { return (r & 3) + 8 * (r >> 2) + 4 * hi; }
__device__ __forceinline__ unsigned cvtpk(float lo, float hi) { unsigned r; asm volatile("v_cvt_pk_bf16_f32 %0, %1, %2" : "=v"(r) : "v"(lo), "v"(hi)); return r; }

template <int DQK> __device__ __forceinline__ void partialSM(f32x16& p0, f32x16& p1, float& m_reg, float& mn, float& alpha) {
  constexpr float SCALE = (DQK == 128) ? 0.088388347648318440f : 0.125f;
  constexpr float C = SCALE * 1.4426950408889634f;
  float pmax = p0[0];
#pragma unroll
  for (int r = 1; r < 16; ++r) pmax = fmaxf(pmax, p0[r]);
#pragma unroll
  for (int r = 0; r < 16; ++r) pmax = fmaxf(pmax, p1[r]);
  { auto rr = __builtin_amdgcn_permlane32_swap(__float_as_uint(pmax), __float_as_uint(pmax), false, false);
    pmax = fmaxf(__uint_as_float(rr[0]), __uint_as_float(rr[1])); }
  if (__builtin_expect(__all(pmax - m_reg <= THR / SCALE), 1)) { mn = m_reg; alpha = 1.f; }
  else { mn = fmaxf(m_reg, pmax); alpha = __builtin_amdgcn_exp2f((m_reg - mn) * C); m_reg = mn; }
  const float mnC = -mn * C;
#pragma unroll
  for (int r = 0; r < 16; ++r) p0[r] = fmaf(p0[r], C, mnC);
#pragma unroll
  for (int r = 0; r < 16; ++r) p1[r] = fmaf(p1[r], C, mnC);
#pragma unroll
  for (int r = 0; r < 16; ++r) p0[r] = __builtin_amdgcn_exp2f(p0[r]);
}
__device__ __forceinline__ void finishSM(f32x16& p0, f32x16& p1, float alpha, float& l_reg, bf16x8& pa0, bf16x8& pa1, bf16x8& pa2, bf16x8& pa3) {
#pragma unroll
  for (int r = 0; r < 16; ++r) p1[r] = __builtin_amdgcn_exp2f(p1[r]);
  float ps = 0;
#pragma unroll
  for (int r = 0; r < 16; ++r) ps += p0[r];
#pragma unroll
  for (int r = 0; r < 16; ++r) ps += p1[r];
  { auto rr = __builtin_amdgcn_permlane32_swap(__float_as_uint(ps), __float_as_uint(ps), false, false);
    ps = __uint_as_float(rr[0]) + __uint_as_float(rr[1]); }
  l_reg = l_reg * alpha + ps;
#define ATT_PK4(P, BASE, OUT) do { unsigned a0 = cvtpk(P[BASE + 0], P[BASE + 1]), a1 = cvtpk(P[BASE + 2], P[BASE + 3]);   \
    unsigned b0 = cvtpk(P[BASE + 4], P[BASE + 5]), b1 = cvtpk(P[BASE + 6], P[BASE + 7]);                              \
    auto r0 = __builtin_amdgcn_permlane32_swap(a0, b0, false, false); auto r1 = __builtin_amdgcn_permlane32_swap(a1, b1, false, false); \
    u32x4 w = {r0[0], r1[0], r0[1], r1[1]}; OUT = *reinterpret_cast<bf16x8*>(&w); } while (0)
  ATT_PK4(p0, 0, pa0); ATT_PK4(p0, 8, pa1); ATT_PK4(p1, 0, pa2); ATT_PK4(p1, 8, pa3);
#undef ATT_PK4
}
template <int DQK> __device__ __forceinline__ void qkt(f32x16& p0, f32x16& p1, const char* Ks, const bf16x8* qr, int r32, int hi) {
  p0 = f32x16{}; p1 = f32x16{};
#pragma unroll
  for (int d0 = 0; d0 < DQK / 16; ++d0) { const int cb = (d0 * 16 + hi * 8) * 2;
    const bf16x8 b0 = *reinterpret_cast<const bf16x8*>(Ks + kswz<DQK>(r32, cb));
    const bf16x8 b1 = *reinterpret_cast<const bf16x8*>(Ks + kswz<DQK>(32 + r32, cb));
    p0 = __builtin_amdgcn_mfma_f32_32x32x16_bf16(b0, qr[d0], p0, 0, 0, 0);
    p1 = __builtin_amdgcn_mfma_f32_32x32x16_bf16(b1, qr[d0], p1, 0, 0, 0); }
}
__device__ __forceinline__ int v_st(int k, int c) { const int kk = (k & ~0xC) | ((k & 4) << 1) | ((k & 8) >> 1); return ((kk >> 3) * 4 + (c >> 5)) * 512 + ((kk & 7) * 32 + (c & 31)) * 2; }
__device__ __forceinline__ int v_rd_base(int lane) { return ((lane & 3) << 3) | (((lane >> 2) & 3) << 6) | (((lane >> 4) & 1) << 5) | (((lane >> 5) & 1) << 8); }
constexpr int v_rd_off(int d0, int ks, int half) { return d0 * 512 + ks * 4096 + half * 2048; }
template <int OFF> __device__ __forceinline__ s16x4 tr_read(int vb) {
  s16x4 r; asm volatile("ds_read_b64_tr_b16 %0, %1 offset:%2" : "=&v"(r) : "v"(vb), "i"(OFF) : "memory"); return r;
}
template <int D0> __device__ __forceinline__ void pv_one(f32x16& od, int vb, bf16x8 pa0, bf16x8 pa1, bf16x8 pa2, bf16x8 pa3) {
  const s16x4 l0 = tr_read<v_rd_off(D0, 0, 0)>(vb), h0 = tr_read<v_rd_off(D0, 0, 1)>(vb), l1 = tr_read<v_rd_off(D0, 1, 0)>(vb), h1 = tr_read<v_rd_off(D0, 1, 1)>(vb);
  const s16x4 l2 = tr_read<v_rd_off(D0, 2, 0)>(vb), h2 = tr_read<v_rd_off(D0, 2, 1)>(vb), l3 = tr_read<v_rd_off(D0, 3, 0)>(vb), h3 = tr_read<v_rd_off(D0, 3, 1)>(vb);
  asm volatile("s_waitcnt lgkmcnt(0)" ::: "memory"); ATT_SBAR();
#define ATT_PK(L, H) (bf16x8){L[0], L[1], L[2], L[3], H[0], H[1], H[2], H[3]}
  od = __builtin_amdgcn_mfma_f32_32x32x16_bf16(pa0, ATT_PK(l0, h0), od, 0, 0, 0);
  od = __builtin_amdgcn_mfma_f32_32x32x16_bf16(pa1, ATT_PK(l1, h1), od, 0, 0, 0);
  od = __builtin_amdgcn_mfma_f32_32x32x16_bf16(pa2, ATT_PK(l2, h2), od, 0, 0, 0);
  od = __builtin_amdgcn_mfma_f32_32x32x16_bf16(pa3, ATT_PK(l3, h3), od, 0, 0, 0);
#undef ATT_PK
}
__device__ __forceinline__ void pv_d0(f32x16* o, int vb, bf16x8 pa0, bf16x8 pa1, bf16x8 pa2, bf16x8 pa3) {
  pv_one<0>(o[0], vb, pa0, pa1, pa2, pa3); pv_one<1>(o[1], vb, pa0, pa1, pa2, pa3); pv_one<2>(o[2], vb, pa0, pa1, pa2, pa3); pv_one<3>(o[3], vb, pa0, pa1, pa2, pa3);
}

template <int DQK, int LDQ, int LDK, int LDV>
__device__ __forceinline__ void attn_pass(const bf16* __restrict__ Qb, const bf16* __restrict__ Kh, const bf16* __restrict__ Vh, int seq, char* lds, float* wsf, f32x16 (&o)[4], float& l_out) {
  constexpr int SHM_K = KVBLK * DQK * 2, NLD = (DQK == 128) ? 4 : 3;
  int tid_ = threadIdx.x; asm volatile("" : "+v"(tid_));
  const int tid = tid_, wid = tid >> 6, lane = tid & 63, r32 = lane & 31, hi = lane >> 5;
  char* V_lds = lds + OFF_V; char* K_lds = lds + OFF_K;
  float* al_l = wsf + 32;
  float m_reg = -1e30f, l_reg = 0;
#pragma unroll
  for (int d = 0; d < 4; ++d) o[d] = f32x16{};
  bf16x8 qr[DQK / 16];
  const bf16* Qw = Qb + (long)(wid * QBLK + r32) * LDQ + hi * 8;
#pragma unroll
  for (int d0 = 0; d0 < DQK / 16; ++d0) qr[d0] = *reinterpret_cast<const bf16x8*>(Qw + d0 * 16);
  const int sr = tid >> 4, sc = (tid & 15) * 8, vst0 = v_st(sr, sc), vst1 = v_st(32 + sr, sc);
  const int kr = (DQK == 128) ? sr : (tid >> 3), kc = (DQK == 128) ? sc : (tid & 7) * 8;
  const int vb0 = (int)(uintptr_t)V_lds + v_rd_base(lane);
  struct { bf16x8 vs0, vs1, ks0, ks1; } sr_[2];
#define ATT_SLOAD(i, k0) do { sr_[i].vs0 = *reinterpret_cast<const bf16x8*>(&Vh[(long)((k0) + sr) * LDV + sc]); sr_[i].vs1 = *reinterpret_cast<const bf16x8*>(&Vh[(long)((k0) + 32 + sr) * LDV + sc]); \
    sr_[i].ks0 = *reinterpret_cast<const bf16x8*>(&Kh[(long)((k0) + kr) * LDK + kc]); if constexpr (DQK == 128) sr_[i].ks1 = *reinterpret_cast<const bf16x8*>(&Kh[(long)((k0) + 32 + kr) * LDK + kc]); } while (0)
#define ATT_SWRITE(b, i) do { *(bf16x8*)(V_lds + (b) * SHM_V + vst0) = sr_[i].vs0; *(bf16x8*)(V_lds + (b) * SHM_V + vst1) = sr_[i].vs1; \
    *(bf16x8*)(K_lds + (b) * SHM_K + kswz<DQK>(kr, kc * 2)) = sr_[i].ks0; if constexpr (DQK == 128) *(bf16x8*)(K_lds + (b) * SHM_K + kswz<DQK>(32 + kr, kc * 2)) = sr_[i].ks1; } while (0)
#define ATT_SWAIT() do { if constexpr (NLD == 4) asm volatile("s_waitcnt vmcnt(4)" ::: "memory"); else asm volatile("s_waitcnt vmcnt(3)" ::: "memory"); } while (0)
#define ATT_RESC(a) do { if (__any((a) < 1.f)) { if (hi == 0) al_l[r32] = (a); asm volatile("s_waitcnt lgkmcnt(0)" ::: "memory"); \
    _Pragma("unroll") for (int d = 0; d < 4; ++d) _Pragma("unroll") for (int r = 0; r < 16; ++r) o[d][r] *= al_l[crow(r, hi)]; } } while (0)
  f32x16 pA0, pA1, pB0, pB1; float mnA, mnB, alA, alB; bf16x8 pa0, pa1, pa2, pa3; const int NT = seq / KVBLK;
  constexpr int SE = 0, SO = 1;
  ATT_SLOAD(SE, 0); asm volatile("s_waitcnt vmcnt(0)" ::: "memory"); ATT_SWRITE(0, SE); __syncthreads();
  qkt<DQK>(pA0, pA1, K_lds, qr, r32, hi); partialSM<DQK>(pA0, pA1, m_reg, mnA, alA);
  ATT_SLOAD(SO, KVBLK); if (2 < NT) ATT_SLOAD(SE, 2 * KVBLK);
  ATT_SWAIT(); ATT_SWRITE(1, SO); __syncthreads();
  for (int j = 1; j + 1 < NT; j += 2) {
    ATT_SBAR(); qkt<DQK>(pB0, pB1, K_lds + SHM_K, qr, r32, hi);
    finishSM(pA0, pA1, alA, l_reg, pa0, pa1, pa2, pa3); ATT_SBAR();
    ATT_SLOAD(SO, (j + 2) * KVBLK); ATT_SBAR();
    pv_d0(o, vb0, pa0, pa1, pa2, pa3); partialSM<DQK>(pB0, pB1, m_reg, mnB, alB);
    __syncthreads(); ATT_SWAIT(); ATT_SWRITE(0, SE);
    ATT_RESC(alB); __syncthreads();
    ATT_SBAR(); qkt<DQK>(pA0, pA1, K_lds, qr, r32, hi);
    finishSM(pB0, pB1, alB, l_reg, pa0, pa1, pa2, pa3); ATT_SBAR();
    if (j + 3 < NT) ATT_SLOAD(SE, (j + 3) * KVBLK); ATT_SBAR();
    pv_d0(o, vb0 + SHM_V, pa0, pa1, pa2, pa3); partialSM<DQK>(pA0, pA1, m_reg, mnA, alA);
    __syncthreads(); ATT_SWAIT(); ATT_SWRITE(1, SO);
    ATT_RESC(alA); __syncthreads();
  }
  ATT_SBAR(); qkt<DQK>(pB0, pB1, K_lds + SHM_K, qr, r32, hi);
  finishSM(pA0, pA1, alA, l_reg, pa0, pa1, pa2, pa3); ATT_SBAR();
  pv_d0(o, vb0, pa0, pa1, pa2, pa3); partialSM<DQK>(pB0, pB1, m_reg, mnB, alB);
  __syncthreads(); ATT_RESC(alB);
  finishSM(pB0, pB1, alB, l_reg, pa0, pa1, pa2, pa3); ATT_SBAR();
  pv_d0(o, vb0 + SHM_V, pa0, pa1, pa2, pa3);
  l_out = l_reg;
#undef ATT_SLOAD
#undef ATT_SWRITE
#undef ATT_SWAIT
#undef ATT_RESC
}
__device__ __forceinline__ void row_recips(float l_reg, float* wsf, int r32, int hi, float (&rli)[16]) {
  if (hi == 0) wsf[r32] = l_reg; asm volatile("s_waitcnt lgkmcnt(0)" ::: "memory");
#pragma unroll
  for (int r = 0; r < 16; ++r) rli[r] = __builtin_amdgcn_rcpf(wsf[crow(r, hi)]);
  asm volatile("s_waitcnt lgkmcnt(0)" ::: "memory");
}
}

constexpr int NWAVES = 8;
constexpr int DM = 2048, BATCH = 4, SEQ = 8192, T = BATCH * SEQ;
constexpr int NCOL1 = 4608 + 4096;
constexpr int NEXP = 32, FF = 512, LCAP = 32768;
constexpr int PMAX = 288;
constexpr float EPS = 1e-6f;
constexpr float LAM_INIT = 0.2f;
#ifndef MK_ONE_LAUNCH
#define MK_ONE_LAUNCH 1
#endif
constexpr int N_PHASES = 11;

constexpr size_t MiB = 1u << 20;
constexpr size_t WS_CTL = 0, CTL_ZERO_BYTES = 1 * MiB;
constexpr size_t WS_ROPE = 2 * MiB;
constexpr size_t WS_WRT = 4 * MiB;
constexpr size_t WS_TOKROW = 5 * MiB;
constexpr size_t WS_ROWW = 6 * MiB;
constexpr size_t WS_WIN = 8 * MiB;
constexpr size_t WS_WA = 42 * MiB, WS_WB = 46 * MiB, WS_WO = 50 * MiB;
constexpr size_t WS_W13 = 58 * MiB;
constexpr size_t WS_W2 = 186 * MiB;
constexpr size_t WS_SSQ = 250 * MiB;
constexpr size_t WS_LENT = 254 * MiB, WS_LW = 258 * MiB;
constexpr size_t WS_XN = 264 * MiB;
constexpr size_t WS_QA = 392 * MiB, WS_KA = 456 * MiB, WS_VA = 472 * MiB, WS_QB = 488 * MiB, WS_KB = 552 * MiB, WS_VB = 616 * MiB;
constexpr size_t WS_XG = 392 * MiB;
constexpr size_t WS_GT = 680 * MiB;
constexpr size_t WS_YC = WS_XG;
constexpr size_t WS_END = 936 * MiB;
constexpr int CW_CNT = 64;
constexpr int CW_BAR = 4096;

constexpr int SCR_OFF = 0, SCR_BYTES = 131072;
constexpr int AWS_OFF = 131072;
constexpr int MOE_OFF = AWS_OFF + 2048;
constexpr int MISC_OFF = MOE_OFF + 512;
constexpr int LDS_BYTES = 147456;
static_assert(MISC_OFF + 128 <= LDS_BYTES, "LDS map");

#define GAS __attribute__((address_space(1)))
#define LAS __attribute__((address_space(3)))
typedef unsigned short bf16;
typedef unsigned v4u __attribute__((ext_vector_type(4)));
typedef unsigned v2u __attribute__((ext_vector_type(2)));
typedef float f32x4 __attribute__((ext_vector_type(4)));
typedef short bf16x8 __attribute__((ext_vector_type(8)));
typedef GAS unsigned gu32;
#define RLX_AGENT __ATOMIC_RELAXED, __HIP_MEMORY_SCOPE_AGENT
#define LDS_WAIT() asm volatile("s_waitcnt lgkmcnt(0)" ::: "memory")
#define VM_WAIT() asm volatile("s_waitcnt vmcnt(0)" ::: "memory")
__device__ __forceinline__ unsigned f2bf(float f) { unsigned u = __builtin_bit_cast(unsigned, f); return (u + 0x7fffu + ((u >> 16) & 1u)) >> 16; }
__device__ __forceinline__ unsigned pk2(float lo, float hi) { return f2bf(lo) | (f2bf(hi) << 16); }
__device__ __forceinline__ float bflo(unsigned w) { return __uint_as_float(w << 16); }
__device__ __forceinline__ float bfhi(unsigned w) { return __uint_as_float(w & 0xffff0000u); }
__device__ __forceinline__ float wave_sum(float v) {
#pragma unroll
    for (int o = 1; o < 64; o <<= 1) v += __shfl_xor(v, o);
    return v;
}

#define XB_TMO      128
#define XB_XCNT(j)  (256  + 64 * (j))
#define XB_XSUB(j)  (1280 + 64 * (j))
#define XB_XGEN(j)  (2304 + 64 * (j))
#define XB_TOP      3328
#define XB_TOPGEN   3392
#define XCD_BAR_WORDS 3456
#define XB_SPIN_CAP (1u << 18)

__device__ __forceinline__ unsigned xb_ld(unsigned* p)              { return __hip_atomic_load(p, __ATOMIC_RELAXED, __HIP_MEMORY_SCOPE_AGENT); }
__device__ __forceinline__ unsigned xb_add(unsigned* p, unsigned v) { return __hip_atomic_fetch_add(p, v, __ATOMIC_RELAXED, __HIP_MEMORY_SCOPE_AGENT); }
__device__ __forceinline__ unsigned xb_xcc_id() { return (unsigned)__builtin_amdgcn_s_getreg((3 << 11) | 20) & 0xFu; }
#define XB_SPIN(cond, bar) do { unsigned _sp = 0; while (cond) { __builtin_amdgcn_s_sleep(1); \
    if ((++_sp & 255u) == 0u) { if (xb_ld(&(bar)[XB_TMO])) break; if (_sp > XB_SPIN_CAP) { atomicAdd(&(bar)[XB_TMO], 1u); break; } } } } while (0)

struct XcdBarrier {
    unsigned* bar; unsigned x;
    volatile LAS unsigned* st;
};

__device__ __forceinline__ XcdBarrier xcd_barrier_post(unsigned* bar, volatile LAS unsigned* st) {
    XcdBarrier b; b.bar = bar; b.x = xb_xcc_id(); b.st = st;
    if (threadIdx.x == 0) (void)xb_add(&bar[XB_XCNT(b.x)], 1u);
    return b;
}
__device__ __forceinline__ void xcd_barrier_complete(unsigned* bar, unsigned x, unsigned& nloc, unsigned& nx) {
    const unsigned G = gridDim.x * gridDim.y * gridDim.z;
    unsigned sum, cnt, mine, sp = 0u;
    for (;;) {
        sum = 0u; cnt = 0u; mine = 0u;
#pragma unroll
        for (unsigned j = 0; j < 16; ++j) { const unsigned c = xb_ld(&bar[XB_XCNT(j)]); sum += c; cnt += (c > 0u) ? 1u : 0u; mine = (j == x) ? c : mine; }
        if (sum == G) break;
        __builtin_amdgcn_s_sleep(1);
        if ((++sp & 255u) == 0u) { if (xb_ld(&bar[XB_TMO])) break; if (sp > XB_SPIN_CAP) { atomicAdd(&bar[XB_TMO], 1u); break; } }
    }
    nloc = mine > 0u ? mine : 1u; nx = cnt > 0u ? cnt : 1u;
}

__device__ __forceinline__ void xcd_barrier(const XcdBarrier& b) {
    asm volatile("s_waitcnt vmcnt(0)" ::: "memory");
    __syncthreads();
    if (threadIdx.x == 0) {
        unsigned* bar = b.bar;
        __builtin_amdgcn_s_waitcnt(0);
        unsigned nloc = b.st[0], nx = b.st[1];
        if (nloc == 0u) { xcd_barrier_complete(bar, b.x, nloc, nx); b.st[0] = nloc; b.st[1] = nx; }
        const unsigned old = xb_add(&bar[XB_XSUB(b.x)], 1u);
        const unsigned gen = old / nloc;
        if (old + 1u == (gen + 1u) * nloc) {
            __builtin_amdgcn_fence(__ATOMIC_RELEASE, "agent");
            asm volatile("s_waitcnt vmcnt(0)" ::: "memory");
            const unsigned og = xb_add(&bar[XB_TOP], 1u);
            const unsigned tg = og / nx;
            if (og + 1u == (tg + 1u) * nx) xb_add(&bar[XB_TOPGEN], 1u);
            else XB_SPIN(xb_ld(&bar[XB_TOPGEN]) == tg, bar);
            __builtin_amdgcn_fence(__ATOMIC_ACQUIRE, "agent");
            xb_add(&bar[XB_XGEN(b.x)], 1u);
            asm volatile("s_waitcnt vmcnt(0)" ::: "memory");
        } else {
            XB_SPIN(xb_ld(&bar[XB_XGEN(b.x)]) == gen, bar);
            __builtin_amdgcn_fence(__ATOMIC_ACQUIRE, "agent");
            asm volatile("s_waitcnt vmcnt(0)" ::: "memory");
        }
    }
    __syncthreads();
}

struct Args { const float* in[22]; float* out; unsigned char* ws; int ph_lo, ph_hi, li, pad; };
struct Frame { unsigned char* lds; int tid, lane, wave, vcu, G, gw, NGW; };
typedef const Args __attribute__((address_space(4)))* KArgs;
#define FRESH_ARGS() ({ KArgs p_ = (KArgs)__builtin_amdgcn_kernarg_segment_ptr(); asm volatile("" : "+s"(p_)); p_; })

__device__ __forceinline__ void p0_transpose_item(const float* W, int N, int k0, int n0, bf16* WT, int K, int dst_row0, LAS float* scr, int lane) {
#pragma unroll 8
    for (int i = 0; i < 32; ++i) { const int kk = 2 * i + (lane >> 5); scr[kk * 33 + (lane & 31)] = W[(size_t)(k0 + kk) * N + n0 + (lane & 31)]; }
    LDS_WAIT(); asm volatile("" ::: "memory");
    const int c = lane & 7;
#pragma unroll
    for (int j = 0; j < 4; ++j) { const int n = (lane >> 3) + 8 * j; const LAS float* s = scr + (8 * c) * 33 + n;
        v4u o; o.x = pk2(s[0 * 33], s[1 * 33]); o.y = pk2(s[2 * 33], s[3 * 33]); o.z = pk2(s[4 * 33], s[5 * 33]); o.w = pk2(s[6 * 33], s[7 * 33]);
        *(GAS v4u*)(WT + (size_t)(dst_row0 + n) * K + k0 + 8 * c) = o; }
    LDS_WAIT(); asm volatile("" ::: "memory");
}
__device__ __forceinline__ void p0_prologue(const Frame& F, KArgs a) {
    unsigned char* ws = a->ws;
    LAS float* scr = (LAS float*)((LAS unsigned char*)F.lds + SCR_OFF + F.wave * 16384);
    constexpr int I_IN = 32 * 144, I_GT = 32 * 128, I_BA = 16 * 64, I_WO = 32 * 64, I_E = 32 * 512;
    constexpr int NITEMS = I_IN + I_GT + 2 * I_BA + I_WO + 3 * I_E;
    for (int it = F.gw; it < NITEMS; it += F.NGW) {
        int r = it;
        if (r < I_IN) { const int kb = r / 144, nb = r % 144; p0_transpose_item(a->in[2], 4608, 64 * kb, 32 * nb, (bf16*)(ws + WS_WIN), 2048, 32 * nb, scr, F.lane); continue; } r -= I_IN;
        if (r < I_GT) { const int kb = r / 128, nb = r % 128; p0_transpose_item(a->in[12], 4096, 64 * kb, 32 * nb, (bf16*)(ws + WS_WIN), 2048, 4608 + 32 * nb, scr, F.lane); continue; } r -= I_GT;
        if (r < I_BA) { const int kb = r / 64, nb = r % 64; p0_transpose_item(a->in[10], 2048, 64 * kb, 32 * nb, (bf16*)(ws + WS_WA), 1024, 32 * nb, scr, F.lane); continue; } r -= I_BA;
        if (r < I_BA) { const int kb = r / 64, nb = r % 64; p0_transpose_item(a->in[11], 2048, 64 * kb, 32 * nb, (bf16*)(ws + WS_WB), 1024, 32 * nb, scr, F.lane); continue; } r -= I_BA;
        if (r < I_WO) { const int kb = r / 64, nb = r % 64; p0_transpose_item(a->in[14], 2048, 64 * kb, 32 * nb, (bf16*)(ws + WS_WO), 2048, 32 * nb, scr, F.lane); continue; } r -= I_WO;
        if (r < I_E)  { const int e = r / 512, q = r % 512, kb = q / 16, nb = q % 16, n0 = 32 * nb;
                        p0_transpose_item(a->in[18] + (size_t)e * 2048 * 512, 512, 64 * kb, n0, (bf16*)(ws + WS_W13), 2048, e * 1024 + (n0 >> 7) * 256 + (n0 & 127), scr, F.lane); continue; } r -= I_E;
        if (r < I_E)  { const int e = r / 512, q = r % 512, kb = q / 16, nb = q % 16, n0 = 32 * nb;
                        p0_transpose_item(a->in[19] + (size_t)e * 2048 * 512, 512, 64 * kb, n0, (bf16*)(ws + WS_W13), 2048, e * 1024 + (n0 >> 7) * 256 + 128 + (n0 & 127), scr, F.lane); continue; } r -= I_E;
        { const int e = r / 512, q = r % 512, kb = q / 64, nb = q % 64;
          p0_transpose_item(a->in[20] + (size_t)e * 512 * 2048, 2048, 64 * kb, 32 * nb, (bf16*)(ws + WS_W2), 512, e * 2048 + 32 * nb, scr, F.lane); }
    }
    { float2* tab = (float2*)(ws + WS_ROPE);
      for (int idx = F.gw * 64 + F.lane; idx < SEQ * 32; idx += F.NGW * 64) { const int pos = idx >> 5, i = idx & 31;
          const float inv = powf(10000.0f, -(float)(2 * i) / 64.0f); const float ang = (float)pos * inv;
          double s, c; sincos((double)ang, &s, &c); tab[idx] = make_float2((float)c, (float)s); } }
    { bf16* wh = (bf16*)(ws + WS_WRT); bf16* wl = wh + 48 * 2048;
      for (int idx = F.gw * 64 + F.lane; idx < 48 * 2048; idx += F.NGW * 64) { const int c = idx >> 11, k = idx & 2047;
          const float v = c < 4 ? a->in[16][k * 4 + c] : (c < 36 ? a->in[17][k * 32 + (c - 4)] : 0.f);
          const unsigned h = f2bf(v); const float hf = __uint_as_float(h << 16); wh[idx] = (bf16)h; wl[idx] = (bf16)f2bf(v - hf); } }
    { const float* x = a->in[0]; const GAS f32x4* g4 = (const GAS f32x4*)a->in[1] + F.lane; bf16* XN = (bf16*)(ws + WS_XN);
      for (int m = F.gw; m < T; m += F.NGW) {
          const GAS f32x4* xr = (const GAS f32x4*)(x + (size_t)m * DM) + F.lane; f32x4 v[8]; float s = 0.f;
#pragma unroll
          for (int j = 0; j < 8; ++j) { v[j] = xr[64 * j]; s += (v[j].x * v[j].x + v[j].y * v[j].y) + (v[j].z * v[j].z + v[j].w * v[j].w); }
          const float rstd = 1.0f / sqrtf(wave_sum(s) * (1.0f / DM) + EPS);
          GAS v2u* o8 = (GAS v2u*)(XN + (size_t)m * DM) + F.lane;
#pragma unroll
          for (int j = 0; j < 8; ++j) { const f32x4 g = g4[64 * j]; v2u w; w.x = pk2(v[j].x * rstd * g.x, v[j].y * rstd * g.y); w.y = pk2(v[j].z * rstd * g.z, v[j].w * rstd * g.w); o8[64 * j] = w; } } }
}

__device__ __forceinline__ void rope8(float (&v)[8], const float2* tab, int pos, int cc) {
    const GAS f32x4* tp = (const GAS f32x4*)(tab + (size_t)pos * 32 + 8 * (cc & 3));
    const f32x4 t0 = tp[0], t1 = tp[1], t2 = tp[2], t3 = tp[3];
    const float cs[8] = {t0.x, t0.z, t1.x, t1.z, t2.x, t2.z, t3.x, t3.z}, sn[8] = {t0.y, t0.w, t1.y, t1.w, t2.y, t2.w, t3.y, t3.w};
    const float sg = (cc & 4) ? 1.f : -1.f;
#pragma unroll
    for (int e = 0; e < 8; ++e) { const float p = __shfl_xor(v[e], 4); v[e] = v[e] * cs[e] + sg * p * sn[e]; }
}
__device__ __forceinline__ void unpack8(const v4u w, float (&v)[8]) { v[0] = bflo(w.x); v[1] = bfhi(w.x); v[2] = bflo(w.y); v[3] = bfhi(w.y); v[4] = bflo(w.z); v[5] = bfhi(w.z); v[6] = bflo(w.w); v[7] = bfhi(w.w); }
__device__ __forceinline__ v4u pack8(const float (&v)[8]) { v4u w; w.x = pk2(v[0], v[1]); w.y = pk2(v[2], v[3]); w.z = pk2(v[4], v[5]); w.w = pk2(v[6], v[7]); return w; }
__device__ __forceinline__ void p1b_normrope(const Frame& F, KArgs a) {
    unsigned char* ws = a->ws; const float2* tab = (const float2*)(ws + WS_ROPE);
    bf16* QA = (bf16*)(ws + WS_QA); bf16* KA = (bf16*)(ws + WS_KA); bf16* QB = (bf16*)(ws + WS_QB); bf16* KB = (bf16*)(ws + WS_KB);
    const float* qg = a->in[3]; const float* kg = a->in[4];
    const int cc16 = F.lane & 15;
    float gq[8], gk[8];
#pragma unroll
    for (int e = 0; e < 8; ++e) { gq[e] = qg[cc16 * 8 + e]; gk[e] = kg[cc16 * 8 + e]; }
    for (int t = F.gw; t < T; t += F.NGW) {
        const int s = t & (SEQ - 1), prow = s >> 6, pcol = s & 63;
        const int posA = (cc16 < 8) ? prow : pcol;
#pragma unroll
        for (int j = 0; j < 3; ++j) {
            const bool isk = (j == 2); const int c = isk ? (F.lane & 31) : (F.lane + 64 * j);
            bf16* p = (isk ? KA + (size_t)t * 256 : QA + (size_t)t * 1024) + c * 8;
            float v[8]; unpack8(*(const GAS v4u*)p, v);
            float ss = 0.f;
#pragma unroll
            for (int e = 0; e < 8; ++e) ss += v[e] * v[e];
            ss += __shfl_xor(ss, 1); ss += __shfl_xor(ss, 2); ss += __shfl_xor(ss, 4); ss += __shfl_xor(ss, 8);
            const float rstd = 1.0f / sqrtf(ss * (1.0f / 128.0f) + EPS);
#pragma unroll
            for (int e = 0; e < 8; ++e) v[e] = v[e] * rstd * (isk ? gk[e] : gq[e]);
            rope8(v, tab, posA, cc16 & 7);
            if (!isk || F.lane < 32) *(GAS v4u*)p = pack8(v);
        }
#pragma unroll
        for (int j = 0; j < 4; ++j) {
            bf16* p = ((j & 2) ? KB : QB) + (size_t)t * 1024 + (F.lane + 64 * (j & 1)) * 8;
            float v[8]; unpack8(*(const GAS v4u*)p, v);
            rope8(v, tab, s, F.lane & 7);
            *(GAS v4u*)p = pack8(v);
        }
    }
}

__device__ __forceinline__ void attn_unit_A(const Frame& F, KArgs a, int b, int h, int qb) {
    using namespace att;
    unsigned char* ws = a->ws; char* lds = (char*)F.lds + SCR_OFF; float* wsf = (float*)((char*)F.lds + AWS_OFF) + F.wave * 64;
    const int r32 = F.lane & 31, hi = F.lane >> 5, kvh = h >> 2;
    const att::bf16* Qb = (const att::bf16*)(ws + WS_QA) + ((size_t)b * SEQ + (size_t)qb * 256) * 1024 + h * 128;
    const att::bf16* Kh = (const att::bf16*)(ws + WS_KA) + (size_t)b * SEQ * 256 + kvh * 128;
    const att::bf16* Vh = (const att::bf16*)(ws + WS_VA) + (size_t)b * SEQ * 256 + kvh * 128;
    f32x16 o[4]; float l_reg;
    attn_pass<128, 1024, 256, 256>(Qb, Kh, Vh, SEQ, lds, wsf, o, l_reg);
    float rli[16]; row_recips(l_reg, wsf, r32, hi, rli);
    att::bf16* Ow = (att::bf16*)(ws + WS_QA) + ((size_t)b * SEQ + (size_t)qb * 256 + F.wave * 32) * 1024 + h * 128;
#pragma unroll
    for (int r = 0; r < 16; ++r) { const int orow = crow(r, hi);
#pragma unroll
        for (int d0 = 0; d0 < 4; ++d0) Ow[(size_t)orow * 1024 + d0 * 32 + r32] = (att::bf16)f2bf(o[d0][r] * rli[r]); }
}
__device__ __forceinline__ void attn_unit_B(const Frame& F, KArgs a, int b, int h, int qb, float lam) {
    using namespace att;
    unsigned char* ws = a->ws; char* lds = (char*)F.lds + SCR_OFF; float* wsf = (float*)((char*)F.lds + AWS_OFF) + F.wave * 64;
    unsigned* stash = (unsigned*)(lds + OFF_STASH) + F.wave * 2048;
    const int r32 = F.lane & 31, hi = F.lane >> 5;
    const att::bf16* Qb = (const att::bf16*)(ws + WS_QB) + ((size_t)b * SEQ + (size_t)qb * 256) * 1024 + h * 128;
    const att::bf16* Kh = (const att::bf16*)(ws + WS_KB) + (size_t)b * SEQ * 1024 + h * 128;
    const att::bf16* Vh = (const att::bf16*)(ws + WS_VB) + (size_t)b * SEQ * 1024 + h * 128;
    f32x16 o[4]; float l_reg; float rli[16];
    attn_pass<64, 1024, 1024, 1024>(Qb, Kh, Vh, SEQ, lds, wsf, o, l_reg);
    row_recips(l_reg, wsf, r32, hi, rli);
#pragma unroll
    for (int d0 = 0; d0 < 4; ++d0)
#pragma unroll
        for (int r = 0; r < 16; r += 2) stash[(d0 * 8 + (r >> 1)) * 64 + F.lane] = att::cvtpk(o[d0][r] * rli[r], o[d0][r + 1] * rli[r + 1]);
    attn_pass<64, 1024, 1024, 1024>(Qb + 64, Kh + 64, Vh, SEQ, lds, wsf, o, l_reg);
    row_recips(l_reg, wsf, r32, hi, rli);
    asm volatile("s_waitcnt lgkmcnt(0)" ::: "memory");
    float ss[16];
#pragma unroll
    for (int r = 0; r < 16; ++r) ss[r] = 0.f;
#pragma unroll
    for (int d0 = 0; d0 < 4; ++d0)
#pragma unroll
        for (int r = 0; r < 16; r += 2) { const unsigned w = stash[(d0 * 8 + (r >> 1)) * 64 + F.lane];
            const float x0 = bflo(w) - lam * (o[d0][r] * rli[r]), x1 = bfhi(w) - lam * (o[d0][r + 1] * rli[r + 1]);
            o[d0][r] = x0; o[d0][r + 1] = x1; ss[r] += x0 * x0; ss[r + 1] += x1 * x1; }
#pragma unroll
    for (int r = 0; r < 16; ++r) { float s = ss[r]; s += __shfl_xor(s, 1); s += __shfl_xor(s, 2); s += __shfl_xor(s, 4); s += __shfl_xor(s, 8); s += __shfl_xor(s, 16);
        ss[r] = (1.0f - LAM_INIT) / sqrtf(s * (1.0f / 128.0f) + EPS); }
    const float* sg = a->in[9]; float g4[4];
#pragma unroll
    for (int d0 = 0; d0 < 4; ++d0) g4[d0] = sg[d0 * 32 + r32];
    att::bf16* Ow = (att::bf16*)(ws + WS_QB) + ((size_t)b * SEQ + (size_t)qb * 256 + F.wave * 32) * 1024 + h * 128;
#pragma unroll
    for (int r = 0; r < 16; ++r) { const int orow = crow(r, hi);
#pragma unroll
        for (int d0 = 0; d0 < 4; ++d0) Ow[(size_t)orow * 1024 + d0 * 32 + r32] = (att::bf16)f2bf(o[d0][r] * ss[r] * g4[d0]); }
}
__device__ __forceinline__ void p2_attention(const Frame& F, KArgs a) {
    const float lam = expf(wave_sum(a->in[5][F.lane] * a->in[6][F.lane])) - expf(wave_sum(a->in[7][F.lane] * a->in[8][F.lane])) + LAM_INIT;
    for (int L = F.vcu; L < 2048; L += F.G) {
        const int i = L >> 8, v = L & 255, x = v >> 5, qb = v & 31, b = x >> 1;
#ifndef ATT_SKIP_A
        if (i < 4) attn_unit_A(F, a, b, 4 * (x & 1) + i, qb);
#endif
#ifndef ATT_SKIP_B
        if (i >= 4) attn_unit_B(F, a, b, 4 * (x & 1) + (i - 4), qb, lam);
#endif
    }
}

__device__ __forceinline__ void moe_table(const Frame& F, KArgs a) {
    LAS int* tab = (LAS int*)((LAS unsigned char*)F.lds + MOE_OFF);
    if (F.tid == 0) { const gu32* cnt = (const gu32*)(a->ws + WS_CTL) + CW_CNT; int acc = 0;
        for (int e = 0; e < NEXP; ++e) { const int c = (int)__hip_atomic_load(cnt + e, RLX_AGENT); tab[e] = c; tab[32 + e] = acc; acc += (c + 255) >> 8; }
        tab[64] = acc; }
    __syncthreads();
}

__device__ __forceinline__ void p4_router(const Frame& F, KArgs a) {
    typedef float f32x4v __attribute__((ext_vector_type(4)));
    unsigned char* ws = a->ws; const float* X1 = a->out; const float* SSQ = (const float*)(ws + WS_SSQ); const float* gf = a->in[15];
    bf16* H2 = (bf16*)(ws + WS_GT); const bf16* wh = (const bf16*)(ws + WS_WRT); const bf16* wl = wh + 48 * 2048;
    gu32* cnt = (gu32*)(ws + WS_CTL) + CW_CNT; int* LENT = (int*)(ws + WS_LENT); float* LW = (float*)(ws + WS_LW);
    LAS float* LG = (LAS float*)((LAS unsigned char*)F.lds + SCR_OFF) + F.wave * (16 * 48);
    LAS int* lcnt = (LAS int*)((LAS unsigned char*)F.lds + SCR_OFF + 32768);
    const int row = F.lane & 15, kq = F.lane >> 4;
    const int NTASK = T / 16, rounds = (NTASK + F.NGW - 1) / F.NGW;
    for (int it = 0; it < rounds; ++it) {
        const int task = it * F.NGW + F.gw; const bool valid = task < NTASK; const int t0 = valid ? task * 16 : 0;
        if (F.tid < 64) lcnt[F.tid] = 0;
        __syncthreads();
        int e0 = 0, e1 = 0, r0 = 0, r1 = 0; float w0 = 0.f, w1 = 0.f;
        {
            const GAS f32x4v* sp = (const GAS f32x4v*)(SSQ + (size_t)(t0 + row) * 32); float s = 0.f;
#pragma unroll
            for (int j = 0; j < 8; ++j) { const f32x4v q = sp[j]; s += (q.x + q.y) + (q.z + q.w); }
            const float rstd = 1.0f / sqrtf(s * (1.0f / DM) + EPS);
            f32x4v acc[3] = {{0.f, 0.f, 0.f, 0.f}, {0.f, 0.f, 0.f, 0.f}, {0.f, 0.f, 0.f, 0.f}};
            const float* xrow = X1 + (size_t)(t0 + row) * DM + 8 * kq; bf16* hrow = H2 + (size_t)(t0 + row) * DM + 8 * kq;
            const bf16* bh = wh + (size_t)row * 2048 + 8 * kq; const bf16* bl = wl + (size_t)row * 2048 + 8 * kq;
#pragma unroll 2
            for (int ks = 0; ks < 64; ++ks) {
                const f32x4v x0 = *(const GAS f32x4v*)(xrow + 32 * ks), x1 = *(const GAS f32x4v*)(xrow + 32 * ks + 4);
                const f32x4v g0 = *(const GAS f32x4v*)(gf + 32 * ks + 8 * kq), g1 = *(const GAS f32x4v*)(gf + 32 * ks + 8 * kq + 4);
                float h[8] = {x0.x * rstd * g0.x, x0.y * rstd * g0.y, x0.z * rstd * g0.z, x0.w * rstd * g0.w, x1.x * rstd * g1.x, x1.y * rstd * g1.y, x1.z * rstd * g1.z, x1.w * rstd * g1.w};
                unsigned hh[8], hl[8];
#pragma unroll
                for (int e = 0; e < 8; ++e) { hh[e] = f2bf(h[e]); hl[e] = f2bf(h[e] - __uint_as_float(hh[e] << 16)); }
                v4u ah, al; ah.x = hh[0] | (hh[1] << 16); ah.y = hh[2] | (hh[3] << 16); ah.z = hh[4] | (hh[5] << 16); ah.w = hh[6] | (hh[7] << 16);
                al.x = hl[0] | (hl[1] << 16); al.y = hl[2] | (hl[3] << 16); al.z = hl[4] | (hl[5] << 16); al.w = hl[6] | (hl[7] << 16);
                if (valid) *(GAS v4u*)(hrow + 32 * ks) = ah;
                const bf16x8 Ah = __builtin_bit_cast(bf16x8, ah), Al = __builtin_bit_cast(bf16x8, al);
#pragma unroll
                for (int blk = 0; blk < 3; ++blk) {
                    const bf16x8 Bh = *(const GAS bf16x8*)(bh + (size_t)blk * 16 * 2048 + 32 * ks), Bl = *(const GAS bf16x8*)(bl + (size_t)blk * 16 * 2048 + 32 * ks);
                    acc[blk] = __builtin_amdgcn_mfma_f32_16x16x32_bf16(Ah, Bh, acc[blk], 0, 0, 0);
                    acc[blk] = __builtin_amdgcn_mfma_f32_16x16x32_bf16(Al, Bh, acc[blk], 0, 0, 0);
                    acc[blk] = __builtin_amdgcn_mfma_f32_16x16x32_bf16(Ah, Bl, acc[blk], 0, 0, 0);
                }
            }
#pragma unroll
            for (int blk = 0; blk < 3; ++blk)
#pragma unroll
                for (int i = 0; i < 4; ++i) LG[(4 * kq + i) * 48 + 16 * blk + row] = acc[blk][i];
            LDS_WAIT();
            if (F.lane < 16) {
                const LAS float* lg = LG + F.lane * 48;
                float gl[4];
#pragma unroll
                for (int i = 0; i < 4; ++i) gl[i] = lg[i];
                int gi = 0; float gm = gl[0];
#pragma unroll
                for (int i = 1; i < 4; ++i) if (gl[i] > gm) { gm = gl[i]; gi = i; }
                float gs = 0.f;
#pragma unroll
                for (int i = 0; i < 4; ++i) gs += expf(gl[i] - gm);
                const float gw_ = 1.0f / gs;
                const LAS float* el = lg + 4 + gi * 8;
                float ev[8];
#pragma unroll
                for (int i = 0; i < 8; ++i) ev[i] = el[i];
                int i0 = 0; float v0 = ev[0];
#pragma unroll
                for (int i = 1; i < 8; ++i) if (ev[i] > v0) { v0 = ev[i]; i0 = i; }
                int i1 = -1; float v1 = -3.0e38f;
#pragma unroll
                for (int i = 0; i < 8; ++i) if (i != i0 && ev[i] > v1) { v1 = ev[i]; i1 = i; }
                const float ex = expf(v1 - v0), den = 1.0f / (1.0f + ex);
                w0 = den * gw_; w1 = ex * den * gw_; e0 = gi * 8 + i0; e1 = gi * 8 + i1;
                if (valid) { r0 = atomicAdd((int*)&lcnt[e0], 1); r1 = atomicAdd((int*)&lcnt[e1], 1); }
            }
        }
        __syncthreads();
        if (F.tid < 32) { const int c = lcnt[F.tid]; lcnt[32 + F.tid] = c ? (int)__hip_atomic_fetch_add(cnt + F.tid, (unsigned)c, RLX_AGENT) : 0; }
        __syncthreads();
        if (valid && F.lane < 16) { const int tok = t0 + F.lane;
            const int s0 = lcnt[32 + e0] + r0, s1 = lcnt[32 + e1] + r1;
            LENT[(size_t)e0 * LCAP + s0] = tok * 2; LW[(size_t)e0 * LCAP + s0] = w0;
            LENT[(size_t)e1 * LCAP + s1] = tok * 2 + 1; LW[(size_t)e1 * LCAP + s1] = w1; }
        __syncthreads();
    }
}

__device__ __forceinline__ void p4b_gather(const Frame& F, KArgs a) {
    unsigned char* ws = a->ws; const LAS int* tab = (const LAS int*)((LAS unsigned char*)F.lds + MOE_OFF);
    const bf16* H2 = (const bf16*)(ws + WS_GT); bf16* XG = (bf16*)(ws + WS_XG); float* ROWW = (float*)(ws + WS_ROWW); int* TOKROW = (int*)(ws + WS_TOKROW);
    const int* LENT = (const int*)(ws + WS_LENT); const float* LW = (const float*)(ws + WS_LW);
    const int P = tab[64];
    for (int R = F.gw; R < P * 256; R += F.NGW) {
        const int p = R >> 8; int e = 0;
#pragma unroll 1
        for (int k = 1; k < 32; ++k) if (tab[32 + k] <= p) e = k;
        const int slot = R - tab[32 + e] * 256;
        GAS v4u* dst = (GAS v4u*)(XG + (size_t)R * DM) + F.lane;
        if (slot < tab[e]) {
            const int ent = LENT[(size_t)e * LCAP + slot]; const GAS v4u* src = (const GAS v4u*)(H2 + (size_t)(ent >> 1) * DM) + F.lane;
#pragma unroll
            for (int j = 0; j < 4; ++j) dst[64 * j] = src[64 * j];
            if (F.lane == 0) { ROWW[R] = LW[(size_t)e * LCAP + slot]; TOKROW[ent] = R; }
        } else {
            const v4u z = {0u, 0u, 0u, 0u};
#pragma unroll
            for (int j = 0; j < 4; ++j) dst[64 * j] = z;
            if (F.lane == 0) ROWW[R] = 0.f;
        }
    }
}

__device__ __forceinline__ void p6_final(const Frame& F, KArgs a) {
    unsigned char* ws = a->ws; const bf16* YC = (const bf16*)(ws + WS_YC); const int* TOKROW = (const int*)(ws + WS_TOKROW);
    const GAS f32x4* g4 = (const GAS f32x4*)a->in[21] + F.lane;
    for (int t = F.gw; t < T; t += F.NGW) {
        GAS f32x4* xr = (GAS f32x4*)(a->out + (size_t)t * DM) + F.lane;
        const int R0 = TOKROW[2 * t], R1 = TOKROW[2 * t + 1];
        const GAS v2u* y0 = (const GAS v2u*)(YC + (size_t)R0 * DM) + F.lane; const GAS v2u* y1 = (const GAS v2u*)(YC + (size_t)R1 * DM) + F.lane;
        f32x4 v[8]; float s = 0.f;
#pragma unroll
        for (int j = 0; j < 8; ++j) { const f32x4 x = xr[64 * j]; const v2u p = y0[64 * j], q = y1[64 * j];
            v[j].x = x.x + (bflo(p.x) + bflo(q.x)); v[j].y = x.y + (bfhi(p.x) + bfhi(q.x)); v[j].z = x.z + (bflo(p.y) + bflo(q.y)); v[j].w = x.w + (bfhi(p.y) + bfhi(q.y));
            s += (v[j].x * v[j].x + v[j].y * v[j].y) + (v[j].z * v[j].z + v[j].w * v[j].w); }
        const float rstd = 1.0f / sqrtf(wave_sum(s) * (1.0f / DM) + EPS);
#pragma unroll
        for (int j = 0; j < 8; ++j) { const f32x4 g = g4[64 * j]; xr[64 * j] = (f32x4){v[j].x * rstd * g.x, v[j].y * rstd * g.y, v[j].z * rstd * g.z, v[j].w * rstd * g.w}; }
    }
}

__global__ void __launch_bounds__(NWAVES * 64, 2) fwd_kernel(Args args) {
    extern __shared__ __attribute__((aligned(16))) unsigned char lds[];
    Frame F;
    F.lds = lds; F.tid = threadIdx.x; F.lane = F.tid & 63; F.wave = __builtin_amdgcn_readfirstlane(F.tid >> 6);
    F.G = gridDim.x; { const int bx = blockIdx.x; F.vcu = (F.G % 8 == 0) ? (bx % 8) * (F.G / 8) + bx / 8 : bx; }
    F.gw = F.vcu * NWAVES + F.wave; F.NGW = F.G * NWAVES;
    LAS unsigned char* L = (LAS unsigned char*)lds;
    volatile LAS unsigned* MISC = (volatile LAS unsigned*)(L + MISC_OFF);
    for (int u = F.tid; u < (LDS_BYTES - MISC_OFF) / 4; u += NWAVES * 64) ((LAS unsigned*)(L + MISC_OFF))[u] = 0u;
    __syncthreads();
    int lo, hi, li; unsigned* ctl;
    { KArgs a = FRESH_ARGS(); lo = a->ph_lo; hi = a->ph_hi; li = a->li; ctl = (unsigned*)(a->ws + WS_CTL); }
    XcdBarrier bar; bar.bar = ctl + CW_BAR + li * XCD_BAR_WORDS; bar.x = 0; bar.st = nullptr;
    if (hi - lo > 1) bar = xcd_barrier_post(ctl + CW_BAR + li * XCD_BAR_WORDS, MISC + 8);
#ifndef PH_MASK
#define PH_MASK 0x7ff
#endif
#define IN(k) (((PH_MASK >> (k)) & 1) && lo <= (k) && (k) < hi)
#define SEAM(k) do { if (IN(k) && IN((k) + 1)) xcd_barrier(bar); } while (0)

    if (IN(0)) { KArgs a = FRESH_ARGS(); p0_prologue(F, a); } SEAM(0);

    if (IN(1)) {
        KArgs a = FRESH_ARGS(); unsigned char* ws = a->ws;
        pg8::Gemm g{(const pg8::bf16_t*)(ws + WS_XN), (const pg8::bf16_t*)(ws + WS_WIN), T, NCOL1, DM}; pg8::StaticOrder S; S.init(T, NCOL1, F.G, (int)blockIdx.x);
        pg8::EpiP1 E{(pg8::bf16_t*)(ws + WS_QA), (pg8::bf16_t*)(ws + WS_KA), (pg8::bf16_t*)(ws + WS_VA), (pg8::bf16_t*)(ws + WS_QB), (pg8::bf16_t*)(ws + WS_KB), (pg8::bf16_t*)(ws + WS_VB), (pg8::bf16_t*)(ws + WS_GT), a->in[13]};
        pg8::gemm_phase<pg8::EpiP1, pg8::StaticOrder, true, true>(L + SCR_OFF, g, S, E);
    } SEAM(1);

    if (IN(2)) { KArgs a = FRESH_ARGS(); p1b_normrope(F, a); } SEAM(2);

    if (IN(3)) { KArgs a = FRESH_ARGS(); p2_attention(F, a); } SEAM(3);

    if (IN(4)) {
        pg8::StaticOrder S; S.init(T, DM, F.G, (int)blockIdx.x);
        { KArgs a = FRESH_ARGS(); unsigned char* ws = a->ws;
          pg8::Gemm g{(const pg8::bf16_t*)(ws + WS_QA), (const pg8::bf16_t*)(ws + WS_WA), T, DM, 1024};
          pg8::EpiGateA E{(const pg8::bf16_t*)(ws + WS_GT), a->out};
          pg8::gemm_phase<pg8::EpiGateA, pg8::StaticOrder, true, true>(L + SCR_OFF, g, S, E); }
        __syncthreads();
        { KArgs a = FRESH_ARGS(); unsigned char* ws = a->ws;
          pg8::Gemm g{(const pg8::bf16_t*)(ws + WS_QB), (const pg8::bf16_t*)(ws + WS_WB), T, DM, 1024};
          pg8::EpiGateB E{(const pg8::bf16_t*)(ws + WS_GT), a->out, (pg8::bf16_t*)(ws + WS_XN)};
          pg8::gemm_phase<pg8::EpiGateB, pg8::StaticOrder, true, true>(L + SCR_OFF, g, S, E); }
    } SEAM(4);

    if (IN(5)) {
        KArgs a = FRESH_ARGS(); unsigned char* ws = a->ws;
        pg8::Gemm g{(const pg8::bf16_t*)(ws + WS_XN), (const pg8::bf16_t*)(ws + WS_WO), T, DM, DM}; pg8::StaticOrder S; S.init(T, DM, F.G, (int)blockIdx.x);
        pg8::EpiOut E{a->in[0], a->out, (float*)(ws + WS_SSQ)};
        pg8::gemm_phase<pg8::EpiOut, pg8::StaticOrder, true, true>(L + SCR_OFF, g, S, E);
    } SEAM(5);

    if (IN(6)) { KArgs a = FRESH_ARGS(); p4_router(F, a); } SEAM(6);

    if (IN(7)) { KArgs a = FRESH_ARGS(); moe_table(F, a); p4b_gather(F, a); } SEAM(7);

    if (IN(8)) {
        KArgs a = FRESH_ARGS(); unsigned char* ws = a->ws;
        moe_table(F, a);
        pg8::Gemm g{(const pg8::bf16_t*)(ws + WS_XG), (const pg8::bf16_t*)(ws + WS_W13), PMAX * 256, 1024, DM};
        pg8::MoeOrder<4, (long)1024 * 2048 * 2> S{(const LAS int*)(L + MOE_OFF), F.G, (int)blockIdx.x};
        pg8::EpiG1 E{(pg8::bf16_t*)(ws + WS_XN)};
        pg8::gemm_phase<pg8::EpiG1, pg8::MoeOrder<4, (long)1024 * 2048 * 2>, true, true>(L + SCR_OFF, g, S, E);
    } SEAM(8);

    if (IN(9)) {
        KArgs a = FRESH_ARGS(); unsigned char* ws = a->ws;
        moe_table(F, a);
        pg8::Gemm g{(const pg8::bf16_t*)(ws + WS_XN), (const pg8::bf16_t*)(ws + WS_W2), PMAX * 256, DM, FF};
        pg8::MoeOrder<8, (long)2048 * 512 * 2> S{(const LAS int*)(L + MOE_OFF), F.G, (int)blockIdx.x};
        pg8::EpiG2 E{(pg8::bf16_t*)(ws + WS_YC), (const float*)(ws + WS_ROWW)};
        pg8::gemm_phase<pg8::EpiG2, pg8::MoeOrder<8, (long)2048 * 512 * 2>, true, true>(L + SCR_OFF, g, S, E);
    } SEAM(9);

    if (IN(10)) { KArgs a = FRESH_ARGS(); p6_final(F, a); }
#undef IN
#undef SEAM
}

extern "C" void kernel_launch(void* const* d_in, const int* in_sizes, int n_in, void* d_out, int out_size, void* d_ws, size_t ws_size, hipStream_t stream) {
    static int grid = 0;
    if (grid == 0) {
        if (n_in != 22 || in_sizes[0] != T * DM || out_size != T * DM || ws_size < WS_END) { fprintf(stderr, "kernel_launch: shape mismatch (n_in %d, in0 %d, out %d, ws %zu)\n", n_in, n_in > 0 ? in_sizes[0] : -1, out_size, ws_size); grid = -1; return; }
        int dev = 0, cus = 0, per_cu = 0;
        if (hipGetDevice(&dev) != hipSuccess || hipDeviceGetAttribute(&cus, hipDeviceAttributeMultiprocessorCount, dev) != hipSuccess) { grid = -1; return; }
        if (hipFuncSetAttribute((const void*)fwd_kernel, hipFuncAttributeMaxDynamicSharedMemorySize, LDS_BYTES) != hipSuccess) { fprintf(stderr, "kernel_launch: hipFuncSetAttribute failed\n"); grid = -1; return; }
        if (hipOccupancyMaxActiveBlocksPerMultiprocessor(&per_cu, (const void*)fwd_kernel, NWAVES * 64, LDS_BYTES) != hipSuccess || per_cu < 1) fprintf(stderr, "kernel_launch: occupancy query says %d\n", per_cu);
        (void)hipGetLastError();
        grid = cus;
    }
    if (grid < 0) return;
    if (hipMemsetAsync((char*)d_ws + WS_CTL, 0, CTL_ZERO_BYTES, stream) != hipSuccess) return;
    Args a{};
    for (int i = 0; i < 22; ++i) a.in[i] = (const float*)d_in[i];
    a.out = (float*)d_out; a.ws = (unsigned char*)d_ws; a.pad = 0;
#if MK_ONE_LAUNCH
    a.ph_lo = 0; a.ph_hi = N_PHASES; a.li = 0;
    hipLaunchKernelGGL(fwd_kernel, dim3(grid), dim3(NWAVES * 64), LDS_BYTES, stream, a);
#else
    for (int li = 0; li < N_PHASES; ++li) { a.ph_lo = li; a.ph_hi = li + 1; a.li = li;
        hipLaunchKernelGGL(fwd_kernel, dim3(grid), dim3(NWAVES * 64), LDS_BYTES, stream, a); }
#endif
    const hipError_t le = hipPeekAtLastError();
    if (le != hipSuccess) fprintf(stderr, "kernel_launch: launch failed: %s\n", hipGetErrorName(le));
}
```

```cpp
#include <hip/hip_runtime.h>
#include <cstdio>
#include <cstdint>
#include <cmath>

namespace pg8 {
#define PG8_LAS __attribute__((address_space(3)))
typedef unsigned short bf16_t;
typedef short bf16x8 __attribute__((ext_vector_type(8)));
typedef float f32x4 __attribute__((ext_vector_type(4)));
typedef unsigned u32x4 __attribute__((ext_vector_type(4)));
constexpr int BM = 256, BK = 64, HALF = 128, HTB = HALF * BK * 2  , STAGE_BYTES = 8 * HTB, NXCD = 8, WGM = 8;

__host__ __device__ __forceinline__ int lds_byte(int r, int c) { const int st = (r >> 4) * 2 + (c >> 5), rr = r & 15, cc = c & 31, ob = rr * 64 + cc * 2; return st * 1024 + (ob ^ (((ob >> 9) & 1) << 5)); }
__host__ __device__ __forceinline__ void stage_rc(int b, int& R, int& C) { const int st = b / 1024, sb = b % 1024, swz = sb ^ (((sb >> 9) & 1) << 5); R = (st >> 1) * 16 + swz / 64; C = (st & 1) * 32 + (swz % 64) / 2; }
__host__ __device__ __forceinline__ int perm32(int rho) { const int n = rho >> 4, i = rho & 15; return 8 * (i >> 2) + 4 * n + (i & 3); }

struct Unit { int pm, pn; long bofs; };
struct Gemm { const bf16_t* A; const bf16_t* Bt; int M, N, K; };

struct StaticOrder {
    int nM, nN, nwg, G, c;
    __host__ __device__ void init(int M, int N, int G_, int c_) { nM = M / BM; nN = N / BM; nwg = nM * nN; G = G_; c = c_; }
    __host__ __device__ bool next(int i, Unit& u) const {
        const long L = (long)i * G + c; if (L >= nwg) return false;
        int wgid = (int)L; { const int q = nwg / NXCD, r = nwg % NXCD, xcd = wgid % NXCD, off = wgid / NXCD; wgid = (xcd < r ? xcd * (q + 1) : r * (q + 1) + (xcd - r) * q) + off; }
        const int nig = WGM * nN, gid = wgid / nig, fm = gid * WGM, gsz = (nM - fm) < WGM ? (nM - fm) : WGM;
        u.pm = fm + ((wgid % nig) % gsz); u.pn = (wgid % nig) / gsz; u.bofs = 0; return true;
    }
    __device__ __forceinline__ void a_ready(const Unit&) const {}
    __device__ __forceinline__ void done(const Unit&) const {}
};

__device__ __forceinline__ unsigned cvt_pk_bf16(float lo, float hi) { unsigned r; asm volatile("v_cvt_pk_bf16_f32 %0, %1, %2" : "=v"(r) : "v"(lo), "v"(hi)); return r; }
typedef float f32x2 __attribute__((ext_vector_type(2)));

__device__ __forceinline__ float bf_lo(unsigned w) { return __uint_as_float(w << 16); }
__device__ __forceinline__ float bf_hi(unsigned w) { return __uint_as_float(w & 0xffff0000u); }
__device__ __forceinline__ float sigmoid_f(float x) { return __builtin_amdgcn_rcpf(1.0f + __builtin_amdgcn_exp2f(-1.4426950408889634f * x)); }

struct EpiP1 {
    static constexpr bool PERM = true, AFTER_DRAIN = false;
    bf16_t *QA, *KA, *VA, *QB, *KB, *VB, *GT; const float* bgate;
    __device__ __forceinline__ void operator()(const f32x4 (&acc)[2][2][4][2], const Unit& u, int wr, int wc, int fr, int fq) const {
        const int pn = u.pn; bf16_t* base; int ld, colt; bool gate = false;
        if (pn < 4)       { base = QA; ld = 1024; colt = pn * 256; }
        else if (pn == 4) { base = KA; ld = 256;  colt = 0; }
        else if (pn == 5) { base = VA; ld = 256;  colt = 0; }
        else if (pn < 10) { base = QB; ld = 1024; colt = (pn - 6) * 256; }
        else if (pn < 14) { base = KB; ld = 1024; colt = (pn - 10) * 256; }
        else if (pn < 18) { base = VB; ld = 1024; colt = (pn - 14) * 256; }
        else              { base = GT; ld = 4096; colt = (pn - 18) * 256; gate = true; }
        const int row0 = u.pm * BM + wr * 64 + fr, col0 = colt + wc * 32 + 8 * fq;
        f32x4 bv[2][2];
#pragma unroll
        for (int bj = 0; bj < 2; ++bj)
#pragma unroll
            for (int n = 0; n < 2; ++n) bv[bj][n] = gate ? *(const f32x4*)(bgate + col0 + bj * HALF + 4 * n) : (f32x4){0.f, 0.f, 0.f, 0.f};
#pragma unroll
        for (int ai = 0; ai < 2; ++ai)
#pragma unroll
            for (int m = 0; m < 4; ++m) { bf16_t* rowp = base + (size_t)(row0 + ai * HALF + m * 16) * ld + col0;
#pragma unroll
                for (int bj = 0; bj < 2; ++bj) { f32x4 v0 = acc[ai][bj][m][0] + bv[bj][0], v1 = acc[ai][bj][m][1] + bv[bj][1];
                    if (gate) {
#pragma unroll
                        for (int e = 0; e < 4; ++e) { v0[e] = sigmoid_f(v0[e]); v1[e] = sigmoid_f(v1[e]); } }
                    u32x4 w; w.x = cvt_pk_bf16(v0[0], v0[1]); w.y = cvt_pk_bf16(v0[2], v0[3]); w.z = cvt_pk_bf16(v1[0], v1[1]); w.w = cvt_pk_bf16(v1[2], v1[3]);
                    *(u32x4*)(rowp + bj * HALF) = w; } }
    }
};

struct EpiGateA {
    static constexpr bool PERM = true, AFTER_DRAIN = false;
    const bf16_t* GT; float* MA;
    __device__ __forceinline__ void operator()(const f32x4 (&acc)[2][2][4][2], const Unit& u, int wr, int wc, int fr, int fq) const {
        const int row0 = u.pm * BM + wr * 64 + fr, col0 = u.pn * BM + wc * 32 + 8 * fq;
#pragma unroll
        for (int ai = 0; ai < 2; ++ai)
#pragma unroll
            for (int m = 0; m < 4; ++m) { const size_t r = (size_t)(row0 + ai * HALF + m * 16);
#pragma unroll
                for (int bj = 0; bj < 2; ++bj) { const u32x4 g = *(const u32x4*)(GT + r * 4096 + col0 + bj * HALF);
                    f32x4 v0 = acc[ai][bj][m][0], v1 = acc[ai][bj][m][1];
                    v0[0] *= bf_lo(g.x); v0[1] *= bf_hi(g.x); v0[2] *= bf_lo(g.y); v0[3] *= bf_hi(g.y);
                    v1[0] *= bf_lo(g.z); v1[1] *= bf_hi(g.z); v1[2] *= bf_lo(g.w); v1[3] *= bf_hi(g.w);
                    float* o = MA + r * 2048 + col0 + bj * HALF; *(f32x4*)o = v0; *(f32x4*)(o + 4) = v1; }
                if (m & 1) asm volatile("" ::: "memory"); }
    }
};
struct EpiGateB {
    static constexpr bool PERM = true, AFTER_DRAIN = false;
    const bf16_t* GT; const float* MA; bf16_t* MG;
    __device__ __forceinline__ void operator()(const f32x4 (&acc)[2][2][4][2], const Unit& u, int wr, int wc, int fr, int fq) const {
        const int row0 = u.pm * BM + wr * 64 + fr, col0 = u.pn * BM + wc * 32 + 8 * fq;
#pragma unroll
        for (int ai = 0; ai < 2; ++ai)
#pragma unroll
            for (int m = 0; m < 4; ++m) { const size_t r = (size_t)(row0 + ai * HALF + m * 16);
#pragma unroll
                for (int bj = 0; bj < 2; ++bj) { const u32x4 g = *(const u32x4*)(GT + r * 4096 + 2048 + col0 + bj * HALF);
                    const float* mp = MA + r * 2048 + col0 + bj * HALF; const f32x4 a0 = *(const f32x4*)mp, a1 = *(const f32x4*)(mp + 4);
                    f32x4 v0 = acc[ai][bj][m][0], v1 = acc[ai][bj][m][1];
                    v0[0] = a0[0] + v0[0] * bf_lo(g.x); v0[1] = a0[1] + v0[1] * bf_hi(g.x); v0[2] = a0[2] + v0[2] * bf_lo(g.y); v0[3] = a0[3] + v0[3] * bf_hi(g.y);
                    v1[0] = a1[0] + v1[0] * bf_lo(g.z); v1[1] = a1[1] + v1[1] * bf_hi(g.z); v1[2] = a1[2] + v1[2] * bf_lo(g.w); v1[3] = a1[3] + v1[3] * bf_hi(g.w);
                    u32x4 w; w.x = cvt_pk_bf16(v0[0], v0[1]); w.y = cvt_pk_bf16(v0[2], v0[3]); w.z = cvt_pk_bf16(v1[0], v1[1]); w.w = cvt_pk_bf16(v1[2], v1[3]);
                    *(u32x4*)(MG + r * 2048 + col0 + bj * HALF) = w; }
                if (m & 1) asm volatile("" ::: "memory"); }
    }
};
struct EpiOut {
    static constexpr bool PERM = false, AFTER_DRAIN = false;
    const float* X; float* X1; float* SSQ;
    __device__ __forceinline__ void operator()(const f32x4 (&acc)[2][2][4][2], const Unit& u, int wr, int wc, int fr, int fq) const {
        const int row0 = u.pm * BM + wr * 64 + fr, col0 = u.pn * BM + wc * 32 + 4 * fq;
#pragma unroll
        for (int ai = 0; ai < 2; ++ai)
#pragma unroll
            for (int m = 0; m < 4; ++m) { const size_t r = (size_t)(row0 + ai * HALF + m * 16); float s = 0.f;
#pragma unroll
                for (int bj = 0; bj < 2; ++bj)
#pragma unroll
                    for (int n = 0; n < 2; ++n) { const size_t off = r * 2048 + col0 + bj * HALF + n * 16;
                        const f32x4 v = *(const f32x4*)(X + off) + acc[ai][bj][m][n]; *(f32x4*)(X1 + off) = v;
                        s += (v[0] * v[0] + v[1] * v[1]) + (v[2] * v[2] + v[3] * v[3]); }
                s += __shfl_xor(s, 16); s += __shfl_xor(s, 32);
                if (fq == 0) SSQ[r * 32 + u.pn * 4 + wc] = s;
                if (m & 1) asm volatile("" ::: "memory"); }
    }
};
struct EpiG1 {
    static constexpr bool PERM = true, AFTER_DRAIN = false;
    bf16_t* U;
    __device__ __forceinline__ void operator()(const f32x4 (&acc)[2][2][4][2], const Unit& u, int wr, int wc, int fr, int fq) const {
        const int row0 = u.pm * BM + wr * 64 + fr, col0 = u.pn * HALF + wc * 32 + 8 * fq;
#pragma unroll
        for (int ai = 0; ai < 2; ++ai)
#pragma unroll
            for (int m = 0; m < 4; ++m) { f32x4 v0, v1;
#pragma unroll
                for (int e = 0; e < 4; ++e) { const float g0 = acc[ai][0][m][0][e], g1 = acc[ai][0][m][1][e];
                    v0[e] = g0 * sigmoid_f(g0) * acc[ai][1][m][0][e]; v1[e] = g1 * sigmoid_f(g1) * acc[ai][1][m][1][e]; }
                u32x4 w; w.x = cvt_pk_bf16(v0[0], v0[1]); w.y = cvt_pk_bf16(v0[2], v0[3]); w.z = cvt_pk_bf16(v1[0], v1[1]); w.w = cvt_pk_bf16(v1[2], v1[3]);
                *(u32x4*)(U + (size_t)(row0 + ai * HALF + m * 16) * 512 + col0) = w; }
    }
};
struct EpiG2 {
    static constexpr bool PERM = true, AFTER_DRAIN = false;
    bf16_t* YC; const float* ROWW;
    __device__ __forceinline__ void operator()(const f32x4 (&acc)[2][2][4][2], const Unit& u, int wr, int wc, int fr, int fq) const {
        const int row0 = u.pm * BM + wr * 64 + fr, col0 = u.pn * BM + wc * 32 + 8 * fq;
#pragma unroll
        for (int ai = 0; ai < 2; ++ai)
#pragma unroll
            for (int m = 0; m < 4; ++m) { const size_t r = (size_t)(row0 + ai * HALF + m * 16); const float wt = ROWW[r];
#pragma unroll
                for (int bj = 0; bj < 2; ++bj) { const f32x4 v0 = acc[ai][bj][m][0] * wt, v1 = acc[ai][bj][m][1] * wt;
                    u32x4 w; w.x = cvt_pk_bf16(v0[0], v0[1]); w.y = cvt_pk_bf16(v0[2], v0[3]); w.z = cvt_pk_bf16(v1[0], v1[1]); w.w = cvt_pk_bf16(v1[2], v1[3]);
                    *(u32x4*)(YC + r * 2048 + col0 + bj * HALF) = w; } }
    }
};
template <int NT, long BSTRIDE  > struct MoeOrder {
    const PG8_LAS int* tab; int G, c;
    __device__ __forceinline__ bool next(int i, Unit& u) const {
        const int P = tab[64]; const long L = (long)i * G + c; if (L >= (long)P * NT) return false;
        const int p = (int)(L / NT); int e = 0;
#pragma unroll 1
        for (int k = 1; k < 32; ++k) if (tab[32 + k] <= p) e = k;
        u.pm = p; u.pn = (int)(L % NT); u.bofs = (long)e * BSTRIDE; return true;
    }
    __device__ __forceinline__ void a_ready(const Unit&) const {}
    __device__ __forceinline__ void done(const Unit&) const {}
};

template <class Epi, class Sched, bool ALIGN_EPI = false, bool SP2 = false>
__device__ __forceinline__ void gemm_phase(PG8_LAS unsigned char* lds, const Gemm g, const Sched& S, const Epi& E) {
    const int tid = threadIdx.x, wid = __builtin_amdgcn_readfirstlane(tid >> 6), lane = tid & 63, wr = wid >> 2, wc = wid & 3, fr = lane & 15, fq = lane >> 4;
    const int K = g.K, nt = K / BK;
    unsigned voffA[2], voffB[2];
#pragma unroll
    for (int i = 0; i < 2; ++i) { int R, C; stage_rc(tid * 16 + i * 8192, R, C); const int Rb = Epi::PERM ? ((R & ~31) + perm32(R & 31)) : R;
        voffA[i] = (unsigned)(R * K + C) * 2u; voffB[i] = (unsigned)(Rb * K + C) * 2u; }
    const size_t kstep = (size_t)(BK * 2);
    const size_t hstep = (size_t)HALF * K * 2;
    const size_t tstep = 2 * hstep;
    const unsigned ldsw = (unsigned)wid * 1024u;
    const int aoff = lds_byte(wr * 64 + fr, fq * 8), boff = lds_byte(wc * 32 + fr, fq * 8);
#define PG8_SA(b, h) (((b) * 2 + (h)) * HTB)
#define PG8_SB(b, h) ((4 + (b) * 2 + (h)) * HTB)
#define PG8_STAGE(bufoff, gbase, voff) do { _Pragma("unroll") for (int _i = 0; _i < 2; ++_i) \
        __builtin_amdgcn_global_load_lds((const unsigned*)((const char*)(gbase) + (voff)[_i]), (PG8_LAS unsigned*)(lds + (bufoff) + ldsw + _i * 8192), 16, 0, 0); } while (0)
#define PG8_LDA(dst, b, h) do { _Pragma("unroll") for (int m = 0; m < 4; ++m) _Pragma("unroll") for (int k = 0; k < 2; ++k) dst[m][k] = *(const PG8_LAS bf16x8*)(lds + PG8_SA(b, h) + aoff + m * 2048 + k * 1024); } while (0)
#define PG8_LDB(dst, b, h) do { _Pragma("unroll") for (int n = 0; n < 2; ++n) _Pragma("unroll") for (int k = 0; k < 2; ++k) dst[n][k] = *(const PG8_LAS bf16x8*)(lds + PG8_SB(b, h) + boff + n * 2048 + k * 1024); } while (0)
#define PG8_MMA(ai, bj, At, Bt) do { __builtin_amdgcn_s_setprio(1); _Pragma("unroll") for (int m = 0; m < 4; ++m) _Pragma("unroll") for (int n = 0; n < 2; ++n) _Pragma("unroll") for (int k = 0; k < 2; ++k) \
        acc[ai][bj][m][n] = __builtin_amdgcn_mfma_f32_16x16x32_bf16(Bt[n][k], At[m][k], acc[ai][bj][m][n], 0, 0, 0); __builtin_amdgcn_s_setprio(0); } while (0)
#define PG8_WAIT_V(n) asm volatile("s_waitcnt vmcnt(" #n ")" ::: "memory")
#define PG8_WAIT_L(n) asm volatile("s_waitcnt lgkmcnt(" #n ")" ::: "memory")
#define PG8_BAR __builtin_amdgcn_s_barrier()
#define PG8_SCHED __builtin_amdgcn_sched_barrier(0)
    Unit cur, nxt; int ui = 0;
    if (!S.next(0, cur)) return;
    f32x4 acc[2][2][4][2];
#pragma unroll
    for (int a = 0; a < 2; ++a)
#pragma unroll
        for (int b = 0; b < 2; ++b)
#pragma unroll
            for (int m = 0; m < 4; ++m)
#pragma unroll
                for (int n = 0; n < 2; ++n) acc[a][b][m][n] = (f32x4){0.f, 0.f, 0.f, 0.f};
    bf16x8 At[4][2], B0[2][2], B1[2][2];
    const char* cA = (const char*)g.A + (size_t)cur.pm * tstep; const char* cB = (const char*)g.Bt + (size_t)cur.pn * tstep + cur.bofs;
    S.a_ready(cur);
    if constexpr (SP2) {
        PG8_STAGE(PG8_SB(0, 0), cB, voffB); PG8_STAGE(PG8_SB(0, 1), cB + hstep, voffB); PG8_STAGE(PG8_SA(0, 0), cA, voffA); PG8_STAGE(PG8_SA(0, 1), cA + hstep, voffA);
        if (wr == 1) PG8_BAR;
        PG8_WAIT_V(2); PG8_BAR;
        PG8_STAGE(PG8_SB(1, 0), cB + kstep, voffB); PG8_STAGE(PG8_SA(1, 0), cA + kstep, voffA); PG8_STAGE(PG8_SB(1, 1), cB + hstep + kstep, voffB);
        PG8_WAIT_V(6); PG8_BAR;
    } else {
        PG8_STAGE(PG8_SB(0, 0), cB, voffB); PG8_STAGE(PG8_SA(0, 0), cA, voffA); PG8_STAGE(PG8_SB(0, 1), cB + hstep, voffB); PG8_STAGE(PG8_SA(0, 1), cA + hstep, voffA);
        if (wr == 1) PG8_BAR;
        PG8_WAIT_V(4); PG8_BAR;
        PG8_STAGE(PG8_SB(1, 0), cB + kstep, voffB); PG8_STAGE(PG8_SA(1, 0), cA + kstep, voffA); PG8_STAGE(PG8_SB(1, 1), cB + hstep + kstep, voffB);
        PG8_WAIT_V(6); PG8_BAR;
    }
    for (;;) {
        const bool has_next = S.next(ui + 1, nxt);
        const char* nA = has_next ? (const char*)g.A + (size_t)nxt.pm * tstep : cA; const char* nB = has_next ? (const char*)g.Bt + (size_t)nxt.pn * tstep + nxt.bofs : cB;
        for (int t = 0; t < nt; t += 2) {
            const bool last = (t == nt - 2);
            const char* a1 = cA + (size_t)(t + 1) * kstep;
            const char* a2 = last ? nA : cA + (size_t)(t + 2) * kstep; const char* b2 = last ? nB : cB + (size_t)(t + 2) * kstep;
            const char* a3 = a2 + kstep; const char* b3 = b2 + kstep;
            if (last && has_next) S.a_ready(nxt);
            if constexpr (SP2) {
            PG8_LDB(B0, 0, 0); PG8_LDB(B1, 0, 1); PG8_SCHED; PG8_LDA(At, 0, 0); PG8_STAGE(PG8_SA(1, 1), a1 + hstep, voffA);
            PG8_WAIT_V(8); PG8_WAIT_L(0); PG8_BAR; PG8_MMA(0, 0, At, B0); PG8_MMA(0, 1, At, B1); PG8_BAR; PG8_SCHED;
            PG8_LDA(At, 0, 1); PG8_STAGE(PG8_SB(0, 0), b2, voffB); PG8_STAGE(PG8_SB(0, 1), b2 + hstep, voffB); PG8_STAGE(PG8_SA(0, 0), a2, voffA);
            PG8_WAIT_V(8); PG8_WAIT_L(0); PG8_BAR; PG8_MMA(1, 0, At, B0); PG8_MMA(1, 1, At, B1); PG8_BAR; PG8_SCHED;
            PG8_LDB(B0, 1, 0); PG8_LDB(B1, 1, 1); PG8_SCHED; PG8_LDA(At, 1, 0); PG8_STAGE(PG8_SA(0, 1), a2 + hstep, voffA);
            PG8_WAIT_V(8); PG8_WAIT_L(0); PG8_BAR; PG8_MMA(0, 0, At, B0); PG8_MMA(0, 1, At, B1); PG8_BAR; PG8_SCHED;
            PG8_LDA(At, 1, 1); PG8_STAGE(PG8_SB(1, 0), b3, voffB); PG8_STAGE(PG8_SB(1, 1), b3 + hstep, voffB); PG8_STAGE(PG8_SA(1, 0), a3, voffA);
            PG8_WAIT_V(8); PG8_WAIT_L(0); PG8_BAR; PG8_MMA(1, 0, At, B0); PG8_MMA(1, 1, At, B1); PG8_BAR; PG8_SCHED;
            } else {
            PG8_LDB(B0, 0, 0); PG8_SCHED; PG8_LDA(At, 0, 0); PG8_STAGE(PG8_SA(1, 1), a1 + hstep, voffA);
            PG8_WAIT_L(8); PG8_BAR; PG8_WAIT_L(0); PG8_MMA(0, 0, At, B0); PG8_BAR; PG8_SCHED;
            PG8_LDB(B1, 0, 1); PG8_STAGE(PG8_SB(0, 0), b2, voffB);
            PG8_BAR; PG8_WAIT_L(0); PG8_MMA(0, 1, At, B1); PG8_BAR;
            PG8_LDA(At, 0, 1); PG8_STAGE(PG8_SA(0, 0), a2, voffA);
            PG8_BAR; PG8_WAIT_L(0); PG8_MMA(1, 0, At, B0); PG8_BAR; PG8_SCHED;
            PG8_STAGE(PG8_SB(0, 1), b2 + hstep, voffB);
            PG8_WAIT_V(6); PG8_BAR; PG8_MMA(1, 1, At, B1); PG8_BAR;
            PG8_LDB(B0, 1, 0); PG8_SCHED; PG8_LDA(At, 1, 0); PG8_STAGE(PG8_SA(0, 1), a2 + hstep, voffA);
            PG8_WAIT_L(8); PG8_BAR; PG8_WAIT_L(0); PG8_MMA(0, 0, At, B0); PG8_BAR; PG8_SCHED;
            PG8_LDB(B1, 1, 1); PG8_STAGE(PG8_SB(1, 0), b3, voffB);
            PG8_BAR; PG8_WAIT_L(0); PG8_MMA(0, 1, At, B1); PG8_BAR;
            PG8_LDA(At, 1, 1); PG8_STAGE(PG8_SA(1, 0), a3, voffA);
            PG8_BAR; PG8_WAIT_L(0); PG8_MMA(1, 0, At, B0); PG8_BAR; PG8_SCHED;
            PG8_STAGE(PG8_SB(1, 1), b3 + hstep, voffB);
            PG8_WAIT_V(6); PG8_BAR; PG8_MMA(1, 1, At, B1); PG8_BAR;
            }
        }
        if constexpr (ALIGN_EPI) { if (wr == 0) PG8_BAR; }
        if constexpr (!Epi::AFTER_DRAIN) { E(acc, cur, wr, wc, fr, fq); S.done(cur); }
        if (!has_next) break;
#pragma unroll
        for (int a = 0; a < 2; ++a)
#pragma unroll
            for (int b = 0; b < 2; ++b)
#pragma unroll
                for (int m = 0; m < 4; ++m)
#pragma unroll
                    for (int n = 0; n < 2; ++n) acc[a][b][m][n] = (f32x4){0.f, 0.f, 0.f, 0.f};
        cur = nxt; cA = nA; cB = nB; ++ui;
        if constexpr (ALIGN_EPI) { if (wr == 1) PG8_BAR; }
    }
    PG8_WAIT_V(0);
    if constexpr (!ALIGN_EPI) { if (wr == 0) PG8_BAR; }
    PG8_BAR;
    if constexpr (Epi::AFTER_DRAIN) { E.fused(acc, cur, wr, wc, fr, fq, lds, wid, lane); S.done(cur); }
#undef PG8_SA
#undef PG8_SB
#undef PG8_STAGE
#undef PG8_LDA
#undef PG8_LDB
#undef PG8_MMA
#undef PG8_WAIT_V
#undef PG8_WAIT_L
#undef PG8_BAR
#undef PG8_SCHED
}
}

namespace att {
typedef unsigned short bf16;
using bf16x8 = __attribute__((ext_vector_type(8))) short;
using s16x4  = __attribute__((ext_vector_type(4))) short;
using f32x16 = __attribute__((ext_vector_type(16))) float;
using u32x4  = __attribute__((ext_vector_type(4))) unsigned;
constexpr int NW = 8, QBLK = 32, KVBLK = 64, DV = 128;
constexpr int SHM_V = KVBLK * DV * 2;
constexpr int OFF_V = 0, OFF_K = 3 * SHM_V, OFF_STASH = 73728;
constexpr float THR = 8.f;
#define ATT_SBAR() __builtin_amdgcn_sched_barrier(0)
template <int DQK> __device__ __forceinline__ int kswz(int row, int colB) { return row * (DQK * 2) + (colB ^ ((DQK == 128 ? ((row & 7) | (((row >> 4) & 1) << 3)) : ((row >> 1) & 7)) << 4)); }
__device__ __forceinline__ int crow(int r, int hi) { return (r & 3) + 8 * (r >> 2) + 4 * hi; }
__device__ __forceinline__ unsigned cvtpk(float lo, float hi) { unsigned r; asm volatile("v_cvt_pk_bf16_f32 %0, %1, %2" : "=v"(r) : "v"(lo), "v"(hi)); return r; }

template <int DQK> __device__ __forceinline__ void partialSM(f32x16& p0, f32x16& p1, float& m_reg, float& mn, float& alpha) {
  constexpr float SCALE = (DQK == 128) ? 0.088388347648318440f : 0.125f;
  constexpr float C = SCALE * 1.4426950408889634f;
  float pmax = p0[0];
#pragma unroll
  for (int r = 1; r < 16; ++r) pmax = fmaxf(pmax, p0[r]);
#pragma unroll
  for (int r = 0; r < 16; ++r) pmax = fmaxf(pmax, p1[r]);
  { auto rr = __builtin_amdgcn_permlane32_swap(__float_as_uint(pmax), __float_as_uint(pmax), false, false);
    pmax = fmaxf(__uint_as_float(rr[0]), __uint_as_float(rr[1])); }
  if (__builtin_expect(__all(pmax - m_reg <= THR / SCALE), 1)) { mn = m_reg; alpha = 1.f; }
  else { mn = fmaxf(m_reg, pmax); alpha = __builtin_amdgcn_exp2f((m_reg - mn) * C); m_reg = mn; }
  const float mnC = -mn * C;
#pragma unroll
  for (int r = 0; r < 16; ++r) p0[r] = fmaf(p0[r], C, mnC);
#pragma unroll
  for (int r = 0; r < 16; ++r) p1[r] = fmaf(p1[r], C, mnC);
#pragma unroll
  for (int r = 0; r < 16; ++r) p0[r] = __builtin_amdgcn_exp2f(p0[r]);
}
__device__ __forceinline__ void finishSM(f32x16& p0, f32x16& p1, float alpha, float& l_reg, bf16x8& pa0, bf16x8& pa1, bf16x8& pa2, bf16x8& pa3) {
#pragma unroll
  for (int r = 0; r < 16; ++r) p1[r] = __builtin_amdgcn_exp2f(p1[r]);
  float ps = 0;
#pragma unroll
  for (int r = 0; r < 16; ++r) ps += p0[r];
#pragma unroll
  for (int r = 0; r < 16; ++r) ps += p1[r];
  { auto rr = __builtin_amdgcn_permlane32_swap(__float_as_uint(ps), __float_as_uint(ps), false, false);
    ps = __uint_as_float(rr[0]) + __uint_as_float(rr[1]); }
  l_reg = l_reg * alpha + ps;
#define ATT_PK4(P, BASE, OUT) do { unsigned a0 = cvtpk(P[BASE + 0], P[BASE + 1]), a1 = cvtpk(P[BASE + 2], P[BASE + 3]);   \
    unsigned b0 = cvtpk(P[BASE + 4], P[BASE + 5]), b1 = cvtpk(P[BASE + 6], P[BASE + 7]);                              \
    auto r0 = __builtin_amdgcn_permlane32_swap(a0, b0, false, false); auto r1 = __builtin_amdgcn_permlane32_swap(a1, b1, false, false); \
    u32x4 w = {r0[0], r1[0], r0[1], r1[1]}; OUT = *reinterpret_cast<bf16x8*>(&w); } while (0)
  ATT_PK4(p0, 0, pa0); ATT_PK4(p0, 8, pa1); ATT_PK4(p1, 0, pa2); ATT_PK4(p1, 8, pa3);
#undef ATT_PK4
}
template <int DQK> __device__ __forceinline__ void qkt(f32x16& p0, f32x16& p1, const char* Ks, const bf16x8* qr, int r32, int hi) {
  p0 = f32x16{}; p1 = f32x16{};
#pragma unroll
  for (int d0 = 0; d0 < DQK / 16; ++d0) { const int cb = (d0 * 16 + hi * 8) * 2;
    const bf16x8 b0 = *reinterpret_cast<const bf16x8*>(Ks + kswz<DQK>(r32, cb));
    const bf16x8 b1 = *reinterpret_cast<const bf16x8*>(Ks + kswz<DQK>(32 + r32, cb));
    p0 = __builtin_amdgcn_mfma_f32_32x32x16_bf16(b0, qr[d0], p0, 0, 0, 0);
    p1 = __builtin_amdgcn_mfma_f32_32x32x16_bf16(b1, qr[d0], p1, 0, 0, 0); }
}
__device__ __forceinline__ int v_st(int k, int c) { const int kk = (k & ~0xC) | ((k & 4) << 1) | ((k & 8) >> 1); return ((kk >> 3) * 4 + (c >> 5)) * 512 + ((kk & 7) * 32 + (c & 31)) * 2; }
__device__ __forceinline__ int v_rd_base(int lane) { return ((lane & 3) << 3) | (((lane >> 2) & 3) << 6) | (((lane >> 4) & 1) << 5) | (((lane >> 5) & 1) << 8); }
constexpr int v_rd_off(int d0, int ks, int half) { return d0 * 512 + ks * 4096 + half * 2048; }
template <int OFF> __device__ __forceinline__ s16x4 tr_read(int vb) {
  s16x4 r; asm volatile("ds_read_b64_tr_b16 %0, %1 offset:%2" : "=&v"(r) : "v"(vb), "i"(OFF) : "memory"); return r;
}
typedef __attribute__((address_space(3))) const char* lds_cptr;
typedef short v4i16_t __attribute__((ext_vector_type(4)));
__device__ __forceinline__ s16x4 vtr(lds_cptr p) { return __builtin_bit_cast(s16x4, __builtin_amdgcn_ds_read_tr16_b64_v4i16((__attribute__((address_space(3))) v4i16_t*)p)); }
template <int D0> __device__ __forceinline__ void pv_one(f32x16& od, int vb, bf16x8 pa0, bf16x8 pa1, bf16x8 pa2, bf16x8 pa3) {
  const s16x4 l0 = tr_read<v_rd_off(D0, 0, 0)>(vb), h0 = tr_read<v_rd_off(D0, 0, 1)>(vb), l1 = tr_read<v_rd_off(D0, 1, 0)>(vb), h1 = tr_read<v_rd_off(D0, 1, 1)>(vb);
  const s16x4 l2 = tr_read<v_rd_off(D0, 2, 0)>(vb), h2 = tr_read<v_rd_off(D0, 2, 1)>(vb), l3 = tr_read<v_rd_off(D0, 3, 0)>(vb), h3 = tr_read<v_rd_off(D0, 3, 1)>(vb);
  asm volatile("s_waitcnt lgkmcnt(0)" ::: "memory"); ATT_SBAR();
#define ATT_PK(L, H) (bf16x8){L[0], L[1], L[2], L[3], H[0], H[1], H[2], H[3]}
  od = __builtin_amdgcn_mfma_f32_32x32x16_bf16(pa0, ATT_PK(l0, h0), od, 0, 0, 0);
  od = __builtin_amdgcn_mfma_f32_32x32x16_bf16(pa1, ATT_PK(l1, h1), od, 0, 0, 0);
  od = __builtin_amdgcn_mfma_f32_32x32x16_bf16(pa2, ATT_PK(l2, h2), od, 0, 0, 0);
  od = __builtin_amdgcn_mfma_f32_32x32x16_bf16(pa3, ATT_PK(l3, h3), od, 0, 0, 0);
#undef ATT_PK
}
__device__ __forceinline__ void pv_d0(f32x16* o, int vb, bf16x8 pa0, bf16x8 pa1, bf16x8 pa2, bf16x8 pa3) {
  pv_one<0>(o[0], vb, pa0, pa1, pa2, pa3); pv_one<1>(o[1], vb, pa0, pa1, pa2, pa3); pv_one<2>(o[2], vb, pa0, pa1, pa2, pa3); pv_one<3>(o[3], vb, pa0, pa1, pa2, pa3);
}

template <int DQK> __device__ __forceinline__ void softmax_tile(f32x16& p0, f32x16& p1, float& m_reg, float& l_reg, float& alpha, bf16x8& pa0, bf16x8& pa1, bf16x8& pa2, bf16x8& pa3) {
  constexpr float SCALE = (DQK == 128) ? 0.088388347648318440f : 0.125f;
  constexpr float C = SCALE * 1.4426950408889634f;
  float pmax = p0[0];
#pragma unroll
  for (int r = 1; r < 16; ++r) pmax = fmaxf(pmax, p0[r]);
#pragma unroll
  for (int r = 0; r < 16; ++r) pmax = fmaxf(pmax, p1[r]);
  { auto rr = __builtin_amdgcn_permlane32_swap(__float_as_uint(pmax), __float_as_uint(pmax), false, false);
    pmax = fmaxf(__uint_as_float(rr[0]), __uint_as_float(rr[1])); }
  float mn;
  if (__builtin_expect(__all(pmax - m_reg <= THR / SCALE), 1)) { mn = m_reg; alpha = 1.f; }
  else { mn = fmaxf(m_reg, pmax); alpha = __builtin_amdgcn_exp2f((m_reg - mn) * C); m_reg = mn; }
  const float mnC = -mn * C;
#pragma unroll
  for (int r = 0; r < 16; ++r) { p0[r] = __builtin_amdgcn_exp2f(fmaf(p0[r], C, mnC)); p1[r] = __builtin_amdgcn_exp2f(fmaf(p1[r], C, mnC)); }
  float ps = 0;
#pragma unroll
  for (int r = 0; r < 16; ++r) ps += p0[r];
#pragma unroll
  for (int r = 0; r < 16; ++r) ps += p1[r];
  { auto rr = __builtin_amdgcn_permlane32_swap(__float_as_uint(ps), __float_as_uint(ps), false, false);
    ps = __uint_as_float(rr[0]) + __uint_as_float(rr[1]); }
  l_reg = l_reg * alpha + ps;
#define ATT_PK4(P, BASE, OUT) do { unsigned a0 = cvtpk(P[BASE + 0], P[BASE + 1]), a1 = cvtpk(P[BASE + 2], P[BASE + 3]);   \
    unsigned b0 = cvtpk(P[BASE + 4], P[BASE + 5]), b1 = cvtpk(P[BASE + 6], P[BASE + 7]);                              \
    auto r0 = __builtin_amdgcn_permlane32_swap(a0, b0, false, false); auto r1 = __builtin_amdgcn_permlane32_swap(a1, b1, false, false); \
    u32x4 w = {r0[0], r1[0], r0[1], r1[1]}; OUT = *reinterpret_cast<bf16x8*>(&w); } while (0)
  ATT_PK4(p0, 0, pa0); ATT_PK4(p0, 8, pa1); ATT_PK4(p1, 0, pa2); ATT_PK4(p1, 8, pa3);
#undef ATT_PK4
}

template <int DQK, int LDQ, int LDK, int LDV, int ABL = 0>
__device__ __forceinline__ void attn_pass(const bf16* __restrict__ Qb, const bf16* __restrict__ Kh, const bf16* __restrict__ Vh, int seq, char* lds, float* wsf, f32x16 (&o)[4], float& l_out) {
  constexpr int SHM_K = KVBLK * DQK * 2;
  int tid_ = threadIdx.x; asm volatile("" : "+v"(tid_));
  const int tid = tid_, lane = tid & 63, r32 = lane & 31, hi = lane >> 5;
  const int wid = __builtin_amdgcn_readfirstlane(tid >> 6), grp = wid >> 2;
  char* V_lds = lds + OFF_V; char* K_lds = lds + OFF_K;
  float* al_l = wsf + 32;
  float m_reg = -1e30f, l_reg = 0;
#pragma unroll
  for (int d = 0; d < 4; ++d) o[d] = f32x16{};
  bf16x8 qr[DQK / 16];
  const bf16* Qw = Qb + (long)(wid * QBLK + r32) * LDQ + hi * 8;
#pragma unroll
  for (int d0 = 0; d0 < DQK / 16; ++d0) qr[d0] = *reinterpret_cast<const bf16x8*>(Qw + d0 * 16);
  const int sr = tid >> 4, sc = (tid & 15) * 8, vst0 = v_st(sr, sc), vst1 = v_st(32 + sr, sc);
  const int kr = (DQK == 128) ? sr : (tid >> 3), kc = (DQK == 128) ? sc : (tid & 7) * 8;
  const int vb0 = (int)(uintptr_t)V_lds + v_rd_base(lane);
  bf16x8 sv0, sv1, sk0, sk1;
  const bf16* kp = Kh + (long)kr * LDK + kc; const bf16* vp = Vh + (long)sr * LDV + sc;
#define ATT_LOAD_K(t) do { sk0 = *reinterpret_cast<const bf16x8*>(kp + (long)(t) * (KVBLK * LDK)); if constexpr (DQK == 128) sk1 = *reinterpret_cast<const bf16x8*>(kp + (long)(t) * (KVBLK * LDK) + 32 * LDK); } while (0)
#define ATT_LOAD_V(t) do { sv0 = *reinterpret_cast<const bf16x8*>(vp + (long)(t) * (KVBLK * LDV)); sv1 = *reinterpret_cast<const bf16x8*>(vp + (long)(t) * (KVBLK * LDV) + 32 * LDV); } while (0)
#define ATT_WRITE_K(so) do { *(bf16x8*)(K_lds + (so) + kswz<DQK>(kr, kc * 2)) = sk0; if constexpr (DQK == 128) *(bf16x8*)(K_lds + (so) + kswz<DQK>(32 + kr, kc * 2)) = sk1; } while (0)
#define ATT_WRITE_V(so) do { *(bf16x8*)(V_lds + (so) + vst0) = sv0; *(bf16x8*)(V_lds + (so) + vst1) = sv1; } while (0)
#define ATT_BAR() do { ATT_SBAR(); asm volatile("s_barrier" ::: "memory"); ATT_SBAR(); } while (0)
#define ATT_RESC(a) do { if (__any((a) < 1.f)) { if (hi == 0) al_l[r32] = (a); asm volatile("s_waitcnt lgkmcnt(0)" ::: "memory"); \
    _Pragma("unroll") for (int d = 0; d < 4; ++d) _Pragma("unroll") for (int r = 0; r < 16; ++r) o[d][r] *= al_l[crow(r, hi)]; } } while (0)
  const int NT = seq / KVBLK;
  f32x16 p0, p1; float alpha; bf16x8 pa0, pa1, pa2, pa3;
  ATT_LOAD_K(0); ATT_LOAD_V(0); ATT_WRITE_K(0); ATT_WRITE_V(0);
  ATT_LOAD_K(1); ATT_WRITE_K(SHM_K);
  ATT_LOAD_K(2); ATT_LOAD_V(1);
  asm volatile("s_waitcnt lgkmcnt(0)" ::: "memory"); ATT_BAR();
  if (grp == 1) ATT_BAR();
  qkt<DQK>(p0, p1, K_lds, qr, r32, hi);
  ATT_BAR();
  int k1 = SHM_K, k2 = 2 * SHM_K, k0 = 0, v0 = 0, v1 = SHM_V, v2 = 2 * SHM_V;
  const lds_cptr kq0 = (lds_cptr)K_lds, vq0 = (lds_cptr)V_lds + v_rd_base(lane);
  constexpr int KPRE = DQK / 32;
  bf16x8 kf[DQK / 8]; s16x4 va[8], vc[8];
#define ATT_KRD(so, DLO, DHI) do { if constexpr (!(ABL & 8) && !(ABL & 16)) _Pragma("unroll") for (int d0 = DLO; d0 < DHI; ++d0) { const int cb = (d0 * 16 + hi * 8) * 2; \
    const int a0_ = (ABL & 64) ? cb * 16 : kswz<DQK>(r32, cb), a1_ = (ABL & 64) ? cb * 16 + 8192 : kswz<DQK>(32 + r32, cb);     \
    if constexpr (ABL & 128) { typedef short s16x4_ __attribute__((ext_vector_type(4))); const s16x4_ x0 = *(const __attribute__((address_space(3))) s16x4_*)(kq0 + (so) + a0_), x1 = *(const __attribute__((address_space(3))) s16x4_*)(kq0 + (so) + a0_ + 8); \
        const s16x4_ y0 = *(const __attribute__((address_space(3))) s16x4_*)(kq0 + (so) + a1_), y1 = *(const __attribute__((address_space(3))) s16x4_*)(kq0 + (so) + a1_ + 8); \
        kf[2 * d0] = (bf16x8){x0[0], x0[1], x0[2], x0[3], x1[0], x1[1], x1[2], x1[3]}; kf[2 * d0 + 1] = (bf16x8){y0[0], y0[1], y0[2], y0[3], y1[0], y1[1], y1[2], y1[3]}; } else { \
    kf[2 * d0] = *(const __attribute__((address_space(3))) bf16x8*)(kq0 + (so) + a0_); kf[2 * d0 + 1] = *(const __attribute__((address_space(3))) bf16x8*)(kq0 + (so) + a1_); } } } while (0)
#define ATT_VRD(buf, so, D0) do { if constexpr (!(ABL & 8) && !(ABL & 32)) _Pragma("unroll") for (int ks = 0; ks < 4; ++ks) { buf[2 * ks] = vtr(vq0 + (so) + v_rd_off(D0, ks, 0)); buf[2 * ks + 1] = vtr(vq0 + (so) + v_rd_off(D0, ks, 1)); } } while (0)
#define ATT_VF(buf, ks) (bf16x8){buf[2 * ks][0], buf[2 * ks][1], buf[2 * ks][2], buf[2 * ks][3], buf[2 * ks + 1][0], buf[2 * ks + 1][1], buf[2 * ks + 1][2], buf[2 * ks + 1][3]}
#define ATT_MF(A_, B_, C_) do { if constexpr (ABL & 2) { asm volatile("" :: "v"(A_), "v"(B_)); } else { C_ = __builtin_amdgcn_mfma_f32_32x32x16_bf16(A_, B_, C_, 0, 0, 0); } } while (0)
#define ATT_PVB(buf, D0) do { ATT_MF(pa0, ATT_VF(buf, 0), o[D0]); ATT_MF(pa1, ATT_VF(buf, 1), o[D0]); ATT_MF(pa2, ATT_VF(buf, 2), o[D0]); ATT_MF(pa3, ATT_VF(buf, 3), o[D0]); } while (0)
  for (int t = 0; t + 1 < NT; ++t) {
    if constexpr (ABL & 1) { u32x4 w0 = {cvtpk(p0[0], p0[1]), cvtpk(p0[2], p0[3]), cvtpk(p0[4], p0[5]), cvtpk(p0[6], p0[7])}, w1 = {cvtpk(p0[8], p0[9]), cvtpk(p0[10], p0[11]), cvtpk(p0[12], p0[13]), cvtpk(p0[14], p0[15])};
        u32x4 w2 = {cvtpk(p1[0], p1[1]), cvtpk(p1[2], p1[3]), cvtpk(p1[4], p1[5]), cvtpk(p1[6], p1[7])}, w3 = {cvtpk(p1[8], p1[9]), cvtpk(p1[10], p1[11]), cvtpk(p1[12], p1[13]), cvtpk(p1[14], p1[15])};
        pa0 = *reinterpret_cast<bf16x8*>(&w0); pa1 = *reinterpret_cast<bf16x8*>(&w1); pa2 = *reinterpret_cast<bf16x8*>(&w2); pa3 = *reinterpret_cast<bf16x8*>(&w3); alpha = 1.f; }
    else { softmax_tile<DQK>(p0, p1, m_reg, l_reg, alpha, pa0, pa1, pa2, pa3);
    ATT_RESC(alpha); }
    if constexpr (!(ABL & 4)) { ATT_WRITE_K(k2); ATT_WRITE_V(v1); }
    ATT_SBAR();
    ATT_VRD(va, v0, 0);
    asm volatile("s_waitcnt lgkmcnt(0)" ::: "memory"); ATT_BAR();
#pragma unroll
    for (int g = 0; g < 16; ++g) {
      const int blk = g >> 2, ks = g & 3;
      if (blk == 0 || blk == 2) { if (ks == 0) ATT_MF(pa0, ATT_VF(va, 0), o[blk]); else if (ks == 1) ATT_MF(pa1, ATT_VF(va, 1), o[blk]); else if (ks == 2) ATT_MF(pa2, ATT_VF(va, 2), o[blk]); else ATT_MF(pa3, ATT_VF(va, 3), o[blk]); }
      else                        { if (ks == 0) ATT_MF(pa0, ATT_VF(vc, 0), o[blk]); else if (ks == 1) ATT_MF(pa1, ATT_VF(vc, 1), o[blk]); else if (ks == 2) ATT_MF(pa2, ATT_VF(vc, 2), o[blk]); else ATT_MF(pa3, ATT_VF(vc, 3), o[blk]); }
      if constexpr (!(ABL & 8)) {
        const lds_cptr vqx = (ABL & 256) ? (lds_cptr)V_lds : vq0;
        if (blk < 3) { if (blk == 0 || blk == 2) { vc[2 * ks] = vtr(vqx + v0 + v_rd_off(blk + 1, ks, 0)); vc[2 * ks + 1] = vtr(vqx + v0 + v_rd_off(blk + 1, ks, 1)); }
                       else                        { va[2 * ks] = vtr(vqx + v0 + v_rd_off(blk + 1, ks, 0)); va[2 * ks + 1] = vtr(vqx + v0 + v_rd_off(blk + 1, ks, 1)); } }
        if (g < DQK / 8) { const int d0 = g >> 1, cb = (d0 * 16 + hi * 8) * 2; kf[g] = *(const __attribute__((address_space(3))) bf16x8*)(kq0 + k1 + ((ABL & 64) ? (g * 256) : kswz<DQK>((g & 1) * 32 + r32, cb))); }
      }
      ATT_SBAR();
    }
    p0 = f32x16{}; p1 = f32x16{};
#pragma unroll
    for (int d0 = 0; d0 < DQK / 16; ++d0) { ATT_MF(kf[2 * d0], qr[d0], p0); ATT_MF(kf[2 * d0 + 1], qr[d0], p1); }
    ATT_SBAR();
    if constexpr (!(ABL & 4)) { const int tk = (t + 3 < NT) ? t + 3 : NT - 1, tv = (t + 2 < NT) ? t + 2 : NT - 1; ATT_LOAD_K(tk); ATT_LOAD_V(tv); }
    ATT_BAR();
    { const int tk_ = k0; k0 = k1; k1 = k2; k2 = tk_; const int tv_ = v0; v0 = v1; v1 = v2; v2 = tv_; }
  }
#undef ATT_KRD
#undef ATT_VRD
#undef ATT_VF
#undef ATT_PVB
#undef ATT_MF
  softmax_tile<DQK>(p0, p1, m_reg, l_reg, alpha, pa0, pa1, pa2, pa3);
  ATT_RESC(alpha);
  ATT_BAR();
  pv_d0(o, vb0 + v0, pa0, pa1, pa2, pa3);
  ATT_BAR();
  if (grp == 0) ATT_BAR();
  l_out = l_reg;
#undef ATT_LOAD_K
#undef ATT_LOAD_V
#undef ATT_WRITE_K
#undef ATT_WRITE_V
#undef ATT_BAR
#undef ATT_RESC
}
__device__ __forceinline__ void row_recips(float l_reg, float* wsf, int r32, int hi, float (&rli)[16]) {
  if (hi == 0) wsf[r32] = l_reg; asm volatile("s_waitcnt lgkmcnt(0)" ::: "memory");
#pragma unroll
  for (int r = 0; r < 16; ++r) rli[r] = __builtin_amdgcn_rcpf(wsf[crow(r, hi)]);
  asm volatile("s_waitcnt lgkmcnt(0)" ::: "memory");
}
}

constexpr int NWAVES = 8;
constexpr int DM = 2048, BATCH = 4, SEQ = 8192, T = BATCH * SEQ;
constexpr int NCOL1 = 4608 + 4096;
constexpr int NEXP = 32, FF = 512, LCAP = 32768;
constexpr int PMAX = 288;
constexpr float EPS = 1e-6f;
constexpr float LAM_INIT = 0.2f;
#ifndef MK_ONE_LAUNCH
#define MK_ONE_LAUNCH 1
#endif
constexpr int N_PHASES = 11;
#ifndef ATT_DUMMY
#define ATT_DUMMY -1
#endif
#ifndef PROBE_MASK
#define PROBE_MASK 0
#define PROBE_MUL 1
#endif

constexpr size_t MiB = 1u << 20;
constexpr size_t WS_CTL = 0, CTL_ZERO_BYTES = 1 * MiB;
constexpr size_t WS_ROPE = 2 * MiB;
constexpr size_t WS_WRT = 4 * MiB;
constexpr size_t WS_TOKROW = 5 * MiB;
constexpr size_t WS_ROWW = 6 * MiB;
constexpr size_t WS_WIN = 8 * MiB;
constexpr size_t WS_WA = 42 * MiB, WS_WB = 46 * MiB, WS_WO = 50 * MiB;
constexpr size_t WS_W13 = 58 * MiB;
constexpr size_t WS_W2 = 186 * MiB;
constexpr size_t WS_SSQ = 250 * MiB;
constexpr size_t WS_LENT = 254 * MiB, WS_LW = 258 * MiB;
constexpr size_t WS_XN = 264 * MiB;
constexpr size_t WS_QA = 392 * MiB, WS_KA = 456 * MiB, WS_VA = 472 * MiB, WS_QB = 488 * MiB, WS_KB = 552 * MiB, WS_VB = 616 * MiB;
constexpr size_t WS_XG = 392 * MiB;
constexpr size_t WS_GT = 680 * MiB;
constexpr size_t WS_YC = WS_XG;
constexpr size_t WS_END = 936 * MiB;
constexpr int CW_CNT = 64;
constexpr int CW_BAR = 4096;

constexpr int SCR_OFF = 0, SCR_BYTES = 139264;
constexpr int AWS_OFF = 139264;
constexpr int MOE_OFF = AWS_OFF + 2048;
constexpr int MISC_OFF = MOE_OFF + 512;
constexpr int LDS_BYTES = 147456;
static_assert(MISC_OFF + 128 <= LDS_BYTES, "LDS map");

#define GAS __attribute__((address_space(1)))
#define LAS __attribute__((address_space(3)))
typedef unsigned short bf16;
typedef unsigned v4u __attribute__((ext_vector_type(4)));
typedef unsigned v2u __attribute__((ext_vector_type(2)));
typedef float f32x4 __attribute__((ext_vector_type(4)));
typedef short bf16x8 __attribute__((ext_vector_type(8)));
typedef GAS unsigned gu32;
#define RLX_AGENT __ATOMIC_RELAXED, __HIP_MEMORY_SCOPE_AGENT
#define LDS_WAIT() asm volatile("s_waitcnt lgkmcnt(0)" ::: "memory")
#define VM_WAIT() asm volatile("s_waitcnt vmcnt(0)" ::: "memory")
__device__ __forceinline__ unsigned f2bf(float f) { unsigned u = __builtin_bit_cast(unsigned, f); return (u + 0x7fffu + ((u >> 16) & 1u)) >> 16; }
__device__ __forceinline__ unsigned pk2(float lo, float hi) { return f2bf(lo) | (f2bf(hi) << 16); }
__device__ __forceinline__ float bflo(unsigned w) { return __uint_as_float(w << 16); }
__device__ __forceinline__ float bfhi(unsigned w) { return __uint_as_float(w & 0xffff0000u); }
__device__ __forceinline__ float wave_sum(float v) {
#pragma unroll
    for (int o = 1; o < 64; o <<= 1) v += __shfl_xor(v, o);
    return v;
}

#define XB_TMO      128
#define XB_XCNT(j)  (256  + 64 * (j))
#define XB_XSUB(j)  (1280 + 64 * (j))
#define XB_XGEN(j)  (2304 + 64 * (j))
#define XB_TOP      3328
#define XB_TOPGEN   3392
#define XCD_BAR_WORDS 3456
#define XB_SPIN_CAP (1u << 18)

__device__ __forceinline__ unsigned xb_ld(unsigned* p)              { return __hip_atomic_load(p, __ATOMIC_RELAXED, __HIP_MEMORY_SCOPE_AGENT); }
__device__ __forceinline__ unsigned xb_add(unsigned* p, unsigned v) { return __hip_atomic_fetch_add(p, v, __ATOMIC_RELAXED, __HIP_MEMORY_SCOPE_AGENT); }
__device__ __forceinline__ unsigned xb_xcc_id() { return (unsigned)__builtin_amdgcn_s_getreg((3 << 11) | 20) & 0xFu; }
#define XB_SPIN(cond, bar) do { unsigned _sp = 0; while (cond) { __builtin_amdgcn_s_sleep(1); \
    if ((++_sp & 255u) == 0u) { if (xb_ld(&(bar)[XB_TMO])) break; if (_sp > XB_SPIN_CAP) { atomicAdd(&(bar)[XB_TMO], 1u); break; } } } } while (0)

struct XcdBarrier {
    unsigned* bar; unsigned x;
    volatile LAS unsigned* st;
};

__device__ __forceinline__ XcdBarrier xcd_barrier_post(unsigned* bar, volatile LAS unsigned* st) {
    XcdBarrier b; b.bar = bar; b.x = xb_xcc_id(); b.st = st;
    if (threadIdx.x == 0) (void)xb_add(&bar[XB_XCNT(b.x)], 1u);
    return b;
}
__device__ __forceinline__ void xcd_barrier_complete(unsigned* bar, unsigned x, unsigned& nloc, unsigned& nx) {
    const unsigned G = gridDim.x * gridDim.y * gridDim.z;
    unsigned sum, cnt, mine, sp = 0u;
    for (;;) {
        sum = 0u; cnt = 0u; mine = 0u;
#pragma unroll
        for (unsigned j = 0; j < 16; ++j) { const unsigned c = xb_ld(&bar[XB_XCNT(j)]); sum += c; cnt += (c > 0u) ? 1u : 0u; mine = (j == x) ? c : mine; }
        if (sum == G) break;
        __builtin_amdgcn_s_sleep(1);
        if ((++sp & 255u) == 0u) { if (xb_ld(&bar[XB_TMO])) break; if (sp > XB_SPIN_CAP) { atomicAdd(&bar[XB_TMO], 1u); break; } }
    }
    nloc = mine > 0u ? mine : 1u; nx = cnt > 0u ? cnt : 1u;
}

__device__ __forceinline__ void xcd_barrier(const XcdBarrier& b) {
    asm volatile("s_waitcnt vmcnt(0)" ::: "memory");
    __syncthreads();
    if (threadIdx.x == 0) {
        unsigned* bar = b.bar;
        __builtin_amdgcn_s_waitcnt(0);
        unsigned nloc = b.st[0], nx = b.st[1];
        if (nloc == 0u) { xcd_barrier_complete(bar, b.x, nloc, nx); b.st[0] = nloc; b.st[1] = nx; }
        const unsigned old = xb_add(&bar[XB_XSUB(b.x)], 1u);
        const unsigned gen = old / nloc;
        if (old + 1u == (gen + 1u) * nloc) {
            __builtin_amdgcn_fence(__ATOMIC_RELEASE, "agent");
            asm volatile("s_waitcnt vmcnt(0)" ::: "memory");
            const unsigned og = xb_add(&bar[XB_TOP], 1u);
            const unsigned tg = og / nx;
            if (og + 1u == (tg + 1u) * nx) xb_add(&bar[XB_TOPGEN], 1u);
            else XB_SPIN(xb_ld(&bar[XB_TOPGEN]) == tg, bar);
            __builtin_amdgcn_fence(__ATOMIC_ACQUIRE, "agent");
            xb_add(&bar[XB_XGEN(b.x)], 1u);
            asm volatile("s_waitcnt vmcnt(0)" ::: "memory");
        } else {
            XB_SPIN(xb_ld(&bar[XB_XGEN(b.x)]) == gen, bar);
            __builtin_amdgcn_fence(__ATOMIC_ACQUIRE, "agent");
            asm volatile("s_waitcnt vmcnt(0)" ::: "memory");
        }
    }
    __syncthreads();
}

struct Args { const float* in[22]; float* out; unsigned char* ws; int ph_lo, ph_hi, li, pad; };
struct Frame { unsigned char* lds; int tid, lane, wave, vcu, G, gw, NGW; };
typedef const Args __attribute__((address_space(4)))* KArgs;
#define FRESH_ARGS() ({ KArgs p_ = (KArgs)__builtin_amdgcn_kernarg_segment_ptr(); asm volatile("" : "+s"(p_)); p_; })

__device__ __forceinline__ void p0_transpose_item(const float* W, int N, int k0, int n0, bf16* WT, int K, int dst_row0, LAS float* scr, int lane) {
#pragma unroll 8
    for (int i = 0; i < 32; ++i) { const int kk = 2 * i + (lane >> 5); scr[kk * 33 + (lane & 31)] = W[(size_t)(k0 + kk) * N + n0 + (lane & 31)]; }
    LDS_WAIT(); asm volatile("" ::: "memory");
    const int c = lane & 7;
#pragma unroll
    for (int j = 0; j < 4; ++j) { const int n = (lane >> 3) + 8 * j; const LAS float* s = scr + (8 * c) * 33 + n;
        v4u o; o.x = pk2(s[0 * 33], s[1 * 33]); o.y = pk2(s[2 * 33], s[3 * 33]); o.z = pk2(s[4 * 33], s[5 * 33]); o.w = pk2(s[6 * 33], s[7 * 33]);
        *(GAS v4u*)(WT + (size_t)(dst_row0 + n) * K + k0 + 8 * c) = o; }
    LDS_WAIT(); asm volatile("" ::: "memory");
}
__device__ __forceinline__ void p0_prologue(const Frame& F, KArgs a) {
    unsigned char* ws = a->ws;
    LAS float* scr = (LAS float*)((LAS unsigned char*)F.lds + SCR_OFF + F.wave * 16384);
    constexpr int I_IN = 32 * 144, I_GT = 32 * 128, I_BA = 16 * 64, I_WO = 32 * 64, I_E = 32 * 512;
    constexpr int NITEMS = I_IN + I_GT + 2 * I_BA + I_WO + 3 * I_E;
    for (int it = F.gw; it < NITEMS; it += F.NGW) {
        int r = it;
        if (r < I_IN) { const int kb = r / 144, nb = r % 144; p0_transpose_item(a->in[2], 4608, 64 * kb, 32 * nb, (bf16*)(ws + WS_WIN), 2048, 32 * nb, scr, F.lane); continue; } r -= I_IN;
        if (r < I_GT) { const int kb = r / 128, nb = r % 128; p0_transpose_item(a->in[12], 4096, 64 * kb, 32 * nb, (bf16*)(ws + WS_WIN), 2048, 4608 + 32 * nb, scr, F.lane); continue; } r -= I_GT;
        if (r < I_BA) { const int kb = r / 64, nb = r % 64; p0_transpose_item(a->in[10], 2048, 64 * kb, 32 * nb, (bf16*)(ws + WS_WA), 1024, 32 * nb, scr, F.lane); continue; } r -= I_BA;
        if (r < I_BA) { const int kb = r / 64, nb = r % 64; p0_transpose_item(a->in[11], 2048, 64 * kb, 32 * nb, (bf16*)(ws + WS_WB), 1024, 32 * nb, scr, F.lane); continue; } r -= I_BA;
        if (r < I_WO) { const int kb = r / 64, nb = r % 64; p0_transpose_item(a->in[14], 2048, 64 * kb, 32 * nb, (bf16*)(ws + WS_WO), 2048, 32 * nb, scr, F.lane); continue; } r -= I_WO;
        if (r < I_E)  { const int e = r / 512, q = r % 512, kb = q / 16, nb = q % 16, n0 = 32 * nb;
                        p0_transpose_item(a->in[18] + (size_t)e * 2048 * 512, 512, 64 * kb, n0, (bf16*)(ws + WS_W13), 2048, e * 1024 + (n0 >> 7) * 256 + (n0 & 127), scr, F.lane); continue; } r -= I_E;
        if (r < I_E)  { const int e = r / 512, q = r % 512, kb = q / 16, nb = q % 16, n0 = 32 * nb;
                        p0_transpose_item(a->in[19] + (size_t)e * 2048 * 512, 512, 64 * kb, n0, (bf16*)(ws + WS_W13), 2048, e * 1024 + (n0 >> 7) * 256 + 128 + (n0 & 127), scr, F.lane); continue; } r -= I_E;
        { const int e = r / 512, q = r % 512, kb = q / 64, nb = q % 64;
          p0_transpose_item(a->in[20] + (size_t)e * 512 * 2048, 2048, 64 * kb, 32 * nb, (bf16*)(ws + WS_W2), 512, e * 2048 + 32 * nb, scr, F.lane); }
    }
    { float2* tab = (float2*)(ws + WS_ROPE);
      for (int idx = F.gw * 64 + F.lane; idx < SEQ * 32; idx += F.NGW * 64) { const int pos = idx >> 5, i = idx & 31;
          const float inv = powf(10000.0f, -(float)(2 * i) / 64.0f); const float ang = (float)pos * inv;
          double s, c; sincos((double)ang, &s, &c); tab[idx] = make_float2((float)c, (float)s); } }
    { bf16* wh = (bf16*)(ws + WS_WRT); bf16* wl = wh + 48 * 2048;
      for (int idx = F.gw * 64 + F.lane; idx < 48 * 2048; idx += F.NGW * 64) { const int c = idx >> 11, k = idx & 2047;
          const float v = c < 4 ? a->in[16][k * 4 + c] : (c < 36 ? a->in[17][k * 32 + (c - 4)] : 0.f);
          const unsigned h = f2bf(v); const float hf = __uint_as_float(h << 16); wh[idx] = (bf16)h; wl[idx] = (bf16)f2bf(v - hf); } }
    { const float* x = a->in[0]; const GAS f32x4* g4 = (const GAS f32x4*)a->in[1] + F.lane; bf16* XN = (bf16*)(ws + WS_XN);
      for (int m = F.gw; m < T; m += F.NGW) {
          const GAS f32x4* xr = (const GAS f32x4*)(x + (size_t)m * DM) + F.lane; f32x4 v[8]; float s = 0.f;
#pragma unroll
          for (int j = 0; j < 8; ++j) { v[j] = xr[64 * j]; s += (v[j].x * v[j].x + v[j].y * v[j].y) + (v[j].z * v[j].z + v[j].w * v[j].w); }
          const float rstd = 1.0f / sqrtf(wave_sum(s) * (1.0f / DM) + EPS);
          GAS v2u* o8 = (GAS v2u*)(XN + (size_t)m * DM) + F.lane;
#pragma unroll
          for (int j = 0; j < 8; ++j) { const f32x4 g = g4[64 * j]; v2u w; w.x = pk2(v[j].x * rstd * g.x, v[j].y * rstd * g.y); w.y = pk2(v[j].z * rstd * g.z, v[j].w * rstd * g.w); o8[64 * j] = w; } } }
}

__device__ __forceinline__ void rope8(float (&v)[8], const float2* tab, int pos, int cc) {
    const GAS f32x4* tp = (const GAS f32x4*)(tab + (size_t)pos * 32 + 8 * (cc & 3));
    const f32x4 t0 = tp[0], t1 = tp[1], t2 = tp[2], t3 = tp[3];
    const float cs[8] = {t0.x, t0.z, t1.x, t1.z, t2.x, t2.z, t3.x, t3.z}, sn[8] = {t0.y, t0.w, t1.y, t1.w, t2.y, t2.w, t3.y, t3.w};
    const float sg = (cc & 4) ? 1.f : -1.f;
#pragma unroll
    for (int e = 0; e < 8; ++e) { const float p = __shfl_xor(v[e], 4); v[e] = v[e] * cs[e] + sg * p * sn[e]; }
}
__device__ __forceinline__ void unpack8(const v4u w, float (&v)[8]) { v[0] = bflo(w.x); v[1] = bfhi(w.x); v[2] = bflo(w.y); v[3] = bfhi(w.y); v[4] = bflo(w.z); v[5] = bfhi(w.z); v[6] = bflo(w.w); v[7] = bfhi(w.w); }
__device__ __forceinline__ v4u pack8(const float (&v)[8]) { v4u w; w.x = pk2(v[0], v[1]); w.y = pk2(v[2], v[3]); w.z = pk2(v[4], v[5]); w.w = pk2(v[6], v[7]); return w; }
__device__ __forceinline__ void p1b_normrope(const Frame& F, KArgs a) {
    unsigned char* ws = a->ws; const float2* tab = (const float2*)(ws + WS_ROPE);
    bf16* QA = (bf16*)(ws + WS_QA); bf16* KA = (bf16*)(ws + WS_KA); bf16* QB = (bf16*)(ws + WS_QB); bf16* KB = (bf16*)(ws + WS_KB);
    const float* qg = a->in[3]; const float* kg = a->in[4];
    const int cc16 = F.lane & 15;
    float gq[8], gk[8];
#pragma unroll
    for (int e = 0; e < 8; ++e) { gq[e] = qg[cc16 * 8 + e]; gk[e] = kg[cc16 * 8 + e]; }
    for (int t = F.gw; t < T; t += F.NGW) {
        const int s = t & (SEQ - 1), prow = s >> 6, pcol = s & 63;
        const int posA = (cc16 < 8) ? prow : pcol;
#pragma unroll
        for (int j = 0; j < 3; ++j) {
            const bool isk = (j == 2); const int c = isk ? (F.lane & 31) : (F.lane + 64 * j);
            bf16* p = (isk ? KA + (size_t)t * 256 : QA + (size_t)t * 1024) + c * 8;
            float v[8]; unpack8(*(const GAS v4u*)p, v);
            float ss = 0.f;
#pragma unroll
            for (int e = 0; e < 8; ++e) ss += v[e] * v[e];
            ss += __shfl_xor(ss, 1); ss += __shfl_xor(ss, 2); ss += __shfl_xor(ss, 4); ss += __shfl_xor(ss, 8);
            const float rstd = 1.0f / sqrtf(ss * (1.0f / 128.0f) + EPS);
#pragma unroll
            for (int e = 0; e < 8; ++e) v[e] = v[e] * rstd * (isk ? gk[e] : gq[e]);
            rope8(v, tab, posA, cc16 & 7);
            if (!isk || F.lane < 32) *(GAS v4u*)p = pack8(v);
        }
#pragma unroll
        for (int j = 0; j < 4; ++j) {
            bf16* p = ((j & 2) ? KB : QB) + (size_t)t * 1024 + (F.lane + 64 * (j & 1)) * 8;
            float v[8]; unpack8(*(const GAS v4u*)p, v);
            rope8(v, tab, s, F.lane & 7);
            *(GAS v4u*)p = pack8(v);
        }
    }
}

template <int ABL = 0, size_t OUT_OFF = WS_QA> __device__ __forceinline__ void attn_unit_A(const Frame& F, KArgs a, int b, int h, int qb) {
    using namespace att;
    int tid_ = threadIdx.x; asm volatile("" : "+v"(tid_));
    const int lane_ = tid_ & 63, wave_ = __builtin_amdgcn_readfirstlane(tid_ >> 6);
    unsigned char* ws = a->ws; char* lds = (char*)F.lds + SCR_OFF; float* wsf = (float*)((char*)F.lds + AWS_OFF) + wave_ * 64;
    const int r32 = lane_ & 31, hi = lane_ >> 5, kvh = h >> 2;
    const att::bf16* Qb = (const att::bf16*)(ws + WS_QA) + ((size_t)b * SEQ + (size_t)qb * 256) * 1024 + h * 128;
    const att::bf16* Kh = (const att::bf16*)(ws + WS_KA) + (size_t)b * SEQ * 256 + kvh * 128;
    const att::bf16* Vh = (const att::bf16*)(ws + WS_VA) + (size_t)b * SEQ * 256 + kvh * 128;
    f32x16 o[4]; float l_reg;
    attn_pass<128, 1024, 256, 256, ABL>(Qb, Kh, Vh, SEQ, lds, wsf, o, l_reg);
    float rli[16]; row_recips(l_reg, wsf, r32, hi, rli);
    att::bf16* Ow = (att::bf16*)(ws + OUT_OFF) + ((size_t)b * SEQ + (size_t)qb * 256 + wave_ * 32) * 1024 + h * 128;
#pragma unroll
    for (int r = 0; r < 16; ++r) { const int orow = crow(r, hi);
#pragma unroll
        for (int d0 = 0; d0 < 4; ++d0) Ow[(size_t)orow * 1024 + d0 * 32 + r32] = (att::bf16)f2bf(o[d0][r] * rli[r]); }
}
__device__ __forceinline__ void attn_unit_B(const Frame& F, KArgs a, int b, int h, int qb, float lam) {
    using namespace att;
    int tid_ = threadIdx.x; asm volatile("" : "+v"(tid_));
    const int lane_ = tid_ & 63, wave_ = __builtin_amdgcn_readfirstlane(tid_ >> 6);
    unsigned char* ws = a->ws; char* lds = (char*)F.lds + SCR_OFF; float* wsf = (float*)((char*)F.lds + AWS_OFF) + wave_ * 64;
    unsigned* stash = (unsigned*)(lds + OFF_STASH) + wave_ * 2048;
    const int r32 = lane_ & 31, hi = lane_ >> 5;
    const att::bf16* Qb = (const att::bf16*)(ws + WS_QB) + ((size_t)b * SEQ + (size_t)qb * 256) * 1024 + h * 128;
    const att::bf16* Kh = (const att::bf16*)(ws + WS_KB) + (size_t)b * SEQ * 1024 + h * 128;
    const att::bf16* Vh = (const att::bf16*)(ws + WS_VB) + (size_t)b * SEQ * 1024 + h * 128;
    f32x16 o[4]; float l_reg; float rli[16];
    attn_pass<64, 1024, 1024, 1024>(Qb, Kh, Vh, SEQ, lds, wsf, o, l_reg);
    row_recips(l_reg, wsf, r32, hi, rli);
#pragma unroll
    for (int d0 = 0; d0 < 4; ++d0)
#pragma unroll
        for (int r = 0; r < 16; r += 2) stash[(d0 * 8 + (r >> 1)) * 64 + lane_] = att::cvtpk(o[d0][r] * rli[r], o[d0][r + 1] * rli[r + 1]);
    attn_pass<64, 1024, 1024, 1024>(Qb + 64, Kh + 64, Vh, SEQ, lds, wsf, o, l_reg);
    row_recips(l_reg, wsf, r32, hi, rli);
    asm volatile("s_waitcnt lgkmcnt(0)" ::: "memory");
    float ss[16];
#pragma unroll
    for (int r = 0; r < 16; ++r) ss[r] = 0.f;
#pragma unroll
    for (int d0 = 0; d0 < 4; ++d0)
#pragma unroll
        for (int r = 0; r < 16; r += 2) { const unsigned w = stash[(d0 * 8 + (r >> 1)) * 64 + lane_];
            const float x0 = bflo(w) - lam * (o[d0][r] * rli[r]), x1 = bfhi(w) - lam * (o[d0][r + 1] * rli[r + 1]);
            o[d0][r] = x0; o[d0][r + 1] = x1; ss[r] += x0 * x0; ss[r + 1] += x1 * x1; }
#pragma unroll
    for (int r = 0; r < 16; ++r) { float s = ss[r]; s += __shfl_xor(s, 1); s += __shfl_xor(s, 2); s += __shfl_xor(s, 4); s += __shfl_xor(s, 8); s += __shfl_xor(s, 16);
        ss[r] = (1.0f - LAM_INIT) / sqrtf(s * (1.0f / 128.0f) + EPS); }
    const float* sg = a->in[9]; float g4[4];
#pragma unroll
    for (int d0 = 0; d0 < 4; ++d0) g4[d0] = sg[d0 * 32 + r32];
    att::bf16* Ow = (att::bf16*)(ws + WS_QB) + ((size_t)b * SEQ + (size_t)qb * 256 + wave_ * 32) * 1024 + h * 128;
#pragma unroll
    for (int r = 0; r < 16; ++r) { const int orow = crow(r, hi);
#pragma unroll
        for (int d0 = 0; d0 < 4; ++d0) Ow[(size_t)orow * 1024 + d0 * 32 + r32] = (att::bf16)f2bf(o[d0][r] * ss[r] * g4[d0]); }
}
__device__ __forceinline__ void p2_attention(const Frame& F, KArgs a) {
    const float lam = __uint_as_float(__builtin_amdgcn_readfirstlane(__float_as_uint(expf(wave_sum(a->in[5][F.lane] * a->in[6][F.lane])) - expf(wave_sum(a->in[7][F.lane] * a->in[8][F.lane])) + LAM_INIT)));
#if ATT_DUMMY >= 0
    for (int L = F.vcu; L < 1024; L += F.G) { const int i = L >> 8, v = L & 255, x = v >> 5, qb = v & 31, b = x >> 1; attn_unit_A<ATT_DUMMY, WS_XN>(F, a, b, 4 * (x & 1) + i, qb); }
#endif
    for (int L = F.vcu; L < 2048; L += F.G) {
#if PROBE_MASK
        if (L >> 8 == 4 && blockIdx.x == 0 && F.tid == 0) { volatile LAS unsigned* M_ = (volatile LAS unsigned*)((LAS unsigned char*)F.lds + MISC_OFF); M_[21] = (unsigned)__builtin_amdgcn_s_memrealtime() - M_[20]; }
#endif
        const int i = L >> 8, v = L & 255, x = v >> 5, qb = v & 31, b = x >> 1;
#ifndef ATT_SKIP_A
        if (i < 4) attn_unit_A(F, a, b, 4 * (x & 1) + i, qb);
#endif
#ifndef ATT_SKIP_B
        if (i >= 4) attn_unit_B(F, a, b, 4 * (x & 1) + (i - 4), qb, lam);
#endif
    }
}

__device__ __forceinline__ void moe_table(const Frame& F, KArgs a) {
    LAS int* tab = (LAS int*)((LAS unsigned char*)F.lds + MOE_OFF);
    if (F.tid == 0) { const gu32* cnt = (const gu32*)(a->ws + WS_CTL) + CW_CNT; int acc = 0;
        for (int e = 0; e < NEXP; ++e) { const int c = (int)__hip_atomic_load(cnt + e, RLX_AGENT); tab[e] = c; tab[32 + e] = acc; acc += (c + 255) >> 8; }
        tab[64] = acc; }
    __syncthreads();
}

__device__ __forceinline__ void p4_router(const Frame& F, KArgs a) {
    typedef float f32x4v __attribute__((ext_vector_type(4)));
    unsigned char* ws = a->ws; const float* X1 = a->out; const float* SSQ = (const float*)(ws + WS_SSQ); const float* gf = a->in[15];
    bf16* H2 = (bf16*)(ws + WS_GT); const bf16* wh = (const bf16*)(ws + WS_WRT); const bf16* wl = wh + 48 * 2048;
    gu32* cnt = (gu32*)(ws + WS_CTL) + CW_CNT; int* LENT = (int*)(ws + WS_LENT); float* LW = (float*)(ws + WS_LW);
    LAS float* LG = (LAS float*)((LAS unsigned char*)F.lds + SCR_OFF) + F.wave * (16 * 48);
    LAS int* lcnt = (LAS int*)((LAS unsigned char*)F.lds + SCR_OFF + 32768);
    const int row = F.lane & 15, kq = F.lane >> 4;
    const int NTASK = T / 16, rounds = (NTASK + F.NGW - 1) / F.NGW;
    for (int it = 0; it < rounds; ++it) {
        const int task = it * F.NGW + F.gw; const bool valid = task < NTASK; const int t0 = valid ? task * 16 : 0;
        if (F.tid < 64) lcnt[F.tid] = 0;
        __syncthreads();
        int e0 = 0, e1 = 0, r0 = 0, r1 = 0; float w0 = 0.f, w1 = 0.f;
        {
            const GAS f32x4v* sp = (const GAS f32x4v*)(SSQ + (size_t)(t0 + row) * 32); float s = 0.f;
#pragma unroll
            for (int j = 0; j < 8; ++j) { const f32x4v q = sp[j]; s += (q.x + q.y) + (q.z + q.w); }
            const float rstd = 1.0f / sqrtf(s * (1.0f / DM) + EPS);
            f32x4v acc[3] = {{0.f, 0.f, 0.f, 0.f}, {0.f, 0.f, 0.f, 0.f}, {0.f, 0.f, 0.f, 0.f}};
            const float* xrow = X1 + (size_t)(t0 + row) * DM + 8 * kq; bf16* hrow = H2 + (size_t)(t0 + row) * DM + 8 * kq;
            const bf16* bh = wh + (size_t)row * 2048 + 8 * kq; const bf16* bl = wl + (size_t)row * 2048 + 8 * kq;
#pragma unroll 2
            for (int ks = 0; ks < 64; ++ks) {
                const f32x4v x0 = *(const GAS f32x4v*)(xrow + 32 * ks), x1 = *(const GAS f32x4v*)(xrow + 32 * ks + 4);
                const f32x4v g0 = *(const GAS f32x4v*)(gf + 32 * ks + 8 * kq), g1 = *(const GAS f32x4v*)(gf + 32 * ks + 8 * kq + 4);
                float h[8] = {x0.x * rstd * g0.x, x0.y * rstd * g0.y, x0.z * rstd * g0.z, x0.w * rstd * g0.w, x1.x * rstd * g1.x, x1.y * rstd * g1.y, x1.z * rstd * g1.z, x1.w * rstd * g1.w};
                unsigned hh[8], hl[8];
#pragma unroll
                for (int e = 0; e < 8; ++e) { hh[e] = f2bf(h[e]); hl[e] = f2bf(h[e] - __uint_as_float(hh[e] << 16)); }
                v4u ah, al; ah.x = hh[0] | (hh[1] << 16); ah.y = hh[2] | (hh[3] << 16); ah.z = hh[4] | (hh[5] << 16); ah.w = hh[6] | (hh[7] << 16);
                al.x = hl[0] | (hl[1] << 16); al.y = hl[2] | (hl[3] << 16); al.z = hl[4] | (hl[5] << 16); al.w = hl[6] | (hl[7] << 16);
                if (valid) *(GAS v4u*)(hrow + 32 * ks) = ah;
                const bf16x8 Ah = __builtin_bit_cast(bf16x8, ah), Al = __builtin_bit_cast(bf16x8, al);
#pragma unroll
                for (int blk = 0; blk < 3; ++blk) {
                    const bf16x8 Bh = *(const GAS bf16x8*)(bh + (size_t)blk * 16 * 2048 + 32 * ks), Bl = *(const GAS bf16x8*)(bl + (size_t)blk * 16 * 2048 + 32 * ks);
                    acc[blk] = __builtin_amdgcn_mfma_f32_16x16x32_bf16(Ah, Bh, acc[blk], 0, 0, 0);
                    acc[blk] = __builtin_amdgcn_mfma_f32_16x16x32_bf16(Al, Bh, acc[blk], 0, 0, 0);
                    acc[blk] = __builtin_amdgcn_mfma_f32_16x16x32_bf16(Ah, Bl, acc[blk], 0, 0, 0);
                }
            }
#pragma unroll
            for (int blk = 0; blk < 3; ++blk)
#pragma unroll
                for (int i = 0; i < 4; ++i) LG[(4 * kq + i) * 48 + 16 * blk + row] = acc[blk][i];
            LDS_WAIT();
            if (F.lane < 16) {
                const LAS float* lg = LG + F.lane * 48;
                float gl[4];
#pragma unroll
                for (int i = 0; i < 4; ++i) gl[i] = lg[i];
                int gi = 0; float gm = gl[0];
#pragma unroll
                for (int i = 1; i < 4; ++i) if (gl[i] > gm) { gm = gl[i]; gi = i; }
                float gs = 0.f;
#pragma unroll
                for (int i = 0; i < 4; ++i) gs += expf(gl[i] - gm);
                const float gw_ = 1.0f / gs;
                const LAS float* el = lg + 4 + gi * 8;
                float ev[8];
#pragma unroll
                for (int i = 0; i < 8; ++i) ev[i] = el[i];
                int i0 = 0; float v0 = ev[0];
#pragma unroll
                for (int i = 1; i < 8; ++i) if (ev[i] > v0) { v0 = ev[i]; i0 = i; }
                int i1 = -1; float v1 = -3.0e38f;
#pragma unroll
                for (int i = 0; i < 8; ++i) if (i != i0 && ev[i] > v1) { v1 = ev[i]; i1 = i; }
                const float ex = expf(v1 - v0), den = 1.0f / (1.0f + ex);
                w0 = den * gw_; w1 = ex * den * gw_; e0 = gi * 8 + i0; e1 = gi * 8 + i1;
                if (valid) { r0 = atomicAdd((int*)&lcnt[e0], 1); r1 = atomicAdd((int*)&lcnt[e1], 1); }
            }
        }
        __syncthreads();
        if (F.tid < 32) { const int c = lcnt[F.tid]; lcnt[32 + F.tid] = c ? (int)__hip_atomic_fetch_add(cnt + F.tid, (unsigned)c, RLX_AGENT) : 0; }
        __syncthreads();
        if (valid && F.lane < 16) { const int tok = t0 + F.lane;
            const int s0 = lcnt[32 + e0] + r0, s1 = lcnt[32 + e1] + r1;
            LENT[(size_t)e0 * LCAP + s0] = tok * 2; LW[(size_t)e0 * LCAP + s0] = w0;
            LENT[(size_t)e1 * LCAP + s1] = tok * 2 + 1; LW[(size_t)e1 * LCAP + s1] = w1; }
        __syncthreads();
    }
}

__device__ __forceinline__ void p4b_gather(const Frame& F, KArgs a) {
    unsigned char* ws = a->ws; const LAS int* tab = (const LAS int*)((LAS unsigned char*)F.lds + MOE_OFF);
    const bf16* H2 = (const bf16*)(ws + WS_GT); bf16* XG = (bf16*)(ws + WS_XG); float* ROWW = (float*)(ws + WS_ROWW); int* TOKROW = (int*)(ws + WS_TOKROW);
    const int* LENT = (const int*)(ws + WS_LENT); const float* LW = (const float*)(ws + WS_LW);
    const int P = tab[64];
    for (int R = F.gw; R < P * 256; R += F.NGW) {
        const int p = R >> 8; int e = 0;
#pragma unroll 1
        for (int k = 1; k < 32; ++k) if (tab[32 + k] <= p) e = k;
        const int slot = R - tab[32 + e] * 256;
        GAS v4u* dst = (GAS v4u*)(XG + (size_t)R * DM) + F.lane;
        if (slot < tab[e]) {
            const int ent = LENT[(size_t)e * LCAP + slot]; const GAS v4u* src = (const GAS v4u*)(H2 + (size_t)(ent >> 1) * DM) + F.lane;
#pragma unroll
            for (int j = 0; j < 4; ++j) dst[64 * j] = src[64 * j];
            if (F.lane == 0) { ROWW[R] = LW[(size_t)e * LCAP + slot]; TOKROW[ent] = R; }
        } else {
            const v4u z = {0u, 0u, 0u, 0u};
#pragma unroll
            for (int j = 0; j < 4; ++j) dst[64 * j] = z;
            if (F.lane == 0) ROWW[R] = 0.f;
        }
    }
}

__device__ __forceinline__ void p6_final(const Frame& F, KArgs a) {
    unsigned char* ws = a->ws; const bf16* YC = (const bf16*)(ws + WS_YC); const int* TOKROW = (const int*)(ws + WS_TOKROW);
    const GAS f32x4* g4 = (const GAS f32x4*)a->in[21] + F.lane;
    for (int t = F.gw; t < T; t += F.NGW) {
        GAS f32x4* xr = (GAS f32x4*)(a->out + (size_t)t * DM) + F.lane;
        const int R0 = TOKROW[2 * t], R1 = TOKROW[2 * t + 1];
        const GAS v2u* y0 = (const GAS v2u*)(YC + (size_t)R0 * DM) + F.lane; const GAS v2u* y1 = (const GAS v2u*)(YC + (size_t)R1 * DM) + F.lane;
        f32x4 v[8]; float s = 0.f;
#pragma unroll
        for (int j = 0; j < 8; ++j) { const f32x4 x = xr[64 * j]; const v2u p = y0[64 * j], q = y1[64 * j];
            v[j].x = x.x + (bflo(p.x) + bflo(q.x)); v[j].y = x.y + (bfhi(p.x) + bfhi(q.x)); v[j].z = x.z + (bflo(p.y) + bflo(q.y)); v[j].w = x.w + (bfhi(p.y) + bfhi(q.y));
            s += (v[j].x * v[j].x + v[j].y * v[j].y) + (v[j].z * v[j].z + v[j].w * v[j].w); }
        const float rstd = 1.0f / sqrtf(wave_sum(s) * (1.0f / DM) + EPS);
#pragma unroll
        for (int j = 0; j < 8; ++j) { const f32x4 g = g4[64 * j]; xr[64 * j] = (f32x4){v[j].x * rstd * g.x, v[j].y * rstd * g.y, v[j].z * rstd * g.z, v[j].w * rstd * g.w}; }
    }
}

__global__ void __launch_bounds__(NWAVES * 64, 2) fwd_kernel(Args args) {
    extern __shared__ __attribute__((aligned(16))) unsigned char lds[];
    Frame F;
    F.lds = lds; F.tid = threadIdx.x; F.lane = F.tid & 63; F.wave = __builtin_amdgcn_readfirstlane(F.tid >> 6);
    F.G = gridDim.x; { const int bx = blockIdx.x; F.vcu = (F.G % 8 == 0) ? (bx % 8) * (F.G / 8) + bx / 8 : bx; }
    F.gw = F.vcu * NWAVES + F.wave; F.NGW = F.G * NWAVES;
    LAS unsigned char* L = (LAS unsigned char*)lds;
    volatile LAS unsigned* MISC = (volatile LAS unsigned*)(L + MISC_OFF);
    for (int u = F.tid; u < (LDS_BYTES - MISC_OFF) / 4; u += NWAVES * 64) ((LAS unsigned*)(L + MISC_OFF))[u] = 0u;
    __syncthreads();
    int lo, hi, li; unsigned* ctl;
    { KArgs a = FRESH_ARGS(); lo = a->ph_lo; hi = a->ph_hi; li = a->li; ctl = (unsigned*)(a->ws + WS_CTL); }
    XcdBarrier bar; bar.bar = ctl + CW_BAR + li * XCD_BAR_WORDS; bar.x = 0; bar.st = nullptr;
    if (hi - lo > 1) bar = xcd_barrier_post(ctl + CW_BAR + li * XCD_BAR_WORDS, MISC + 8);
#ifndef PH_MASK
#define PH_MASK 0x7ff
#endif
#define IN(k) (((PH_MASK >> (k)) & 1) && lo <= (k) && (k) < hi)
#if PROBE_MASK
    if (blockIdx.x == 0 && F.tid == 0) MISC[20] = (unsigned)__builtin_amdgcn_s_memrealtime();
#define STAMP(k) do { if (blockIdx.x == 0 && F.tid == 0) { const unsigned now_ = (unsigned)__builtin_amdgcn_s_memrealtime(); MISC[10 + (k)] = now_ - MISC[20]; MISC[20] = now_; } } while (0)
#else
#define STAMP(k) do { } while (0)
#endif
#define SEAM(k) do { if (IN(k) && IN((k) + 1)) { xcd_barrier(bar); STAMP(k); } } while (0)

    if (IN(0)) { KArgs a = FRESH_ARGS(); p0_prologue(F, a); } SEAM(0);

    if (IN(1)) {
        KArgs a = FRESH_ARGS(); unsigned char* ws = a->ws;
        pg8::Gemm g{(const pg8::bf16_t*)(ws + WS_XN), (const pg8::bf16_t*)(ws + WS_WIN), T, NCOL1, DM}; pg8::StaticOrder S; S.init(T, NCOL1, F.G, (int)blockIdx.x);
        pg8::EpiP1 E{(pg8::bf16_t*)(ws + WS_QA), (pg8::bf16_t*)(ws + WS_KA), (pg8::bf16_t*)(ws + WS_VA), (pg8::bf16_t*)(ws + WS_QB), (pg8::bf16_t*)(ws + WS_KB), (pg8::bf16_t*)(ws + WS_VB), (pg8::bf16_t*)(ws + WS_GT), a->in[13]};
        pg8::gemm_phase<pg8::EpiP1, pg8::StaticOrder, true, true>(L + SCR_OFF, g, S, E);
    } SEAM(1);

    if (IN(2)) { KArgs a = FRESH_ARGS(); p1b_normrope(F, a); } SEAM(2);

    if (IN(3)) { KArgs a = FRESH_ARGS(); p2_attention(F, a); } SEAM(3);

    if (IN(4)) {
        pg8::StaticOrder S; S.init(T, DM, F.G, (int)blockIdx.x);
        { KArgs a = FRESH_ARGS(); unsigned char* ws = a->ws;
          pg8::Gemm g{(const pg8::bf16_t*)(ws + WS_QA), (const pg8::bf16_t*)(ws + WS_WA), T, DM, 1024};
          pg8::EpiGateA E{(const pg8::bf16_t*)(ws + WS_GT), a->out};
          pg8::gemm_phase<pg8::EpiGateA, pg8::StaticOrder, true, true>(L + SCR_OFF, g, S, E); }
        __syncthreads();
        { KArgs a = FRESH_ARGS(); unsigned char* ws = a->ws;
          pg8::Gemm g{(const pg8::bf16_t*)(ws + WS_QB), (const pg8::bf16_t*)(ws + WS_WB), T, DM, 1024};
          pg8::EpiGateB E{(const pg8::bf16_t*)(ws + WS_GT), a->out, (pg8::bf16_t*)(ws + WS_XN)};
          pg8::gemm_phase<pg8::EpiGateB, pg8::StaticOrder, true, true>(L + SCR_OFF, g, S, E); }
    } SEAM(4);

    if (IN(5)) {
        KArgs a = FRESH_ARGS(); unsigned char* ws = a->ws;
        pg8::Gemm g{(const pg8::bf16_t*)(ws + WS_XN), (const pg8::bf16_t*)(ws + WS_WO), T, DM, DM}; pg8::StaticOrder S; S.init(T, DM, F.G, (int)blockIdx.x);
        pg8::EpiOut E{a->in[0], a->out, (float*)(ws + WS_SSQ)};
        pg8::gemm_phase<pg8::EpiOut, pg8::StaticOrder, true, true>(L + SCR_OFF, g, S, E);
    } SEAM(5);

    if (IN(6)) { KArgs a = FRESH_ARGS(); p4_router(F, a); } SEAM(6);

    if (IN(7)) { KArgs a = FRESH_ARGS(); moe_table(F, a); p4b_gather(F, a); } SEAM(7);

    if (IN(8)) {
        KArgs a = FRESH_ARGS(); unsigned char* ws = a->ws;
        moe_table(F, a);
        pg8::Gemm g{(const pg8::bf16_t*)(ws + WS_XG), (const pg8::bf16_t*)(ws + WS_W13), PMAX * 256, 1024, DM};
        pg8::MoeOrder<4, (long)1024 * 2048 * 2> S{(const LAS int*)(L + MOE_OFF), F.G, (int)blockIdx.x};
        pg8::EpiG1 E{(pg8::bf16_t*)(ws + WS_XN)};
        pg8::gemm_phase<pg8::EpiG1, pg8::MoeOrder<4, (long)1024 * 2048 * 2>, true, true>(L + SCR_OFF, g, S, E);
    } SEAM(8);

    if (IN(9)) {
        KArgs a = FRESH_ARGS(); unsigned char* ws = a->ws;
        moe_table(F, a);
        pg8::Gemm g{(const pg8::bf16_t*)(ws + WS_XN), (const pg8::bf16_t*)(ws + WS_W2), PMAX * 256, DM, FF};
        pg8::MoeOrder<8, (long)2048 * 512 * 2> S{(const LAS int*)(L + MOE_OFF), F.G, (int)blockIdx.x};
        pg8::EpiG2 E{(pg8::bf16_t*)(ws + WS_YC), (const float*)(ws + WS_ROWW)};
        pg8::gemm_phase<pg8::EpiG2, pg8::MoeOrder<8, (long)2048 * 512 * 2>, true, true>(L + SCR_OFF, g, S, E);
    } SEAM(9);

    if (IN(10)) { KArgs a = FRESH_ARGS(); p6_final(F, a); }
#if PROBE_MASK
    if (blockIdx.x == 0 && F.tid == 0) { unsigned tot = 0;
        for (int k = 0; k < 12; ++k) if ((PROBE_MASK >> k) & 1) tot += MISC[10 + k];
        const unsigned long long t0 = __builtin_amdgcn_s_memrealtime(), span = (unsigned long long)tot * PROBE_MUL;
        while (__builtin_amdgcn_s_memrealtime() - t0 < span) __builtin_amdgcn_s_sleep(8); }
#endif
#undef IN
#undef SEAM
}

extern "C" void kernel_launch(void* const* d_in, const int* in_sizes, int n_in, void* d_out, int out_size, void* d_ws, size_t ws_size, hipStream_t stream) {
    static int grid = 0;
    if (grid == 0) {
        if (n_in != 22 || in_sizes[0] != T * DM || out_size != T * DM || ws_size < WS_END) { fprintf(stderr, "kernel_launch: shape mismatch (n_in %d, in0 %d, out %d, ws %zu)\n", n_in, n_in > 0 ? in_sizes[0] : -1, out_size, ws_size); grid = -1; return; }
        int dev = 0, cus = 0, per_cu = 0;
        if (hipGetDevice(&dev) != hipSuccess || hipDeviceGetAttribute(&cus, hipDeviceAttributeMultiprocessorCount, dev) != hipSuccess) { grid = -1; return; }
        if (hipFuncSetAttribute((const void*)fwd_kernel, hipFuncAttributeMaxDynamicSharedMemorySize, LDS_BYTES) != hipSuccess) { fprintf(stderr, "kernel_launch: hipFuncSetAttribute failed\n"); grid = -1; return; }
        if (hipOccupancyMaxActiveBlocksPerMultiprocessor(&per_cu, (const void*)fwd_kernel, NWAVES * 64, LDS_BYTES) != hipSuccess || per_cu < 1) fprintf(stderr, "kernel_launch: occupancy query says %d\n", per_cu);
        (void)hipGetLastError();
        grid = cus;
    }
    if (grid < 0) return;
    if (hipMemsetAsync((char*)d_ws + WS_CTL, 0, CTL_ZERO_BYTES, stream) != hipSuccess) return;
    Args a{};
    for (int i = 0; i < 22; ++i) a.in[i] = (const float*)d_in[i];
    a.out = (float*)d_out; a.ws = (unsigned char*)d_ws; a.pad = 0;
#if MK_ONE_LAUNCH
    a.ph_lo = 0; a.ph_hi = N_PHASES; a.li = 0;
    hipLaunchKernelGGL(fwd_kernel, dim3(grid), dim3(NWAVES * 64), LDS_BYTES, stream, a);
#else
    for (int li = 0; li < N_PHASES; ++li) { a.ph_lo = li; a.ph_hi = li + 1; a.li = li;
        hipLaunchKernelGGL(fwd_kernel, dim3(grid), dim3(NWAVES * 64), LDS_BYTES, stream, a); }
#endif
    const hipError_t le = hipPeekAtLastError();
    if (le != hipSuccess) fprintf(stderr, "kernel_launch: launch failed: %s\n", hipGetErrorName(le));
}
```

```cpp
#include <hip/hip_runtime.h>
#include <cstdio>
#include <cstdint>
#include <cmath>

namespace pg8 {
#define PG8_LAS __attribute__((address_space(3)))
typedef unsigned short bf16_t;
typedef short bf16x8 __attribute__((ext_vector_type(8)));
typedef float f32x4 __attribute__((ext_vector_type(4)));
typedef unsigned u32x4 __attribute__((ext_vector_type(4)));
constexpr int BM = 256, BK = 64, HALF = 128, HTB = HALF * BK * 2  , STAGE_BYTES = 8 * HTB, NXCD = 8, WGM = 8;

__host__ __device__ __forceinline__ int lds_byte(int r, int c) { const int st = (r >> 4) * 2 + (c >> 5), rr = r & 15, cc = c & 31, ob = rr * 64 + cc * 2; return st * 1024 + (ob ^ (((ob >> 9) & 1) << 5)); }
__host__ __device__ __forceinline__ void stage_rc(int b, int& R, int& C) { const int st = b / 1024, sb = b % 1024, swz = sb ^ (((sb >> 9) & 1) << 5); R = (st >> 1) * 16 + swz / 64; C = (st & 1) * 32 + (swz % 64) / 2; }
__host__ __device__ __forceinline__ int perm32(int rho) { const int n = rho >> 4, i = rho & 15; return 8 * (i >> 2) + 4 * n + (i & 3); }

struct Unit { int pm, pn; long bofs; int ex; };
struct Gemm { const bf16_t* A; const bf16_t* Bt; int M, N, K; };

struct StaticOrder {
    static constexpr bool GATHER = false;
    int nM, nN, nwg, G, c;
    __device__ __forceinline__ unsigned row_byteoff(const Unit&, int, int) const { return 0u; }
    __host__ __device__ void init(int M, int N, int G_, int c_) { nM = M / BM; nN = N / BM; nwg = nM * nN; G = G_; c = c_; }
    __host__ __device__ bool next(int i, Unit& u) const {
        const long L = (long)i * G + c; if (L >= nwg) return false;
        int wgid = (int)L; { const int q = nwg / NXCD, r = nwg % NXCD, xcd = wgid % NXCD, off = wgid / NXCD; wgid = (xcd < r ? xcd * (q + 1) : r * (q + 1) + (xcd - r) * q) + off; }
        const int nig = WGM * nN, gid = wgid / nig, fm = gid * WGM, gsz = (nM - fm) < WGM ? (nM - fm) : WGM;
        u.pm = fm + ((wgid % nig) % gsz); u.pn = (wgid % nig) / gsz; u.bofs = 0; u.ex = 0; return true;
    }
    __device__ __forceinline__ void a_ready(const Unit&) const {}
    __device__ __forceinline__ void done(const Unit&) const {}
};

typedef float f32x2v_ __attribute__((ext_vector_type(2))); typedef __bf16 bf16x2v_ __attribute__((ext_vector_type(2)));
__device__ __forceinline__ unsigned cvt_pk_bf16(float lo, float hi) { f32x2v_ v = {lo, hi}; bf16x2v_ b = __builtin_convertvector(v, bf16x2v_); return __builtin_bit_cast(unsigned, b); }
typedef float f32x2 __attribute__((ext_vector_type(2)));

__device__ __forceinline__ float bf_lo(unsigned w) { return __uint_as_float(w << 16); }
__device__ __forceinline__ float bf_hi(unsigned w) { return __uint_as_float(w & 0xffff0000u); }
__device__ __forceinline__ float sigmoid_f(float x) { return __builtin_amdgcn_rcpf(1.0f + __builtin_amdgcn_exp2f(-1.4426950408889634f * x)); }

struct EpiP1 {
    static constexpr bool PERM = true, AFTER_DRAIN = false, MIDK = false;
    bf16_t *QA, *KA, *VA, *QB, *KB, *VB, *GT; const float* bgate;
    __device__ __forceinline__ void operator()(const f32x4 (&acc)[2][2][4][2], const Unit& u, int wr, int wc, int fr, int fq) const {
        const int pn = u.pn; bf16_t* base; int ld, colt; bool gate = false;
        if (pn < 4)       { base = QA; ld = 1024; colt = pn * 256; }
        else if (pn == 4) { base = KA; ld = 256;  colt = 0; }
        else if (pn == 5) { base = VA; ld = 256;  colt = 0; }
        else if (pn < 10) { base = QB; ld = 1024; colt = (pn - 6) * 256; }
        else if (pn < 14) { base = KB; ld = 1024; colt = (pn - 10) * 256; }
        else if (pn < 18) { base = VB; ld = 1024; colt = (pn - 14) * 256; }
        else              { base = GT; ld = 4096; colt = (pn - 18) * 256; gate = true; }
        const int row0 = u.pm * BM + wr * 64 + fr, col0 = colt + wc * 32 + 8 * fq;
        f32x4 bv[2][2];
#pragma unroll
        for (int bj = 0; bj < 2; ++bj)
#pragma unroll
            for (int n = 0; n < 2; ++n) bv[bj][n] = gate ? *(const f32x4*)(bgate + col0 + bj * HALF + 4 * n) : (f32x4){0.f, 0.f, 0.f, 0.f};
#pragma unroll
        for (int ai = 0; ai < 2; ++ai)
#pragma unroll
            for (int m = 0; m < 4; ++m) { bf16_t* rowp = base + (size_t)(row0 + ai * HALF + m * 16) * ld + col0;
#pragma unroll
                for (int bj = 0; bj < 2; ++bj) { f32x4 v0 = acc[ai][bj][m][0] + bv[bj][0], v1 = acc[ai][bj][m][1] + bv[bj][1];
                    if (gate) {
#pragma unroll
                        for (int e = 0; e < 4; ++e) { v0[e] = sigmoid_f(v0[e]); v1[e] = sigmoid_f(v1[e]); } }
                    u32x4 w; w.x = cvt_pk_bf16(v0[0], v0[1]); w.y = cvt_pk_bf16(v0[2], v0[3]); w.z = cvt_pk_bf16(v1[0], v1[1]); w.w = cvt_pk_bf16(v1[2], v1[3]);
                    *(u32x4*)(rowp + bj * HALF) = w; } }
    }
};

struct EpiMerge {
    static constexpr bool PERM = true, AFTER_DRAIN = false, MIDK = true;
    const bf16_t* GT; bf16_t* MG;
    __device__ __forceinline__ void mid(f32x4 (&acc)[2][2][4][2], const Unit& u, int wr, int wc, int fr, int fq) const {
        asm volatile("" : "+v"(fr), "+v"(fq));
        const int row0 = u.pm * BM + wr * 64 + fr, col0 = u.pn * BM + wc * 32 + 8 * fq;
#pragma unroll
        for (int ai = 0; ai < 2; ++ai)
#pragma unroll
            for (int m = 0; m < 4; ++m) { const size_t r = (size_t)(row0 + ai * HALF + m * 16);
#pragma unroll
                for (int bj = 0; bj < 2; ++bj) { const u32x4 ga = *(const u32x4*)(GT + r * 4096 + col0 + bj * HALF), gb = *(const u32x4*)(GT + r * 4096 + 2048 + col0 + bj * HALF);
#define PG8_RT(A_, B_) ((A_) * __builtin_amdgcn_rcpf(fmaxf((B_), 1e-30f)))
                    acc[ai][bj][m][0][0] *= PG8_RT(bf_lo(ga.x), bf_lo(gb.x)); acc[ai][bj][m][0][1] *= PG8_RT(bf_hi(ga.x), bf_hi(gb.x)); acc[ai][bj][m][0][2] *= PG8_RT(bf_lo(ga.y), bf_lo(gb.y)); acc[ai][bj][m][0][3] *= PG8_RT(bf_hi(ga.y), bf_hi(gb.y));
                    acc[ai][bj][m][1][0] *= PG8_RT(bf_lo(ga.z), bf_lo(gb.z)); acc[ai][bj][m][1][1] *= PG8_RT(bf_hi(ga.z), bf_hi(gb.z)); acc[ai][bj][m][1][2] *= PG8_RT(bf_lo(ga.w), bf_lo(gb.w)); acc[ai][bj][m][1][3] *= PG8_RT(bf_hi(ga.w), bf_hi(gb.w));
#undef PG8_RT
                }
                if (m == 3) asm volatile("" ::: "memory"); }
    }
    __device__ __forceinline__ void operator()(const f32x4 (&acc)[2][2][4][2], const Unit& u, int wr, int wc, int fr, int fq) const {
        asm volatile("" : "+v"(fr), "+v"(fq));
        const int row0 = u.pm * BM + wr * 64 + fr, col0 = u.pn * BM + wc * 32 + 8 * fq;
#pragma unroll
        for (int ai = 0; ai < 2; ++ai)
#pragma unroll
            for (int m = 0; m < 4; ++m) { const size_t r = (size_t)(row0 + ai * HALF + m * 16);
#pragma unroll
                for (int bj = 0; bj < 2; ++bj) { const u32x4 g = *(const u32x4*)(GT + r * 4096 + 2048 + col0 + bj * HALF);
                    f32x4 v0 = acc[ai][bj][m][0], v1 = acc[ai][bj][m][1];
                    v0[0] *= fmaxf(bf_lo(g.x), 1e-30f); v0[1] *= fmaxf(bf_hi(g.x), 1e-30f); v0[2] *= fmaxf(bf_lo(g.y), 1e-30f); v0[3] *= fmaxf(bf_hi(g.y), 1e-30f);
                    v1[0] *= fmaxf(bf_lo(g.z), 1e-30f); v1[1] *= fmaxf(bf_hi(g.z), 1e-30f); v1[2] *= fmaxf(bf_lo(g.w), 1e-30f); v1[3] *= fmaxf(bf_hi(g.w), 1e-30f);
                    u32x4 w; w.x = cvt_pk_bf16(v0[0], v0[1]); w.y = cvt_pk_bf16(v0[2], v0[3]); w.z = cvt_pk_bf16(v1[0], v1[1]); w.w = cvt_pk_bf16(v1[2], v1[3]);
                    *(u32x4*)(MG + r * 2048 + col0 + bj * HALF) = w; }
                if (m & 1) asm volatile("" ::: "memory"); }
    }
};
struct EpiOut {
    static constexpr bool PERM = false, AFTER_DRAIN = false, MIDK = false;
    const float* X; float* X1; float* SSQ;
    __device__ __forceinline__ void operator()(const f32x4 (&acc)[2][2][4][2], const Unit& u, int wr, int wc, int fr, int fq) const {
        const int row0 = u.pm * BM + wr * 64 + fr, col0 = u.pn * BM + wc * 32 + 4 * fq;
#pragma unroll
        for (int ai = 0; ai < 2; ++ai)
#pragma unroll
            for (int m = 0; m < 4; ++m) { const size_t r = (size_t)(row0 + ai * HALF + m * 16); float s = 0.f;
#pragma unroll
                for (int bj = 0; bj < 2; ++bj)
#pragma unroll
                    for (int n = 0; n < 2; ++n) { const size_t off = r * 2048 + col0 + bj * HALF + n * 16;
                        const f32x4 v = *(const f32x4*)(X + off) + acc[ai][bj][m][n]; *(f32x4*)(X1 + off) = v;
                        s += (v[0] * v[0] + v[1] * v[1]) + (v[2] * v[2] + v[3] * v[3]); }
                s += __shfl_xor(s, 16); s += __shfl_xor(s, 32);
                if (fq == 0) SSQ[r * 32 + u.pn * 4 + wc] = s;
                if (m & 1) asm volatile("" ::: "memory"); }
    }
};
struct EpiG1 {
    static constexpr bool PERM = true, AFTER_DRAIN = false, MIDK = false;
    bf16_t* U;
    __device__ __forceinline__ void operator()(const f32x4 (&acc)[2][2][4][2], const Unit& u, int wr, int wc, int fr, int fq) const {
        const int row0 = u.pm * BM + wr * 64 + fr, col0 = u.pn * HALF + wc * 32 + 8 * fq;
#pragma unroll
        for (int ai = 0; ai < 2; ++ai)
#pragma unroll
            for (int m = 0; m < 4; ++m) { f32x4 v0, v1;
#pragma unroll
                for (int e = 0; e < 4; ++e) { const float g0 = acc[ai][0][m][0][e], g1 = acc[ai][0][m][1][e];
                    v0[e] = g0 * sigmoid_f(g0) * acc[ai][1][m][0][e]; v1[e] = g1 * sigmoid_f(g1) * acc[ai][1][m][1][e]; }
                u32x4 w; w.x = cvt_pk_bf16(v0[0], v0[1]); w.y = cvt_pk_bf16(v0[2], v0[3]); w.z = cvt_pk_bf16(v1[0], v1[1]); w.w = cvt_pk_bf16(v1[2], v1[3]);
                *(u32x4*)(U + (size_t)(row0 + ai * HALF + m * 16) * 512 + col0) = w; }
    }
};
constexpr int MOE_LCAP = 32768;
struct EpiG2 {
    static constexpr bool PERM = true, AFTER_DRAIN = false, MIDK = false;
    bf16_t* YC; const float* LW; const PG8_LAS int* tab;
    __device__ __forceinline__ void operator()(const f32x4 (&acc)[2][2][4][2], const Unit& u, int wr, int wc, int fr, int fq) const {
        const int row0 = u.pm * BM + wr * 64 + fr, col0 = u.pn * BM + wc * 32 + 8 * fq;
        const int slot0 = (u.pm - tab[32 + u.ex]) * BM + wr * 64 + fr, cnt = tab[u.ex];
#pragma unroll
        for (int ai = 0; ai < 2; ++ai)
#pragma unroll
            for (int m = 0; m < 4; ++m) { const size_t r = (size_t)(row0 + ai * HALF + m * 16); const int slot = slot0 + ai * HALF + m * 16;
                const float wt = slot < cnt ? LW[(size_t)u.ex * MOE_LCAP + slot] : 0.f;
#pragma unroll
                for (int bj = 0; bj < 2; ++bj) { const f32x4 v0 = acc[ai][bj][m][0] * wt, v1 = acc[ai][bj][m][1] * wt;
                    u32x4 w; w.x = cvt_pk_bf16(v0[0], v0[1]); w.y = cvt_pk_bf16(v0[2], v0[3]); w.z = cvt_pk_bf16(v1[0], v1[1]); w.w = cvt_pk_bf16(v1[2], v1[3]);
                    *(u32x4*)(YC + r * 2048 + col0 + bj * HALF) = w; } }
    }
};
template <int NT, long BSTRIDE  , bool GATHER_> struct MoeOrder {
    static constexpr bool GATHER = GATHER_;
    const PG8_LAS int* tab; int G, c; const int* LENT;
    __device__ __forceinline__ bool next(int i, Unit& u) const {
        const int P = tab[64]; const long L = (long)i * G + c; if (L >= (long)P * NT) return false;
        const int p = (int)(L / NT); int e = 0;
#pragma unroll 1
        for (int k = 1; k < 32; ++k) if (tab[32 + k] <= p) e = k;
        u.pm = p; u.pn = (int)(L % NT); u.bofs = (long)e * BSTRIDE; u.ex = e; return true;
    }
    __device__ __forceinline__ unsigned row_byteoff(const Unit& u, int row, int K) const {
        const int slot = (u.pm - tab[32 + u.ex]) * BM + row; const int tok = slot < tab[u.ex] ? (LENT[(size_t)u.ex * MOE_LCAP + slot] >> 1) : 0;
        return (unsigned)tok * (unsigned)(K * 2);
    }
    __device__ __forceinline__ void a_ready(const Unit&) const {}
    __device__ __forceinline__ void done(const Unit&) const {}
};

template <class Epi, class Sched, bool ALIGN_EPI = false, bool SP2 = false>
__device__ __forceinline__ void gemm_phase(PG8_LAS unsigned char* lds, const Gemm g, const Sched& S, const Epi& E) {
    const int tid = threadIdx.x, wid = __builtin_amdgcn_readfirstlane(tid >> 6), lane = tid & 63, wr = wid >> 2, wc = wid & 3, fr = lane & 15, fq = lane >> 4;
    const int K = g.K, nt = K / BK;
    unsigned voffA[2], voffB[2];
#pragma unroll
    for (int i = 0; i < 2; ++i) { int R, C; stage_rc(tid * 16 + i * 8192, R, C); const int Rb = Epi::PERM ? ((R & ~31) + perm32(R & 31)) : R;
        voffA[i] = (unsigned)(R * K + C) * 2u; voffB[i] = (unsigned)(Rb * K + C) * 2u; }
    const size_t kstep = (size_t)(BK * 2);
    const size_t hstep = (size_t)HALF * K * 2;
    const size_t tstep = 2 * hstep;
    const unsigned ldsw = (unsigned)wid * 1024u;
    const int aoff = lds_byte(wr * 64 + fr, fq * 8), boff = lds_byte(wc * 32 + fr, fq * 8);
#define PG8_SA(b, h) (((b) * 2 + (h)) * HTB)
#define PG8_SB(b, h) ((4 + (b) * 2 + (h)) * HTB)
#define PG8_STAGE(bufoff, gbase, voff) do { _Pragma("unroll") for (int _i = 0; _i < 2; ++_i) \
        __builtin_amdgcn_global_load_lds((const unsigned*)((const char*)(gbase) + (voff)[_i]), (PG8_LAS unsigned*)(lds + (bufoff) + ldsw + _i * 8192), 16, 0, 0); } while (0)
#define PG8_STAGEA(bufoff, gbase, h, nx) do { if constexpr (Sched::GATHER) { _Pragma("unroll") for (int _i = 0; _i < 2; ++_i) { const unsigned vo_ = (nx) ? voffAn[h][_i] : voffAc[h][_i]; \
        __builtin_amdgcn_global_load_lds((const unsigned*)((const char*)(gbase) + vo_), (PG8_LAS unsigned*)(lds + (bufoff) + ldsw + _i * 8192), 16, 0, 0); } } \
    else { PG8_STAGE(bufoff, (gbase) + (h) * hstep, voffA); } } while (0)
#define PG8_LDA(dst, b, h) do { _Pragma("unroll") for (int m = 0; m < 4; ++m) _Pragma("unroll") for (int k = 0; k < 2; ++k) dst[m][k] = *(const PG8_LAS bf16x8*)(lds + PG8_SA(b, h) + aoff + m * 2048 + k * 1024); } while (0)
#define PG8_LDB(dst, b, h) do { _Pragma("unroll") for (int n = 0; n < 2; ++n) _Pragma("unroll") for (int k = 0; k < 2; ++k) dst[n][k] = *(const PG8_LAS bf16x8*)(lds + PG8_SB(b, h) + boff + n * 2048 + k * 1024); } while (0)
#define PG8_MMA(ai, bj, At, Bt) do { __builtin_amdgcn_s_setprio(1); _Pragma("unroll") for (int m = 0; m < 4; ++m) _Pragma("unroll") for (int n = 0; n < 2; ++n) _Pragma("unroll") for (int k = 0; k < 2; ++k) \
        acc[ai][bj][m][n] = __builtin_amdgcn_mfma_f32_16x16x32_bf16(Bt[n][k], At[m][k], acc[ai][bj][m][n], 0, 0, 0); __builtin_amdgcn_s_setprio(0); } while (0)
#define PG8_WAIT_V(n) asm volatile("s_waitcnt vmcnt(" #n ")" ::: "memory")
#define PG8_WAIT_L(n) asm volatile("s_waitcnt lgkmcnt(" #n ")" ::: "memory")
#define PG8_BAR __builtin_amdgcn_s_barrier()
#define PG8_SCHED __builtin_amdgcn_sched_barrier(0)
    Unit cur, nxt; int ui = 0;
    if (!S.next(0, cur)) return;
    f32x4 acc[2][2][4][2];
#pragma unroll
    for (int a = 0; a < 2; ++a)
#pragma unroll
        for (int b = 0; b < 2; ++b)
#pragma unroll
            for (int m = 0; m < 4; ++m)
#pragma unroll
                for (int n = 0; n < 2; ++n) acc[a][b][m][n] = (f32x4){0.f, 0.f, 0.f, 0.f};
    bf16x8 At[4][2], B0[2][2], B1[2][2];
    const char* cA = (const char*)g.A + (Sched::GATHER ? (size_t)0 : (size_t)cur.pm * tstep); const char* cB = (const char*)g.Bt + (size_t)cur.pn * tstep + cur.bofs;
    unsigned voffAc[2][2] = {{0u, 0u}, {0u, 0u}}, voffAn[2][2] = {{0u, 0u}, {0u, 0u}};
    if constexpr (Sched::GATHER) {
#pragma unroll
        for (int h = 0; h < 2; ++h)
#pragma unroll
            for (int i = 0; i < 2; ++i) { int R, C; stage_rc(tid * 16 + i * 8192, R, C); voffAc[h][i] = S.row_byteoff(cur, h * HALF + R, K) + (unsigned)C * 2u; }
    }
    S.a_ready(cur);
    if constexpr (SP2) {
        PG8_STAGE(PG8_SB(0, 0), cB, voffB); PG8_STAGE(PG8_SB(0, 1), cB + hstep, voffB); PG8_STAGEA(PG8_SA(0, 0), cA, 0, false); PG8_STAGEA(PG8_SA(0, 1), cA, 1, false);
        if (wr == 1) PG8_BAR;
        PG8_WAIT_V(2); PG8_BAR;
        PG8_STAGE(PG8_SB(1, 0), cB + kstep, voffB); PG8_STAGEA(PG8_SA(1, 0), cA + kstep, 0, false); PG8_STAGE(PG8_SB(1, 1), cB + hstep + kstep, voffB);
        PG8_WAIT_V(6); PG8_BAR;
    } else {
        PG8_STAGE(PG8_SB(0, 0), cB, voffB); PG8_STAGE(PG8_SA(0, 0), cA, voffA); PG8_STAGE(PG8_SB(0, 1), cB + hstep, voffB); PG8_STAGE(PG8_SA(0, 1), cA + hstep, voffA);
        if (wr == 1) PG8_BAR;
        PG8_WAIT_V(4); PG8_BAR;
        PG8_STAGE(PG8_SB(1, 0), cB + kstep, voffB); PG8_STAGE(PG8_SA(1, 0), cA + kstep, voffA); PG8_STAGE(PG8_SB(1, 1), cB + hstep + kstep, voffB);
        PG8_WAIT_V(6); PG8_BAR;
    }
    for (;;) {
        const bool has_next = S.next(ui + 1, nxt);
        if constexpr (Sched::GATHER) { if (has_next) {
#pragma unroll
            for (int h = 0; h < 2; ++h)
#pragma unroll
                for (int i = 0; i < 2; ++i) { int R, C; stage_rc(tid * 16 + i * 8192, R, C); voffAn[h][i] = S.row_byteoff(nxt, h * HALF + R, K) + (unsigned)C * 2u; } }
            else {
#pragma unroll
            for (int h = 0; h < 2; ++h)
#pragma unroll
                for (int i = 0; i < 2; ++i) voffAn[h][i] = voffAc[h][i]; } }
        const char* nA = Sched::GATHER ? cA : (has_next ? (const char*)g.A + (size_t)nxt.pm * tstep : cA); const char* nB = has_next ? (const char*)g.Bt + (size_t)nxt.pn * tstep + nxt.bofs : cB;
        constexpr int NKH = Epi::MIDK ? 2 : 1;
        int t = 0;
#pragma unroll 1
        for (int kh = 0; kh < NKH; ++kh) {
        const int tend = (NKH == 2 && kh == 0) ? nt / 2 : nt;
#pragma unroll 1
        for (; t < tend; t += 2) {
            const bool last = (t == nt - 2);
            const char* a1 = cA + (size_t)(t + 1) * kstep;
            const char* a2 = last ? nA : cA + (size_t)(t + 2) * kstep; const char* b2 = last ? nB : cB + (size_t)(t + 2) * kstep;
            const char* a3 = a2 + kstep; const char* b3 = b2 + kstep;
            if (last && has_next) S.a_ready(nxt);
            if constexpr (SP2) {
            PG8_LDB(B0, 0, 0); PG8_LDB(B1, 0, 1); PG8_SCHED; PG8_LDA(At, 0, 0); PG8_STAGEA(PG8_SA(1, 1), a1, 1, false);
            PG8_WAIT_V(8); PG8_WAIT_L(0); PG8_BAR; PG8_MMA(0, 0, At, B0); PG8_MMA(0, 1, At, B1); PG8_BAR; PG8_SCHED;
            PG8_LDA(At, 0, 1); PG8_STAGE(PG8_SB(0, 0), b2, voffB); PG8_STAGE(PG8_SB(0, 1), b2 + hstep, voffB); PG8_STAGEA(PG8_SA(0, 0), a2, 0, last);
            PG8_WAIT_V(8); PG8_WAIT_L(0); PG8_BAR; PG8_MMA(1, 0, At, B0); PG8_MMA(1, 1, At, B1); PG8_BAR; PG8_SCHED;
            PG8_LDB(B0, 1, 0); PG8_LDB(B1, 1, 1); PG8_SCHED; PG8_LDA(At, 1, 0); PG8_STAGEA(PG8_SA(0, 1), a2, 1, last);
            PG8_WAIT_V(8); PG8_WAIT_L(0); PG8_BAR; PG8_MMA(0, 0, At, B0); PG8_MMA(0, 1, At, B1); PG8_BAR; PG8_SCHED;
            PG8_LDA(At, 1, 1); PG8_STAGE(PG8_SB(1, 0), b3, voffB); PG8_STAGE(PG8_SB(1, 1), b3 + hstep, voffB); PG8_STAGEA(PG8_SA(1, 0), a3, 0, last);
            PG8_WAIT_V(8); PG8_WAIT_L(0); PG8_BAR; PG8_MMA(1, 0, At, B0); PG8_MMA(1, 1, At, B1); PG8_BAR; PG8_SCHED;
            } else {
            PG8_LDB(B0, 0, 0); PG8_SCHED; PG8_LDA(At, 0, 0); PG8_STAGE(PG8_SA(1, 1), a1 + hstep, voffA);
            PG8_WAIT_L(8); PG8_BAR; PG8_WAIT_L(0); PG8_MMA(0, 0, At, B0); PG8_BAR; PG8_SCHED;
            PG8_LDB(B1, 0, 1); PG8_STAGE(PG8_SB(0, 0), b2, voffB);
            PG8_BAR; PG8_WAIT_L(0); PG8_MMA(0, 1, At, B1); PG8_BAR;
            PG8_LDA(At, 0, 1); PG8_STAGE(PG8_SA(0, 0), a2, voffA);
            PG8_BAR; PG8_WAIT_L(0); PG8_MMA(1, 0, At, B0); PG8_BAR; PG8_SCHED;
            PG8_STAGE(PG8_SB(0, 1), b2 + hstep, voffB);
            PG8_WAIT_V(6); PG8_BAR; PG8_MMA(1, 1, At, B1); PG8_BAR;
            PG8_LDB(B0, 1, 0); PG8_SCHED; PG8_LDA(At, 1, 0); PG8_STAGE(PG8_SA(0, 1), a2 + hstep, voffA);
            PG8_WAIT_L(8); PG8_BAR; PG8_WAIT_L(0); PG8_MMA(0, 0, At, B0); PG8_BAR; PG8_SCHED;
            PG8_LDB(B1, 1, 1); PG8_STAGE(PG8_SB(1, 0), b3, voffB);
            PG8_BAR; PG8_WAIT_L(0); PG8_MMA(0, 1, At, B1); PG8_BAR;
            PG8_LDA(At, 1, 1); PG8_STAGE(PG8_SA(1, 0), a3, voffA);
            PG8_BAR; PG8_WAIT_L(0); PG8_MMA(1, 0, At, B0); PG8_BAR; PG8_SCHED;
            PG8_STAGE(PG8_SB(1, 1), b3 + hstep, voffB);
            PG8_WAIT_V(6); PG8_BAR; PG8_MMA(1, 1, At, B1); PG8_BAR;
            }
        }
        if constexpr (Epi::MIDK) { if (kh == 0) E.mid(acc, cur, wr, wc, fr, fq); }
        }
        if constexpr (ALIGN_EPI) { if (wr == 0) PG8_BAR; }
        if constexpr (!Epi::AFTER_DRAIN) { E(acc, cur, wr, wc, fr, fq); S.done(cur); }
        if (!has_next) break;
#pragma unroll
        for (int a = 0; a < 2; ++a)
#pragma unroll
            for (int b = 0; b < 2; ++b)
#pragma unroll
                for (int m = 0; m < 4; ++m)
#pragma unroll
                    for (int n = 0; n < 2; ++n) acc[a][b][m][n] = (f32x4){0.f, 0.f, 0.f, 0.f};
        cur = nxt; cA = nA; cB = nB; ++ui;
        if constexpr (Sched::GATHER) {
#pragma unroll
            for (int h = 0; h < 2; ++h)
#pragma unroll
                for (int i = 0; i < 2; ++i) voffAc[h][i] = voffAn[h][i]; }
        if constexpr (ALIGN_EPI) { if (wr == 1) PG8_BAR; }
    }
    PG8_WAIT_V(0);
    if constexpr (!ALIGN_EPI) { if (wr == 0) PG8_BAR; }
    PG8_BAR;
    if constexpr (Epi::AFTER_DRAIN) { E.fused(acc, cur, wr, wc, fr, fq, lds, wid, lane); S.done(cur); }
#undef PG8_SA
#undef PG8_SB
#undef PG8_STAGE
#undef PG8_STAGEA
#undef PG8_LDA
#undef PG8_LDB
#undef PG8_MMA
#undef PG8_WAIT_V
#undef PG8_WAIT_L
#undef PG8_BAR
#undef PG8_SCHED
}
}

namespace att {
typedef unsigned short bf16;
using bf16x8 = __attribute__((ext_vector_type(8))) short;
using s16x4  = __attribute__((ext_vector_type(4))) short;
using f32x16 = __attribute__((ext_vector_type(16))) float;
using u32x4  = __attribute__((ext_vector_type(4))) unsigned;
constexpr int NW = 8, QBLK = 32, KVBLK = 64, DV = 128;
constexpr int SHM_V = KVBLK * DV * 2;
constexpr int OFF_V = 0, OFF_K = 3 * SHM_V, OFF_STASH = 73728;
constexpr float THR = 8.f;
#define ATT_SBAR() __builtin_amdgcn_sched_barrier(0)
template <int DQK> __device__ __forceinline__ int kswz(int row, int colB) { return row * (DQK * 2) + (colB ^ ((DQK == 128 ? ((row & 7) | (((row >> 4) & 1) << 3)) : ((row >> 1) & 7)) << 4)); }
__device__ __forceinline__ int crow(int r, int hi) { return (r & 3) + 8 * (r >> 2) + 4 * hi; }
typedef float f32x2_t __attribute__((ext_vector_type(2))); typedef __bf16 bf16x2_t __attribute__((ext_vector_type(2)));
__device__ __forceinline__ unsigned cvtpk(float lo, float hi) { f32x2_t v = {lo, hi}; bf16x2_t b = __builtin_convertvector(v, bf16x2_t); return __builtin_bit_cast(unsigned, b); }

template <int DQK> __device__ __forceinline__ void partialSM(f32x16& p0, f32x16& p1, float& m_reg, float& mn, float& alpha) {
  constexpr float SCALE = (DQK == 128) ? 0.088388347648318440f : 0.125f;
  constexpr float C = SCALE * 1.4426950408889634f;
  float pmax = p0[0];
#pragma unroll
  for (int r = 1; r < 16; ++r) pmax = fmaxf(pmax, p0[r]);
#pragma unroll
  for (int r = 0; r < 16; ++r) pmax = fmaxf(pmax, p1[r]);
  { auto rr = __builtin_amdgcn_permlane32_swap(__float_as_uint(pmax), __float_as_uint(pmax), false, false);
    pmax = fmaxf(__uint_as_float(rr[0]), __uint_as_float(rr[1])); }
  if (__builtin_expect(__all(pmax - m_reg <= THR / SCALE), 1)) { mn = m_reg; alpha = 1.f; }
  else { mn = fmaxf(m_reg, pmax); alpha = __builtin_amdgcn_exp2f((m_reg - mn) * C); m_reg = mn; }
  const float mnC = -mn * C;
#pragma unroll
  for (int r = 0; r < 16; ++r) p0[r] = fmaf(p0[r], C, mnC);
#pragma unroll
  for (int r = 0; r < 16; ++r) p1[r] = fmaf(p1[r], C, mnC);
#pragma unroll
  for (int r = 0; r < 16; ++r) p0[r] = __builtin_amdgcn_exp2f(p0[r]);
}
__device__ __forceinline__ void finishSM(f32x16& p0, f32x16& p1, float alpha, float& l_reg, bf16x8& pa0, bf16x8& pa1, bf16x8& pa2, bf16x8& pa3) {
#pragma unroll
  for (int r = 0; r < 16; ++r) p1[r] = __builtin_amdgcn_exp2f(p1[r]);
  float ps = 0;
#pragma unroll
  for (int r = 0; r < 16; ++r) ps += p0[r];
#pragma unroll
  for (int r = 0; r < 16; ++r) ps += p1[r];
  { auto rr = __builtin_amdgcn_permlane32_swap(__float_as_uint(ps), __float_as_uint(ps), false, false);
    ps = __uint_as_float(rr[0]) + __uint_as_float(rr[1]); }
  l_reg = l_reg * alpha + ps;
#define ATT_PK4(P, BASE, OUT) do { unsigned a0 = cvtpk(P[BASE + 0], P[BASE + 1]), a1 = cvtpk(P[BASE + 2], P[BASE + 3]);   \
    unsigned b0 = cvtpk(P[BASE + 4], P[BASE + 5]), b1 = cvtpk(P[BASE + 6], P[BASE + 7]);                              \
    auto r0 = __builtin_amdgcn_permlane32_swap(a0, b0, false, false); auto r1 = __builtin_amdgcn_permlane32_swap(a1, b1, false, false); \
    u32x4 w = {r0[0], r1[0], r0[1], r1[1]}; OUT = *reinterpret_cast<bf16x8*>(&w); } while (0)
  ATT_PK4(p0, 0, pa0); ATT_PK4(p0, 8, pa1); ATT_PK4(p1, 0, pa2); ATT_PK4(p1, 8, pa3);
#undef ATT_PK4
}
template <int DQK> __device__ __forceinline__ void qkt(f32x16& p0, f32x16& p1, const char* Ks, const bf16x8* qr, int r32, int hi) {
  p0 = f32x16{}; p1 = f32x16{};
#pragma unroll
  for (int d0 = 0; d0 < DQK / 16; ++d0) { const int cb = (d0 * 16 + hi * 8) * 2;
    const bf16x8 b0 = *reinterpret_cast<const bf16x8*>(Ks + kswz<DQK>(r32, cb));
    const bf16x8 b1 = *reinterpret_cast<const bf16x8*>(Ks + kswz<DQK>(32 + r32, cb));
    p0 = __builtin_amdgcn_mfma_f32_32x32x16_bf16(b0, qr[d0], p0, 0, 0, 0);
    p1 = __builtin_amdgcn_mfma_f32_32x32x16_bf16(b1, qr[d0], p1, 0, 0, 0); }
}
__device__ __forceinline__ int v_st(int k, int c) { const int kk = (k & ~0xC) | ((k & 4) << 1) | ((k & 8) >> 1); return ((kk >> 3) * 4 + (c >> 5)) * 512 + ((kk & 7) * 32 + (c & 31)) * 2; }
__device__ __forceinline__ int v_rd_base(int lane) { return ((lane & 3) << 3) | (((lane >> 2) & 3) << 6) | (((lane >> 4) & 1) << 5) | (((lane >> 5) & 1) << 8); }
constexpr int v_rd_off(int d0, int ks, int half) { return d0 * 512 + ks * 4096 + half * 2048; }
template <int OFF> __device__ __forceinline__ s16x4 tr_read(int vb) {
  s16x4 r; asm volatile("ds_read_b64_tr_b16 %0, %1 offset:%2" : "=&v"(r) : "v"(vb), "i"(OFF) : "memory"); return r;
}
typedef __attribute__((address_space(3))) const char* lds_cptr;
typedef short v4i16_t __attribute__((ext_vector_type(4)));
__device__ __forceinline__ s16x4 vtr(lds_cptr p) { return __builtin_bit_cast(s16x4, __builtin_amdgcn_ds_read_tr16_b64_v4i16((__attribute__((address_space(3))) v4i16_t*)p)); }
template <int D0> __device__ __forceinline__ void pv_one(f32x16& od, int vb, bf16x8 pa0, bf16x8 pa1, bf16x8 pa2, bf16x8 pa3) {
  const s16x4 l0 = tr_read<v_rd_off(D0, 0, 0)>(vb), h0 = tr_read<v_rd_off(D0, 0, 1)>(vb), l1 = tr_read<v_rd_off(D0, 1, 0)>(vb), h1 = tr_read<v_rd_off(D0, 1, 1)>(vb);
  const s16x4 l2 = tr_read<v_rd_off(D0, 2, 0)>(vb), h2 = tr_read<v_rd_off(D0, 2, 1)>(vb), l3 = tr_read<v_rd_off(D0, 3, 0)>(vb), h3 = tr_read<v_rd_off(D0, 3, 1)>(vb);
  asm volatile("s_waitcnt lgkmcnt(0)" ::: "memory"); ATT_SBAR();
#define ATT_PK(L, H) (bf16x8){L[0], L[1], L[2], L[3], H[0], H[1], H[2], H[3]}
  od = __builtin_amdgcn_mfma_f32_32x32x16_bf16(pa0, ATT_PK(l0, h0), od, 0, 0, 0);
  od = __builtin_amdgcn_mfma_f32_32x32x16_bf16(pa1, ATT_PK(l1, h1), od, 0, 0, 0);
  od = __builtin_amdgcn_mfma_f32_32x32x16_bf16(pa2, ATT_PK(l2, h2), od, 0, 0, 0);
  od = __builtin_amdgcn_mfma_f32_32x32x16_bf16(pa3, ATT_PK(l3, h3), od, 0, 0, 0);
#undef ATT_PK
}
__device__ __forceinline__ void pv_d0(f32x16* o, int vb, bf16x8 pa0, bf16x8 pa1, bf16x8 pa2, bf16x8 pa3) {
  pv_one<0>(o[0], vb, pa0, pa1, pa2, pa3); pv_one<1>(o[1], vb, pa0, pa1, pa2, pa3); pv_one<2>(o[2], vb, pa0, pa1, pa2, pa3); pv_one<3>(o[3], vb, pa0, pa1, pa2, pa3);
}

constexpr float THRL = 11.5f;
__device__ __forceinline__ void softmax_tile(f32x16& p0, f32x16& p1, f32x16& negm, float& alpha, bool first, bf16x8& pa0, bf16x8& pa1, bf16x8& pa2, bf16x8& pa3) {
  float pmax = fmaxf(p0[0], p1[0]);
#pragma unroll
  for (int r = 1; r < 16; ++r) pmax = fmaxf(pmax, fmaxf(p0[r], p1[r]));
  { auto rr = __builtin_amdgcn_permlane32_swap(__float_as_uint(pmax), __float_as_uint(pmax), false, false);
    pmax = fmaxf(__uint_as_float(rr[0]), __uint_as_float(rr[1])); }
  alpha = 1.f;
  if (__builtin_expect(first || !__all(pmax <= THRL), 0)) {
    const float delta = first ? pmax : fmaxf(pmax, 0.f);
    alpha = first ? 1.f : __builtin_amdgcn_exp2f(-delta);
#pragma unroll
    for (int r = 0; r < 16; ++r) { p0[r] -= delta; p1[r] -= delta; negm[r] -= delta; }
  }
#pragma unroll
  for (int r = 0; r < 16; ++r) { p0[r] = __builtin_amdgcn_exp2f(p0[r]); p1[r] = __builtin_amdgcn_exp2f(p1[r]); }
#define ATT_PK4(P, BASE, OUT) do { unsigned a0 = cvtpk(P[BASE + 0], P[BASE + 1]), a1 = cvtpk(P[BASE + 2], P[BASE + 3]);   \
    unsigned b0 = cvtpk(P[BASE + 4], P[BASE + 5]), b1 = cvtpk(P[BASE + 6], P[BASE + 7]);                              \
    auto r0 = __builtin_amdgcn_permlane32_swap(a0, b0, false, false); auto r1 = __builtin_amdgcn_permlane32_swap(a1, b1, false, false); \
    u32x4 w = {r0[0], r1[0], r0[1], r1[1]}; OUT = *reinterpret_cast<bf16x8*>(&w); } while (0)
  ATT_PK4(p0, 0, pa0); ATT_PK4(p0, 8, pa1); ATT_PK4(p1, 0, pa2); ATT_PK4(p1, 8, pa3);
#undef ATT_PK4
}

template <int DQK> __device__ __forceinline__ void q_prepare(bf16x8 (&qr)[DQK / 16], const float* rope, const float* gain, int s, int hi) {
  typedef float f32x4q __attribute__((ext_vector_type(4)));
  constexpr float CS = (DQK == 128) ? 0.12751743074602467f : 0.18033688011112042f;
  float v[DQK / 16][8];
#pragma unroll
  for (int d0 = 0; d0 < DQK / 16; ++d0) { const u32x4 w = *reinterpret_cast<const u32x4*>(&qr[d0]);
    v[d0][0] = __uint_as_float(w.x << 16); v[d0][1] = __uint_as_float(w.x & 0xffff0000u); v[d0][2] = __uint_as_float(w.y << 16); v[d0][3] = __uint_as_float(w.y & 0xffff0000u);
    v[d0][4] = __uint_as_float(w.z << 16); v[d0][5] = __uint_as_float(w.z & 0xffff0000u); v[d0][6] = __uint_as_float(w.w << 16); v[d0][7] = __uint_as_float(w.w & 0xffff0000u); }
  float mul = CS;
  if constexpr (DQK == 128) {
    float ss = 0.f;
#pragma unroll
    for (int d0 = 0; d0 < 8; ++d0)
#pragma unroll
      for (int j = 0; j < 8; ++j) ss += v[d0][j] * v[d0][j];
    ss += __shfl_xor(ss, 32);
    mul = CS / sqrtf(ss * (1.0f / 128.0f) + 1e-6f);
#pragma unroll
    for (int d0 = 0; d0 < 8; ++d0) { const f32x4q g0 = *(const f32x4q*)(gain + 16 * d0 + 8 * hi), g1 = *(const f32x4q*)(gain + 16 * d0 + 8 * hi + 4);
      v[d0][0] *= g0.x; v[d0][1] *= g0.y; v[d0][2] *= g0.z; v[d0][3] *= g0.w; v[d0][4] *= g1.x; v[d0][5] *= g1.y; v[d0][6] *= g1.z; v[d0][7] *= g1.w; }
  }
#pragma unroll
  for (int blk = 0; blk < DQK / 64; ++blk) {
    const int pos = (DQK == 128) ? (blk == 0 ? (s >> 6) : (s & 63)) : s;
#pragma unroll
    for (int dd = 0; dd < 2; ++dd) {
      const f32x4q* tp = (const f32x4q*)(rope + ((size_t)pos * 32 + 16 * dd + 8 * hi) * 2);
      const f32x4q t0 = tp[0], t1 = tp[1], t2 = tp[2], t3 = tp[3];
      const float cs[8] = {t0.x, t0.z, t1.x, t1.z, t2.x, t2.z, t3.x, t3.z}, sn[8] = {t0.y, t0.w, t1.y, t1.w, t2.y, t2.w, t3.y, t3.w};
#pragma unroll
      for (int j = 0; j < 8; ++j) { const float x1 = v[4 * blk + dd][j], x2 = v[4 * blk + dd + 2][j];
        v[4 * blk + dd][j] = x1 * cs[j] - x2 * sn[j]; v[4 * blk + dd + 2][j] = x2 * cs[j] + x1 * sn[j]; }
    }
  }
#pragma unroll
  for (int d0 = 0; d0 < DQK / 16; ++d0) { u32x4 w = {cvtpk(v[d0][0] * mul, v[d0][1] * mul), cvtpk(v[d0][2] * mul, v[d0][3] * mul), cvtpk(v[d0][4] * mul, v[d0][5] * mul), cvtpk(v[d0][6] * mul, v[d0][7] * mul)};
    qr[d0] = *reinterpret_cast<bf16x8*>(&w); }
}

template <int DQK, int LDQ, int LDK, int LDV, int ABL = 0>
__device__ __forceinline__ void attn_pass(const bf16* __restrict__ Qb, const bf16* __restrict__ Kh, const bf16* __restrict__ Vh, int seq, char* lds, float* wsf, f32x16 (&o)[4], float (&rli)[16], const float* rope, const float* gain, int s0) {
  constexpr int SHM_K = KVBLK * DQK * 2, NKF = DQK / 8;
  int tid_ = threadIdx.x; asm volatile("" : "+v"(tid_));
  const int tid = tid_, lane = tid & 63, r32 = lane & 31, hi = lane >> 5;
  const int wid = __builtin_amdgcn_readfirstlane(tid >> 6), grp = wid >> 2;
  char* V_lds = lds + OFF_V; char* K_lds = lds + OFF_K;
  float* al_l = wsf + 32;
  bf16x8 qr[DQK / 16];
  const bf16* Qw = Qb + (long)(wid * QBLK + r32) * LDQ + hi * 8;
#pragma unroll
  for (int d0 = 0; d0 < DQK / 16; ++d0) qr[d0] = *reinterpret_cast<const bf16x8*>(Qw + d0 * 16);
  q_prepare<DQK>(qr, rope, gain, s0 + wid * QBLK + r32, hi);
#pragma unroll
  for (int d0 = 0; d0 < DQK / 16; ++d0) asm volatile("" : "+v"(qr[d0]));
  f32x16 lacc = f32x16{}, negm = f32x16{}; asm volatile("" : "+v"(lacc));
#pragma unroll
  for (int d = 0; d < 4; ++d) o[d] = f32x16{};
  const int sr = tid >> 4, sc = (tid & 15) * 8, vst0 = v_st(sr, sc), vst1 = v_st(32 + sr, sc);
  const int kr = (DQK == 128) ? sr : (tid >> 3), kc = (DQK == 128) ? sc : (tid & 7) * 8;
  const int vb0 = (int)(uintptr_t)V_lds + v_rd_base(lane);
  bf16x8 sv0, sv1, sk0, sk1;
  const bf16* kp = Kh + (long)kr * LDK + kc; const bf16* vp = Vh + (long)sr * LDV + sc;
#define ATT_LOAD_K(t) do { sk0 = *reinterpret_cast<const bf16x8*>(kp + (long)(t) * (KVBLK * LDK)); if constexpr (DQK == 128) sk1 = *reinterpret_cast<const bf16x8*>(kp + (long)(t) * (KVBLK * LDK) + 32 * LDK); } while (0)
#define ATT_LOAD_V(t) do { sv0 = *reinterpret_cast<const bf16x8*>(vp + (long)(t) * (KVBLK * LDV)); sv1 = *reinterpret_cast<const bf16x8*>(vp + (long)(t) * (KVBLK * LDV) + 32 * LDV); } while (0)
#define ATT_WRITE_K(so) do { *(bf16x8*)(K_lds + (so) + kswz<DQK>(kr, kc * 2)) = sk0; if constexpr (DQK == 128) *(bf16x8*)(K_lds + (so) + kswz<DQK>(32 + kr, kc * 2)) = sk1; } while (0)
#define ATT_WRITE_V(so) do { *(bf16x8*)(V_lds + (so) + vst0) = sv0; *(bf16x8*)(V_lds + (so) + vst1) = sv1; } while (0)
#define ATT_BAR() do { ATT_SBAR(); asm volatile("s_barrier" ::: "memory"); ATT_SBAR(); } while (0)
#define ATT_RESC(a) do { if (__any((a) < 1.f)) { if (hi == 0) al_l[r32] = (a); asm volatile("s_waitcnt lgkmcnt(0)" ::: "memory"); \
    _Pragma("unroll") for (int r = 0; r < 16; ++r) { const float f_ = al_l[crow(r, hi)]; lacc[r] *= f_; _Pragma("unroll") for (int d = 0; d < 4; ++d) o[d][r] *= f_; } } } while (0)
#define ATT_MF(A_, B_, C_) do { if constexpr (ABL & 2) { asm volatile("" :: "v"(A_), "v"(B_)); } else { C_ = __builtin_amdgcn_mfma_f32_32x32x16_bf16(A_, B_, C_, 0, 0, 0); } } while (0)
#define ATT_VF(buf, ks) (bf16x8){buf[2 * ks][0], buf[2 * ks][1], buf[2 * ks][2], buf[2 * ks][3], buf[2 * ks + 1][0], buf[2 * ks + 1][1], buf[2 * ks + 1][2], buf[2 * ks + 1][3]}
  const int NT = seq / KVBLK;
  f32x16 p0, p1; float alpha; bf16x8 pa0, pa1, pa2, pa3;
  const bf16x8 ones = {0x3F80, 0x3F80, 0x3F80, 0x3F80, 0x3F80, 0x3F80, 0x3F80, 0x3F80};
  ATT_LOAD_K(0); ATT_LOAD_V(0); ATT_WRITE_K(0); ATT_WRITE_V(0);
  ATT_LOAD_K(1); ATT_WRITE_K(SHM_K);
  ATT_LOAD_K(2); ATT_LOAD_V(1);
  asm volatile("s_waitcnt lgkmcnt(0)" ::: "memory"); ATT_BAR();
  if (grp == 1) ATT_BAR();
  qkt<DQK>(p0, p1, K_lds, qr, r32, hi);
  ATT_BAR();
  int k1 = SHM_K, k2 = 2 * SHM_K, k0 = 0, v0 = 0, v1 = SHM_V, v2 = 2 * SHM_V;
  const lds_cptr kq0 = (lds_cptr)K_lds, vq0 = (lds_cptr)V_lds + v_rd_base(lane);
  bf16x8 kf[8]; s16x4 va[8], vc[8];
#define ATT_KFRAG(i, so) do { if constexpr (!(ABL & 8)) { const int d0_ = (i) >> 1, cb_ = (d0_ * 16 + hi * 8) * 2; kf[(i) & 7] = *(const __attribute__((address_space(3))) bf16x8*)(kq0 + (so) + kswz<DQK>(((i) & 1) * 32 + r32, cb_)); } } while (0)
#define ATT_VPAIR(buf, so, blk, ks) do { if constexpr (!(ABL & 8)) { buf[2 * (ks)] = vtr(vq0 + (so) + v_rd_off(blk, ks, 0)); buf[2 * (ks) + 1] = vtr(vq0 + (so) + v_rd_off(blk, ks, 1)); } } while (0)
#define ATT_PA(ks) ((ks) == 0 ? pa0 : (ks) == 1 ? pa1 : (ks) == 2 ? pa2 : pa3)
#define ATT_XSECTION(WITH_QK) do { \
    _Pragma("unroll") for (int g = 0; g < 20; ++g) { const int blk = g >> 2, ks = g & 3; \
      if (blk == 4) { ATT_MF(ATT_PA(ks), ones, lacc); } \
      else if (blk == 0 || blk == 2) { ATT_MF(ATT_PA(ks), ATT_VF(va, ks), o[blk]); } \
      else { ATT_MF(ATT_PA(ks), ATT_VF(vc, ks), o[blk]); } \
      if (blk < 3) { if (blk == 0 || blk == 2) ATT_VPAIR(vc, v0, blk + 1, ks); else ATT_VPAIR(va, v0, blk + 1, ks); } \
      if (WITH_QK) { if (g >= 12 && g - 12 < NKF) ATT_KFRAG(g - 12, k1); } \
      ATT_SBAR(); } \
    if (WITH_QK) { _Pragma("unroll") for (int i = 0; i < NKF; ++i) { \
      if (i < 2) { if (i == 0) { if constexpr (ABL & 2) { asm volatile("" :: "v"(kf[0])); p0 = negm; } else p0 = __builtin_amdgcn_mfma_f32_32x32x16_bf16(kf[0], qr[0], negm, 0, 0, 0); } \
                   else        { if constexpr (ABL & 2) { asm volatile("" :: "v"(kf[1])); p1 = negm; } else p1 = __builtin_amdgcn_mfma_f32_32x32x16_bf16(kf[1], qr[0], negm, 0, 0, 0); } } \
      else if (i & 1) { ATT_MF(kf[i & 7], qr[i >> 1], p1); } else { ATT_MF(kf[i & 7], qr[i >> 1], p0); } \
      if (i + 8 < NKF) ATT_KFRAG(i + 8, k1); \
      ATT_SBAR(); } } } while (0)
  for (int t = 0; t + 1 < NT; ++t) {
    if constexpr (ABL & 1) { u32x4 w0 = {cvtpk(p0[0], p0[1]), cvtpk(p0[2], p0[3]), cvtpk(p0[4], p0[5]), cvtpk(p0[6], p0[7])}, w1 = {cvtpk(p0[8], p0[9]), cvtpk(p0[10], p0[11]), cvtpk(p0[12], p0[13]), cvtpk(p0[14], p0[15])};
        u32x4 w2 = {cvtpk(p1[0], p1[1]), cvtpk(p1[2], p1[3]), cvtpk(p1[4], p1[5]), cvtpk(p1[6], p1[7])}, w3 = {cvtpk(p1[8], p1[9]), cvtpk(p1[10], p1[11]), cvtpk(p1[12], p1[13]), cvtpk(p1[14], p1[15])};
        pa0 = *reinterpret_cast<bf16x8*>(&w0); pa1 = *reinterpret_cast<bf16x8*>(&w1); pa2 = *reinterpret_cast<bf16x8*>(&w2); pa3 = *reinterpret_cast<bf16x8*>(&w3); alpha = 1.f; }
    else { softmax_tile(p0, p1, negm, alpha, t == 0, pa0, pa1, pa2, pa3);
    ATT_RESC(alpha); }
    if constexpr (!(ABL & 4)) { ATT_WRITE_K(k2); ATT_WRITE_V(v1); }
    ATT_SBAR();
#pragma unroll
    for (int ks = 0; ks < 4; ++ks) ATT_VPAIR(va, v0, 0, ks);
    asm volatile("s_waitcnt lgkmcnt(0)" ::: "memory"); ATT_BAR();
    ATT_XSECTION(true);
    if constexpr (!(ABL & 4)) { const int tk = (t + 3 < NT) ? t + 3 : NT - 1, tv = (t + 2 < NT) ? t + 2 : NT - 1; ATT_LOAD_K(tk); ATT_LOAD_V(tv); }
    ATT_BAR();
    { const int tk_ = k0; k0 = k1; k1 = k2; k2 = tk_; const int tv_ = v0; v0 = v1; v1 = v2; v2 = tv_; }
  }
  softmax_tile(p0, p1, negm, alpha, false, pa0, pa1, pa2, pa3);
  ATT_RESC(alpha);
#pragma unroll
  for (int ks = 0; ks < 4; ++ks) ATT_VPAIR(va, v0, 0, ks);
  asm volatile("s_waitcnt lgkmcnt(0)" ::: "memory"); ATT_BAR();
  ATT_XSECTION(false);
  ATT_BAR();
  if (grp == 0) ATT_BAR();
#pragma unroll
  for (int r = 0; r < 16; ++r) rli[r] = __builtin_amdgcn_rcpf(lacc[r]);
#undef ATT_LOAD_K
#undef ATT_LOAD_V
#undef ATT_WRITE_K
#undef ATT_WRITE_V
#undef ATT_BAR
#undef ATT_RESC
#undef ATT_MF
#undef ATT_VF
#undef ATT_KFRAG
#undef ATT_VPAIR
#undef ATT_PA
#undef ATT_XSECTION
}
}

constexpr int NWAVES = 8;
constexpr int DM = 2048, BATCH = 4, SEQ = 8192, T = BATCH * SEQ;
constexpr int NCOL1 = 4608 + 4096;
constexpr int NEXP = 32, FF = 512, LCAP = 32768;
constexpr int PMAX = 288;
constexpr float EPS = 1e-6f;
constexpr float LAM_INIT = 0.2f;
#ifndef MK_ONE_LAUNCH
#define MK_ONE_LAUNCH 1
#endif
constexpr int N_PHASES = 10;
#ifndef ATT_DUMMY
#define ATT_DUMMY -1
#define ATT_DUMMY_B 0
#endif
#ifndef PROBE_MASK
#define PROBE_MASK 0
#define PROBE_MUL 1
#endif

constexpr size_t MiB = 1u << 20;
constexpr size_t WS_CTL = 0, CTL_ZERO_BYTES = 1 * MiB;
constexpr size_t WS_ROPE = 2 * MiB;
constexpr size_t WS_WRT = 4 * MiB;
constexpr size_t WS_TOKROW = 5 * MiB;
constexpr size_t WS_ROWW = 6 * MiB;
constexpr size_t WS_WIN = 8 * MiB;
constexpr size_t WS_WA = 42 * MiB, WS_WB = 46 * MiB, WS_WO = 50 * MiB;
constexpr size_t WS_W13 = 58 * MiB;
constexpr size_t WS_W2 = 186 * MiB;
constexpr size_t WS_SSQ = 250 * MiB;
constexpr size_t WS_LENT = 254 * MiB, WS_LW = 258 * MiB;
constexpr size_t WS_XN = 264 * MiB;
constexpr size_t WS_QA = 392 * MiB, WS_KA = 456 * MiB, WS_VA = 472 * MiB, WS_QB = 488 * MiB, WS_KB = 552 * MiB, WS_VB = 616 * MiB;
constexpr size_t WS_XG = 392 * MiB;
constexpr size_t WS_GT = 680 * MiB;
constexpr size_t WS_YC = WS_XG;
constexpr size_t WS_END = 936 * MiB;
constexpr int CW_CNT = 64;
constexpr int CW_BAR = 4096;

constexpr int SCR_OFF = 0, SCR_BYTES = 139264;
constexpr int AWS_OFF = 139264;
constexpr int MOE_OFF = AWS_OFF + 2048;
constexpr int MISC_OFF = MOE_OFF + 512;
constexpr int LDS_BYTES = 147456;
static_assert(MISC_OFF + 128 <= LDS_BYTES, "LDS map");

#define GAS __attribute__((address_space(1)))
#define LAS __attribute__((address_space(3)))
typedef unsigned short bf16;
typedef unsigned v4u __attribute__((ext_vector_type(4)));
typedef unsigned v2u __attribute__((ext_vector_type(2)));
typedef float f32x4 __attribute__((ext_vector_type(4)));
typedef short bf16x8 __attribute__((ext_vector_type(8)));
typedef GAS unsigned gu32;
#define RLX_AGENT __ATOMIC_RELAXED, __HIP_MEMORY_SCOPE_AGENT
#define LDS_WAIT() asm volatile("s_waitcnt lgkmcnt(0)" ::: "memory")
#define VM_WAIT() asm volatile("s_waitcnt vmcnt(0)" ::: "memory")
__device__ __forceinline__ unsigned f2bf(float f) { unsigned u = __builtin_bit_cast(unsigned, f); return (u + 0x7fffu + ((u >> 16) & 1u)) >> 16; }
__device__ __forceinline__ unsigned pk2(float lo, float hi) { return f2bf(lo) | (f2bf(hi) << 16); }
__device__ __forceinline__ float bflo(unsigned w) { return __uint_as_float(w << 16); }
__device__ __forceinline__ float bfhi(unsigned w) { return __uint_as_float(w & 0xffff0000u); }
__device__ __forceinline__ float wave_sum(float v) {
#pragma unroll
    for (int o = 1; o < 64; o <<= 1) v += __shfl_xor(v, o);
    return v;
}

#define XB_TMO      128
#define XB_XCNT(j)  (256  + 64 * (j))
#define XB_XSUB(j)  (1280 + 64 * (j))
#define XB_XGEN(j)  (2304 + 64 * (j))
#define XB_TOP      3328
#define XB_TOPGEN   3392
#define XCD_BAR_WORDS 3456
#define XB_SPIN_CAP (1u << 18)

__device__ __forceinline__ unsigned xb_ld(unsigned* p)              { return __hip_atomic_load(p, __ATOMIC_RELAXED, __HIP_MEMORY_SCOPE_AGENT); }
__device__ __forceinline__ unsigned xb_add(unsigned* p, unsigned v) { return __hip_atomic_fetch_add(p, v, __ATOMIC_RELAXED, __HIP_MEMORY_SCOPE_AGENT); }
__device__ __forceinline__ unsigned xb_xcc_id() { return (unsigned)__builtin_amdgcn_s_getreg((3 << 11) | 20) & 0xFu; }
#define XB_SPIN(cond, bar) do { unsigned _sp = 0; while (cond) { __builtin_amdgcn_s_sleep(1); \
    if ((++_sp & 255u) == 0u) { if (xb_ld(&(bar)[XB_TMO])) break; if (_sp > XB_SPIN_CAP) { atomicAdd(&(bar)[XB_TMO], 1u); break; } } } } while (0)

struct XcdBarrier {
    unsigned* bar; unsigned x;
    volatile LAS unsigned* st;
};

__device__ __forceinline__ XcdBarrier xcd_barrier_post(unsigned* bar, volatile LAS unsigned* st) {
    XcdBarrier b; b.bar = bar; b.x = xb_xcc_id(); b.st = st;
    if (threadIdx.x == 0) (void)xb_add(&bar[XB_XCNT(b.x)], 1u);
    return b;
}
__device__ __forceinline__ void xcd_barrier_complete(unsigned* bar, unsigned x, unsigned& nloc, unsigned& nx) {
    const unsigned G = gridDim.x * gridDim.y * gridDim.z;
    unsigned sum, cnt, mine, sp = 0u;
    for (;;) {
        sum = 0u; cnt = 0u; mine = 0u;
#pragma unroll
        for (unsigned j = 0; j < 16; ++j) { const unsigned c = xb_ld(&bar[XB_XCNT(j)]); sum += c; cnt += (c > 0u) ? 1u : 0u; mine = (j == x) ? c : mine; }
        if (sum == G) break;
        __builtin_amdgcn_s_sleep(1);
        if ((++sp & 255u) == 0u) { if (xb_ld(&bar[XB_TMO])) break; if (sp > XB_SPIN_CAP) { atomicAdd(&bar[XB_TMO], 1u); break; } }
    }
    nloc = mine > 0u ? mine : 1u; nx = cnt > 0u ? cnt : 1u;
}

__device__ __forceinline__ void xcd_barrier(const XcdBarrier& b) {
    asm volatile("s_waitcnt vmcnt(0)" ::: "memory");
    __syncthreads();
    if (threadIdx.x == 0) {
        unsigned* bar = b.bar;
        __builtin_amdgcn_s_waitcnt(0);
        unsigned nloc = b.st[0], nx = b.st[1];
        if (nloc == 0u) { xcd_barrier_complete(bar, b.x, nloc, nx); b.st[0] = nloc; b.st[1] = nx; }
        const unsigned old = xb_add(&bar[XB_XSUB(b.x)], 1u);
        const unsigned gen = old / nloc;
        if (old + 1u == (gen + 1u) * nloc) {
            __builtin_amdgcn_fence(__ATOMIC_RELEASE, "agent");
            asm volatile("s_waitcnt vmcnt(0)" ::: "memory");
            const unsigned og = xb_add(&bar[XB_TOP], 1u);
            const unsigned tg = og / nx;
            if (og + 1u == (tg + 1u) * nx) xb_add(&bar[XB_TOPGEN], 1u);
            else XB_SPIN(xb_ld(&bar[XB_TOPGEN]) == tg, bar);
            __builtin_amdgcn_fence(__ATOMIC_ACQUIRE, "agent");
            xb_add(&bar[XB_XGEN(b.x)], 1u);
            asm volatile("s_waitcnt vmcnt(0)" ::: "memory");
        } else {
            XB_SPIN(xb_ld(&bar[XB_XGEN(b.x)]) == gen, bar);
            __builtin_amdgcn_fence(__ATOMIC_ACQUIRE, "agent");
            asm volatile("s_waitcnt vmcnt(0)" ::: "memory");
        }
    }
    __syncthreads();
}

struct Args { const float* in[22]; float* out; unsigned char* ws; int ph_lo, ph_hi, li, pad; };
struct Frame { unsigned char* lds; int tid, lane, wave, vcu, G, gw, NGW; };
typedef const Args __attribute__((address_space(4)))* KArgs;
#define FRESH_ARGS() ({ KArgs p_ = (KArgs)__builtin_amdgcn_kernarg_segment_ptr(); asm volatile("" : "+s"(p_)); p_; })

__device__ __forceinline__ void p0_transpose_item(const float* W, int N, int k0, int n0, bf16* WT, int K, int dst_row0, LAS float* scr, int lane) {
#pragma unroll 8
    for (int i = 0; i < 32; ++i) { const int kk = 2 * i + (lane >> 5); scr[kk * 33 + (lane & 31)] = W[(size_t)(k0 + kk) * N + n0 + (lane & 31)]; }
    LDS_WAIT(); asm volatile("" ::: "memory");
    const int c = lane & 7;
#pragma unroll
    for (int j = 0; j < 4; ++j) { const int n = (lane >> 3) + 8 * j; const LAS float* s = scr + (8 * c) * 33 + n;
        v4u o; o.x = pk2(s[0 * 33], s[1 * 33]); o.y = pk2(s[2 * 33], s[3 * 33]); o.z = pk2(s[4 * 33], s[5 * 33]); o.w = pk2(s[6 * 33], s[7 * 33]);
        *(GAS v4u*)(WT + (size_t)(dst_row0 + n) * K + k0 + 8 * c) = o; }
    LDS_WAIT(); asm volatile("" ::: "memory");
}
__device__ __forceinline__ void p0_prologue(const Frame& F, KArgs a) {
    unsigned char* ws = a->ws;
    LAS float* scr = (LAS float*)((LAS unsigned char*)F.lds + SCR_OFF + F.wave * 16384);
    constexpr int I_IN = 32 * 144, I_GT = 32 * 128, I_BA = 16 * 64, I_WO = 32 * 64, I_E = 32 * 512;
    constexpr int NITEMS = I_IN + I_GT + 2 * I_BA + I_WO + 3 * I_E;
    for (int it = F.gw; it < NITEMS; it += F.NGW) {
        int r = it;
        if (r < I_IN) { const int kb = r / 144, nb = r % 144; p0_transpose_item(a->in[2], 4608, 64 * kb, 32 * nb, (bf16*)(ws + WS_WIN), 2048, 32 * nb, scr, F.lane); continue; } r -= I_IN;
        if (r < I_GT) { const int kb = r / 128, nb = r % 128; p0_transpose_item(a->in[12], 4096, 64 * kb, 32 * nb, (bf16*)(ws + WS_WIN), 2048, 4608 + 32 * nb, scr, F.lane); continue; } r -= I_GT;
        if (r < I_BA) { const int kb = r / 64, nb = r % 64; p0_transpose_item(a->in[10], 2048, 64 * kb, 32 * nb, (bf16*)(ws + WS_WA), 2048, 32 * nb, scr, F.lane); continue; } r -= I_BA;
        if (r < I_BA) { const int kb = r / 64, nb = r % 64; p0_transpose_item(a->in[11], 2048, 64 * kb, 32 * nb, (bf16*)(ws + WS_WA) + 1024, 2048, 32 * nb, scr, F.lane); continue; } r -= I_BA;
        if (r < I_WO) { const int kb = r / 64, nb = r % 64; p0_transpose_item(a->in[14], 2048, 64 * kb, 32 * nb, (bf16*)(ws + WS_WO), 2048, 32 * nb, scr, F.lane); continue; } r -= I_WO;
        if (r < I_E)  { const int e = r / 512, q = r % 512, kb = q / 16, nb = q % 16, n0 = 32 * nb;
                        p0_transpose_item(a->in[18] + (size_t)e * 2048 * 512, 512, 64 * kb, n0, (bf16*)(ws + WS_W13), 2048, e * 1024 + (n0 >> 7) * 256 + (n0 & 127), scr, F.lane); continue; } r -= I_E;
        if (r < I_E)  { const int e = r / 512, q = r % 512, kb = q / 16, nb = q % 16, n0 = 32 * nb;
                        p0_transpose_item(a->in[19] + (size_t)e * 2048 * 512, 512, 64 * kb, n0, (bf16*)(ws + WS_W13), 2048, e * 1024 + (n0 >> 7) * 256 + 128 + (n0 & 127), scr, F.lane); continue; } r -= I_E;
        { const int e = r / 512, q = r % 512, kb = q / 64, nb = q % 64;
          p0_transpose_item(a->in[20] + (size_t)e * 512 * 2048, 2048, 64 * kb, 32 * nb, (bf16*)(ws + WS_W2), 512, e * 2048 + 32 * nb, scr, F.lane); }
    }
    { float2* tab = (float2*)(ws + WS_ROPE);
      for (int idx = F.gw * 64 + F.lane; idx < SEQ * 32; idx += F.NGW * 64) { const int pos = idx >> 5, i = idx & 31;
          const float inv = powf(10000.0f, -(float)(2 * i) / 64.0f); const float ang = (float)pos * inv;
          double s, c; sincos((double)ang, &s, &c); tab[idx] = make_float2((float)c, (float)s); } }
    { bf16* wh = (bf16*)(ws + WS_WRT); bf16* wl = wh + 48 * 2048;
      for (int idx = F.gw * 64 + F.lane; idx < 48 * 2048; idx += F.NGW * 64) { const int c = idx >> 11, k = idx & 2047;
          const float v = c < 4 ? a->in[16][k * 4 + c] : (c < 36 ? a->in[17][k * 32 + (c - 4)] : 0.f);
          const unsigned h = f2bf(v); const float hf = __uint_as_float(h << 16); wh[idx] = (bf16)h; wl[idx] = (bf16)f2bf(v - hf); } }
    { const float* x = a->in[0]; const GAS f32x4* g4 = (const GAS f32x4*)a->in[1] + F.lane; bf16* XN = (bf16*)(ws + WS_XN);
      for (int m = F.gw; m < T; m += F.NGW) {
          const GAS f32x4* xr = (const GAS f32x4*)(x + (size_t)m * DM) + F.lane; f32x4 v[8]; float s = 0.f;
#pragma unroll
          for (int j = 0; j < 8; ++j) { v[j] = xr[64 * j]; s += (v[j].x * v[j].x + v[j].y * v[j].y) + (v[j].z * v[j].z + v[j].w * v[j].w); }
          const float rstd = 1.0f / sqrtf(wave_sum(s) * (1.0f / DM) + EPS);
          GAS v2u* o8 = (GAS v2u*)(XN + (size_t)m * DM) + F.lane;
#pragma unroll
          for (int j = 0; j < 8; ++j) { const f32x4 g = g4[64 * j]; v2u w; w.x = pk2(v[j].x * rstd * g.x, v[j].y * rstd * g.y); w.y = pk2(v[j].z * rstd * g.z, v[j].w * rstd * g.w); o8[64 * j] = w; } } }
}

__device__ __forceinline__ void rope8(float (&v)[8], const float2* tab, int pos, int cc) {
    const GAS f32x4* tp = (const GAS f32x4*)(tab + (size_t)pos * 32 + 8 * (cc & 3));
    const f32x4 t0 = tp[0], t1 = tp[1], t2 = tp[2], t3 = tp[3];
    const float cs[8] = {t0.x, t0.z, t1.x, t1.z, t2.x, t2.z, t3.x, t3.z}, sn[8] = {t0.y, t0.w, t1.y, t1.w, t2.y, t2.w, t3.y, t3.w};
    const float sg = (cc & 4) ? 1.f : -1.f;
#pragma unroll
    for (int e = 0; e < 8; ++e) { const float p = __shfl_xor(v[e], 4); v[e] = v[e] * cs[e] + sg * p * sn[e]; }
}
__device__ __forceinline__ void unpack8(const v4u w, float (&v)[8]) { v[0] = bflo(w.x); v[1] = bfhi(w.x); v[2] = bflo(w.y); v[3] = bfhi(w.y); v[4] = bflo(w.z); v[5] = bfhi(w.z); v[6] = bflo(w.w); v[7] = bfhi(w.w); }
__device__ __forceinline__ v4u pack8(const float (&v)[8]) { v4u w; w.x = pk2(v[0], v[1]); w.y = pk2(v[2], v[3]); w.z = pk2(v[4], v[5]); w.w = pk2(v[6], v[7]); return w; }
__device__ __forceinline__ void p1b_normrope(const Frame& F, KArgs a) {
    unsigned char* ws = a->ws; const float2* tab = (const float2*)(ws + WS_ROPE);
    bf16* KA = (bf16*)(ws + WS_KA); bf16* KB = (bf16*)(ws + WS_KB);
    const float* kg = a->in[4];
    const int cc16 = F.lane & 15;
    float gk[8];
#pragma unroll
    for (int e = 0; e < 8; ++e) gk[e] = kg[cc16 * 8 + e];
    for (int tA = F.gw; tA < T; tA += 2 * F.NGW) {
        const int tB = (tA + F.NGW < T) ? tA + F.NGW : tA;
        v4u raw[2][3];
#pragma unroll
        for (int u = 0; u < 2; ++u) { const int t = u ? tB : tA;
            raw[u][0] = *(const GAS v4u*)(KA + (size_t)t * 256 + (F.lane & 31) * 8);
            raw[u][1] = *(const GAS v4u*)(KB + (size_t)t * 1024 + F.lane * 8); raw[u][2] = *(const GAS v4u*)(KB + (size_t)t * 1024 + (F.lane + 64) * 8); }
#pragma unroll
        for (int u = 0; u < 2; ++u) { const int t = u ? tB : tA;
            if (u == 1 && tB == tA) break;
            const int s = t & (SEQ - 1), prow = s >> 6, pcol = s & 63;
            const int posA = (cc16 < 8) ? prow : pcol;
            {
                bf16* p = KA + (size_t)t * 256 + (F.lane & 31) * 8;
                float v[8]; unpack8(raw[u][0], v);
                float ss = 0.f;
#pragma unroll
                for (int e = 0; e < 8; ++e) ss += v[e] * v[e];
                ss += __shfl_xor(ss, 1); ss += __shfl_xor(ss, 2); ss += __shfl_xor(ss, 4); ss += __shfl_xor(ss, 8);
                const float rstd = 1.0f / sqrtf(ss * (1.0f / 128.0f) + EPS);
#pragma unroll
                for (int e = 0; e < 8; ++e) v[e] = v[e] * rstd * gk[e];
                rope8(v, tab, posA, cc16 & 7);
                if (F.lane < 32) *(GAS v4u*)p = pack8(v);
            }
#pragma unroll
            for (int j = 0; j < 2; ++j) {
                bf16* p = KB + (size_t)t * 1024 + (F.lane + 64 * j) * 8;
                float v[8]; unpack8(raw[u][1 + j], v);
                rope8(v, tab, s, F.lane & 7);
                *(GAS v4u*)p = pack8(v);
            }
        }
    }
}

template <int ABL = 0> __device__ __forceinline__ void attn_unit_A(const Frame& F, KArgs a, int b, int h, int qb, att::bf16* Obase) {
    using namespace att;
    int tid_ = threadIdx.x; asm volatile("" : "+v"(tid_));
    const int lane_ = tid_ & 63, wave_ = __builtin_amdgcn_readfirstlane(tid_ >> 6);
    unsigned char* ws = a->ws; char* lds = (char*)F.lds + SCR_OFF; float* wsf = (float*)((char*)F.lds + AWS_OFF) + wave_ * 64;
    const int r32 = lane_ & 31, hi = lane_ >> 5, kvh = h >> 2;
    const att::bf16* Qb = (const att::bf16*)(ws + WS_QA) + ((size_t)b * SEQ + (size_t)qb * 256) * 1024 + h * 128;
    const att::bf16* Kh = (const att::bf16*)(ws + WS_KA) + (size_t)b * SEQ * 256 + kvh * 128;
    const att::bf16* Vh = (const att::bf16*)(ws + WS_VA) + (size_t)b * SEQ * 256 + kvh * 128;
    f32x16 o[4]; float rli[16];
    attn_pass<128, 1024, 256, 256, ABL>(Qb, Kh, Vh, SEQ, lds, wsf, o, rli, (const float*)(ws + WS_ROPE), a->in[3], qb * 256);
    att::bf16* Ow = Obase + ((size_t)b * SEQ + (size_t)qb * 256 + wave_ * 32) * 2048 + h * 128;
#pragma unroll
    for (int r = 0; r < 16; ++r) { const int orow = crow(r, hi);
#pragma unroll
        for (int d0 = 0; d0 < 4; ++d0) Ow[(size_t)orow * 2048 + d0 * 32 + r32] = (att::bf16)f2bf(o[d0][r] * rli[r]); }
}
template <int ABL = 0> __device__ __forceinline__ void attn_unit_B(const Frame& F, KArgs a, int b, int h, int qb, float lam, att::bf16* Obase) {
    using namespace att;
    int tid_ = threadIdx.x; asm volatile("" : "+v"(tid_));
    const int lane_ = tid_ & 63, wave_ = __builtin_amdgcn_readfirstlane(tid_ >> 6);
    unsigned char* ws = a->ws; char* lds = (char*)F.lds + SCR_OFF; float* wsf = (float*)((char*)F.lds + AWS_OFF) + wave_ * 64;
    unsigned* stash = (unsigned*)(lds + OFF_STASH) + wave_ * 2048;
    const int r32 = lane_ & 31, hi = lane_ >> 5;
    const att::bf16* Qb = (const att::bf16*)(ws + WS_QB) + ((size_t)b * SEQ + (size_t)qb * 256) * 1024 + h * 128;
    const att::bf16* Kh = (const att::bf16*)(ws + WS_KB) + (size_t)b * SEQ * 1024 + h * 128;
    const att::bf16* Vh = (const att::bf16*)(ws + WS_VB) + (size_t)b * SEQ * 1024 + h * 128;
    f32x16 o[4]; float rli[16];
    attn_pass<64, 1024, 1024, 1024, ABL>(Qb, Kh, Vh, SEQ, lds, wsf, o, rli, (const float*)(ws + WS_ROPE), nullptr, qb * 256);
#pragma unroll
    for (int d0 = 0; d0 < 4; ++d0)
#pragma unroll
        for (int r = 0; r < 16; r += 2) stash[(d0 * 8 + (r >> 1)) * 64 + lane_] = att::cvtpk(o[d0][r] * rli[r], o[d0][r + 1] * rli[r + 1]);
    attn_pass<64, 1024, 1024, 1024, ABL>(Qb + 64, Kh + 64, Vh, SEQ, lds, wsf, o, rli, (const float*)(ws + WS_ROPE), nullptr, qb * 256);
    asm volatile("s_waitcnt lgkmcnt(0)" ::: "memory");
    float ss[16];
#pragma unroll
    for (int r = 0; r < 16; ++r) ss[r] = 0.f;
#pragma unroll
    for (int d0 = 0; d0 < 4; ++d0)
#pragma unroll
        for (int r = 0; r < 16; r += 2) { const unsigned w = stash[(d0 * 8 + (r >> 1)) * 64 + lane_];
            const float x0 = bflo(w) - lam * (o[d0][r] * rli[r]), x1 = bfhi(w) - lam * (o[d0][r + 1] * rli[r + 1]);
            o[d0][r] = x0; o[d0][r + 1] = x1; ss[r] += x0 * x0; ss[r + 1] += x1 * x1; }
#pragma unroll
    for (int r = 0; r < 16; ++r) { float s = ss[r]; s += __shfl_xor(s, 1); s += __shfl_xor(s, 2); s += __shfl_xor(s, 4); s += __shfl_xor(s, 8); s += __shfl_xor(s, 16);
        ss[r] = (1.0f - LAM_INIT) / sqrtf(s * (1.0f / 128.0f) + EPS); }
    const float* sg = a->in[9]; float g4[4];
#pragma unroll
    for (int d0 = 0; d0 < 4; ++d0) g4[d0] = sg[d0 * 32 + r32];
    att::bf16* Ow = Obase + ((size_t)b * SEQ + (size_t)qb * 256 + wave_ * 32) * 2048 + 1024 + h * 128;
#pragma unroll
    for (int r = 0; r < 16; ++r) { const int orow = crow(r, hi);
#pragma unroll
        for (int d0 = 0; d0 < 4; ++d0) Ow[(size_t)orow * 2048 + d0 * 32 + r32] = (att::bf16)f2bf(o[d0][r] * ss[r] * g4[d0]); }
}
__device__ __forceinline__ void p2_attention(const Frame& F, KArgs a) {
    const float lam = __uint_as_float(__builtin_amdgcn_readfirstlane(__float_as_uint(expf(wave_sum(a->in[5][F.lane] * a->in[6][F.lane])) - expf(wave_sum(a->in[7][F.lane] * a->in[8][F.lane])) + LAM_INIT)));
#if ATT_DUMMY >= 0
#if ATT_DUMMY_B
    for (int L = F.vcu; L < 1024; L += F.G) { const int i = L >> 8, v = L & 255, x = v >> 5, qb = v & 31, b = x >> 1; attn_unit_B<ATT_DUMMY>(F, a, b, 4 * (x & 1) + i, qb, lam, (att::bf16*)a->out); }
#else
    for (int L = F.vcu; L < 1024; L += F.G) { const int i = L >> 8, v = L & 255, x = v >> 5, qb = v & 31, b = x >> 1; attn_unit_A<ATT_DUMMY>(F, a, b, 4 * (x & 1) + i, qb, (att::bf16*)a->out); }
#endif
#endif
    for (int L = F.vcu; L < 2048; L += F.G) {
#if PROBE_MASK
        if (L >> 8 == 4 && blockIdx.x == 0 && F.tid == 0) { volatile LAS unsigned* M_ = (volatile LAS unsigned*)((LAS unsigned char*)F.lds + MISC_OFF); M_[21] = (unsigned)__builtin_amdgcn_s_memrealtime() - M_[20]; }
#endif
        const int i = L >> 8, v = L & 255, x = v >> 5, qb = v & 31, b = x >> 1;
#ifndef ATT_SKIP_A
        if (i < 4) attn_unit_A(F, a, b, 4 * (x & 1) + i, qb, (att::bf16*)(a->ws + WS_XN));
#endif
#ifndef ATT_SKIP_B
        if (i >= 4) attn_unit_B(F, a, b, 4 * (x & 1) + (i - 4), qb, lam, (att::bf16*)(a->ws + WS_XN));
#endif
    }
}

__device__ __forceinline__ void moe_table(const Frame& F, KArgs a) {
    LAS int* tab = (LAS int*)((LAS unsigned char*)F.lds + MOE_OFF);
    if (F.tid == 0) { const gu32* cnt = (const gu32*)(a->ws + WS_CTL) + CW_CNT; int acc = 0;
        for (int e = 0; e < NEXP; ++e) { const int c = (int)__hip_atomic_load(cnt + e, RLX_AGENT); tab[e] = c; tab[32 + e] = acc; acc += (c + 255) >> 8; }
        tab[64] = acc; }
    __syncthreads();
}

__device__ __forceinline__ void p4_router(const Frame& F, KArgs a) {
    typedef float f32x4v __attribute__((ext_vector_type(4)));
    unsigned char* ws = a->ws; const float* X1 = a->out; const float* SSQ = (const float*)(ws + WS_SSQ); const float* gf = a->in[15];
    bf16* H2 = (bf16*)(ws + WS_GT); const bf16* wh = (const bf16*)(ws + WS_WRT);
    gu32* cnt = (gu32*)(ws + WS_CTL) + CW_CNT; int* LENT = (int*)(ws + WS_LENT); float* LW = (float*)(ws + WS_LW); int* TOKES = (int*)(ws + WS_TOKROW);
    LAS float* LG = (LAS float*)((LAS unsigned char*)F.lds + SCR_OFF) + F.wave * (16 * 48);
    LAS int* lcnt = (LAS int*)((LAS unsigned char*)F.lds + SCR_OFF + 32768);
    const int row = F.lane & 15, kq = F.lane >> 4;
    const int NTASK = T / 16, rounds = (NTASK + F.NGW - 1) / F.NGW;
    for (int it = 0; it < rounds; ++it) {
        const int task = it * F.NGW + F.gw; const bool valid = task < NTASK; const int t0 = valid ? task * 16 : 0;
        if (F.tid < 64) lcnt[F.tid] = 0;
        __syncthreads();
        int e0 = 0, e1 = 0, r0 = 0, r1 = 0; float w0 = 0.f, w1 = 0.f;
        {
            const GAS f32x4v* sp = (const GAS f32x4v*)(SSQ + (size_t)(t0 + row) * 32); float s = 0.f;
#pragma unroll
            for (int j = 0; j < 8; ++j) { const f32x4v q = sp[j]; s += (q.x + q.y) + (q.z + q.w); }
            const float rstd = 1.0f / sqrtf(s * (1.0f / DM) + EPS);
            f32x4v acc[3] = {{0.f, 0.f, 0.f, 0.f}, {0.f, 0.f, 0.f, 0.f}, {0.f, 0.f, 0.f, 0.f}};
            const float* xrow = X1 + (size_t)(t0 + row) * DM + 8 * kq; bf16* hrow = H2 + (size_t)(t0 + row) * DM + 8 * kq;
            f32x4v xw[8][2];
#pragma unroll
            for (int i = 0; i < 8; ++i) { xw[i][0] = *(const GAS f32x4v*)(xrow + 32 * i); xw[i][1] = *(const GAS f32x4v*)(xrow + 32 * i + 4); }
            LAS unsigned char* RB = (LAS unsigned char*)F.lds + SCR_OFF + 36864;
            for (int c = 0; c < 4; ++c) {
                __syncthreads();
#pragma unroll
                for (int i = 0; i < 12; ++i) { const int idx = F.tid + 512 * i, arr = idx / 3072, rr = (idx % 3072) >> 6, seg = idx & 63;
                    *(LAS v4u*)(RB + arr * 49920 + rr * 1040 + seg * 16) = *(const GAS v4u*)(wh + (size_t)arr * 48 * 2048 + (size_t)rr * 2048 + c * 512 + seg * 8); }
                __syncthreads();
                const LAS unsigned char* rbh = RB + row * 1040 + kq * 16;
#pragma unroll 8
                for (int ksl = 0; ksl < 16; ++ksl) { const int ks = c * 16 + ksl;
                const f32x4v x0 = xw[ksl & 7][0], x1 = xw[ksl & 7][1];
                { const int kn = (ks + 8 < 64) ? ks + 8 : ks; xw[ksl & 7][0] = *(const GAS f32x4v*)(xrow + 32 * kn); xw[ksl & 7][1] = *(const GAS f32x4v*)(xrow + 32 * kn + 4); }
                const f32x4v g0 = *(const GAS f32x4v*)(gf + 32 * ks + 8 * kq), g1 = *(const GAS f32x4v*)(gf + 32 * ks + 8 * kq + 4);
                float h[8] = {x0.x * rstd * g0.x, x0.y * rstd * g0.y, x0.z * rstd * g0.z, x0.w * rstd * g0.w, x1.x * rstd * g1.x, x1.y * rstd * g1.y, x1.z * rstd * g1.z, x1.w * rstd * g1.w};
                unsigned hh[8], hl[8];
#pragma unroll
                for (int e = 0; e < 8; ++e) { hh[e] = f2bf(h[e]); hl[e] = f2bf(h[e] - __uint_as_float(hh[e] << 16)); }
                v4u ah, al; ah.x = hh[0] | (hh[1] << 16); ah.y = hh[2] | (hh[3] << 16); ah.z = hh[4] | (hh[5] << 16); ah.w = hh[6] | (hh[7] << 16);
                al.x = hl[0] | (hl[1] << 16); al.y = hl[2] | (hl[3] << 16); al.z = hl[4] | (hl[5] << 16); al.w = hl[6] | (hl[7] << 16);
                if (valid) *(GAS v4u*)(hrow + 32 * ks) = ah;
                const bf16x8 Ah = __builtin_bit_cast(bf16x8, ah), Al = __builtin_bit_cast(bf16x8, al);
#pragma unroll
                for (int blk = 0; blk < 3; ++blk) {
                    const bf16x8 Bh = *(const LAS bf16x8*)(rbh + blk * 16 * 1040 + ksl * 64), Bl = *(const LAS bf16x8*)(rbh + 49920 + blk * 16 * 1040 + ksl * 64);
                    acc[blk] = __builtin_amdgcn_mfma_f32_16x16x32_bf16(Ah, Bh, acc[blk], 0, 0, 0);
                    acc[blk] = __builtin_amdgcn_mfma_f32_16x16x32_bf16(Al, Bh, acc[blk], 0, 0, 0);
                    acc[blk] = __builtin_amdgcn_mfma_f32_16x16x32_bf16(Ah, Bl, acc[blk], 0, 0, 0);
                }
                }
            }
#pragma unroll
            for (int blk = 0; blk < 3; ++blk)
#pragma unroll
                for (int i = 0; i < 4; ++i) LG[(4 * kq + i) * 48 + 16 * blk + row] = acc[blk][i];
            LDS_WAIT();
            if (F.lane < 16) {
                const LAS float* lg = LG + F.lane * 48;
                float gl[4];
#pragma unroll
                for (int i = 0; i < 4; ++i) gl[i] = lg[i];
                int gi = 0; float gm = gl[0];
#pragma unroll
                for (int i = 1; i < 4; ++i) if (gl[i] > gm) { gm = gl[i]; gi = i; }
                float gs = 0.f;
#pragma unroll
                for (int i = 0; i < 4; ++i) gs += expf(gl[i] - gm);
                const float gw_ = 1.0f / gs;
                const LAS float* el = lg + 4 + gi * 8;
                float ev[8];
#pragma unroll
                for (int i = 0; i < 8; ++i) ev[i] = el[i];
                int i0 = 0; float v0 = ev[0];
#pragma unroll
                for (int i = 1; i < 8; ++i) if (ev[i] > v0) { v0 = ev[i]; i0 = i; }
                int i1 = -1; float v1 = -3.0e38f;
#pragma unroll
                for (int i = 0; i < 8; ++i) if (i != i0 && ev[i] > v1) { v1 = ev[i]; i1 = i; }
                const float ex = expf(v1 - v0), den = 1.0f / (1.0f + ex);
                w0 = den * gw_; w1 = ex * den * gw_; e0 = gi * 8 + i0; e1 = gi * 8 + i1;
                if (valid) { r0 = atomicAdd((int*)&lcnt[e0], 1); r1 = atomicAdd((int*)&lcnt[e1], 1); }
            }
        }
        __syncthreads();
        if (F.tid < 32) { const int c = lcnt[F.tid]; lcnt[32 + F.tid] = c ? (int)__hip_atomic_fetch_add(cnt + F.tid, (unsigned)c, RLX_AGENT) : 0; }
        __syncthreads();
        if (valid && F.lane < 16) { const int tok = t0 + F.lane;
            const int s0 = lcnt[32 + e0] + r0, s1 = lcnt[32 + e1] + r1;
            LENT[(size_t)e0 * LCAP + s0] = tok * 2; LW[(size_t)e0 * LCAP + s0] = w0; TOKES[2 * tok] = (e0 << 16) | s0;
            LENT[(size_t)e1 * LCAP + s1] = tok * 2 + 1; LW[(size_t)e1 * LCAP + s1] = w1; TOKES[2 * tok + 1] = (e1 << 16) | s1; }
        __syncthreads();
    }
}

__device__ __forceinline__ void p6_final(const Frame& F, KArgs a) {
    unsigned char* ws = a->ws; const bf16* YC = (const bf16*)(ws + WS_YC); const int* TOKES = (const int*)(ws + WS_TOKROW); const LAS int* tab = (const LAS int*)((LAS unsigned char*)F.lds + MOE_OFF);
    const GAS f32x4* g4 = (const GAS f32x4*)a->in[21] + F.lane;
    for (int t0 = F.gw; t0 < T; t0 += 2 * F.NGW) {
        const int t1 = (t0 + F.NGW < T) ? t0 + F.NGW : t0;
        const int ea0 = TOKES[2 * t0], ea1 = TOKES[2 * t0 + 1], eb0 = TOKES[2 * t1], eb1 = TOKES[2 * t1 + 1];
        GAS f32x4* xa = (GAS f32x4*)(a->out + (size_t)t0 * DM) + F.lane; GAS f32x4* xb = (GAS f32x4*)(a->out + (size_t)t1 * DM) + F.lane;
        f32x4 va[8], vb[8];
#pragma unroll
        for (int j = 0; j < 8; ++j) { va[j] = xa[64 * j]; vb[j] = xb[64 * j]; }
        const GAS v2u* ya0 = (const GAS v2u*)(YC + (size_t)(tab[32 + (ea0 >> 16)] * 256 + (ea0 & 0xffff)) * DM) + F.lane; const GAS v2u* ya1 = (const GAS v2u*)(YC + (size_t)(tab[32 + (ea1 >> 16)] * 256 + (ea1 & 0xffff)) * DM) + F.lane;
        const GAS v2u* yb0 = (const GAS v2u*)(YC + (size_t)(tab[32 + (eb0 >> 16)] * 256 + (eb0 & 0xffff)) * DM) + F.lane; const GAS v2u* yb1 = (const GAS v2u*)(YC + (size_t)(tab[32 + (eb1 >> 16)] * 256 + (eb1 & 0xffff)) * DM) + F.lane;
        v2u pa[8], qa[8], pb[8], qb[8];
#pragma unroll
        for (int j = 0; j < 8; ++j) { pa[j] = ya0[64 * j]; qa[j] = ya1[64 * j]; pb[j] = yb0[64 * j]; qb[j] = yb1[64 * j]; }
        float sa = 0.f, sb = 0.f;
#pragma unroll
        for (int j = 0; j < 8; ++j) {
            va[j].x += bflo(pa[j].x) + bflo(qa[j].x); va[j].y += bfhi(pa[j].x) + bfhi(qa[j].x); va[j].z += bflo(pa[j].y) + bflo(qa[j].y); va[j].w += bfhi(pa[j].y) + bfhi(qa[j].y);
            vb[j].x += bflo(pb[j].x) + bflo(qb[j].x); vb[j].y += bfhi(pb[j].x) + bfhi(qb[j].x); vb[j].z += bflo(pb[j].y) + bflo(qb[j].y); vb[j].w += bfhi(pb[j].y) + bfhi(qb[j].y);
            sa += (va[j].x * va[j].x + va[j].y * va[j].y) + (va[j].z * va[j].z + va[j].w * va[j].w); sb += (vb[j].x * vb[j].x + vb[j].y * vb[j].y) + (vb[j].z * vb[j].z + vb[j].w * vb[j].w); }
        const float ra = 1.0f / sqrtf(wave_sum(sa) * (1.0f / DM) + EPS), rb = 1.0f / sqrtf(wave_sum(sb) * (1.0f / DM) + EPS);
#pragma unroll
        for (int j = 0; j < 8; ++j) { const f32x4 g = g4[64 * j]; xa[64 * j] = (f32x4){va[j].x * ra * g.x, va[j].y * ra * g.y, va[j].z * ra * g.z, va[j].w * ra * g.w};
            if (t1 != t0) xb[64 * j] = (f32x4){vb[j].x * rb * g.x, vb[j].y * rb * g.y, vb[j].z * rb * g.z, vb[j].w * rb * g.w}; }
    }
}

__global__ void __launch_bounds__(NWAVES * 64, 2) fwd_kernel(Args args) {
    extern __shared__ __attribute__((aligned(16))) unsigned char lds[];
    Frame F;
    F.lds = lds; F.tid = threadIdx.x; F.lane = F.tid & 63; F.wave = __builtin_amdgcn_readfirstlane(F.tid >> 6);
    F.G = gridDim.x; { const int bx = blockIdx.x; F.vcu = (F.G % 8 == 0) ? (bx % 8) * (F.G / 8) + bx / 8 : bx; }
    F.gw = F.vcu * NWAVES + F.wave; F.NGW = F.G * NWAVES;
    LAS unsigned char* L = (LAS unsigned char*)lds;
    volatile LAS unsigned* MISC = (volatile LAS unsigned*)(L + MISC_OFF);
    for (int u = F.tid; u < (LDS_BYTES - MISC_OFF) / 4; u += NWAVES * 64) ((LAS unsigned*)(L + MISC_OFF))[u] = 0u;
    __syncthreads();
    int lo, hi, li; unsigned* ctl;
    { KArgs a = FRESH_ARGS(); lo = a->ph_lo; hi = a->ph_hi; li = a->li; ctl = (unsigned*)(a->ws + WS_CTL); }
    XcdBarrier bar; bar.bar = ctl + CW_BAR + li * XCD_BAR_WORDS; bar.x = 0; bar.st = nullptr;
    if (hi - lo > 1) bar = xcd_barrier_post(ctl + CW_BAR + li * XCD_BAR_WORDS, MISC + 8);
#ifndef PH_MASK
#define PH_MASK 0x3ff
#endif
#define IN(k) (((PH_MASK >> (k)) & 1) && lo <= (k) && (k) < hi)
#if PROBE_MASK
    if (blockIdx.x == 0 && F.tid == 0) MISC[20] = (unsigned)__builtin_amdgcn_s_memrealtime();
#define STAMP(k) do { if (blockIdx.x == 0 && F.tid == 0) { const unsigned now_ = (unsigned)__builtin_amdgcn_s_memrealtime(); MISC[10 + (k)] = now_ - MISC[20]; MISC[20] = now_; } } while (0)
#else
#define STAMP(k) do { } while (0)
#endif
#define SEAM(k) do { if (IN(k) && IN((k) + 1)) { xcd_barrier(bar); STAMP(k); } } while (0)

    if (IN(0)) { KArgs a = FRESH_ARGS(); p0_prologue(F, a); } SEAM(0);

    if (IN(1)) {
        KArgs a = FRESH_ARGS(); unsigned char* ws = a->ws;
        pg8::Gemm g{(const pg8::bf16_t*)(ws + WS_XN), (const pg8::bf16_t*)(ws + WS_WIN), T, NCOL1, DM}; pg8::StaticOrder S; S.init(T, NCOL1, F.G, (int)blockIdx.x);
        pg8::EpiP1 E{(pg8::bf16_t*)(ws + WS_QA), (pg8::bf16_t*)(ws + WS_KA), (pg8::bf16_t*)(ws + WS_VA), (pg8::bf16_t*)(ws + WS_QB), (pg8::bf16_t*)(ws + WS_KB), (pg8::bf16_t*)(ws + WS_VB), (pg8::bf16_t*)(ws + WS_GT), a->in[13]};
        pg8::gemm_phase<pg8::EpiP1, pg8::StaticOrder, true, true>(L + SCR_OFF, g, S, E);
    } SEAM(1);

    if (IN(2)) { KArgs a = FRESH_ARGS(); p1b_normrope(F, a); } SEAM(2);

    if (IN(3)) { KArgs a = FRESH_ARGS(); p2_attention(F, a); } SEAM(3);

    if (IN(4)) {
        KArgs a = FRESH_ARGS(); unsigned char* ws = a->ws;
        pg8::Gemm g{(const pg8::bf16_t*)(ws + WS_XN), (const pg8::bf16_t*)(ws + WS_WA), T, DM, DM}; pg8::StaticOrder S; S.init(T, DM, F.G, (int)blockIdx.x);
        pg8::EpiMerge E{(const pg8::bf16_t*)(ws + WS_GT), (pg8::bf16_t*)(ws + WS_KB)};
        pg8::gemm_phase<pg8::EpiMerge, pg8::StaticOrder, true, true>(L + SCR_OFF, g, S, E);
    } SEAM(4);

    if (IN(5)) {
        KArgs a = FRESH_ARGS(); unsigned char* ws = a->ws;
        pg8::Gemm g{(const pg8::bf16_t*)(ws + WS_KB), (const pg8::bf16_t*)(ws + WS_WO), T, DM, DM}; pg8::StaticOrder S; S.init(T, DM, F.G, (int)blockIdx.x);
        pg8::EpiOut E{a->in[0], a->out, (float*)(ws + WS_SSQ)};
        pg8::gemm_phase<pg8::EpiOut, pg8::StaticOrder, true, true>(L + SCR_OFF, g, S, E);
    } SEAM(5);

    if (IN(6)) { KArgs a = FRESH_ARGS(); p4_router(F, a); } SEAM(6);

    if (IN(7)) {
        KArgs a = FRESH_ARGS(); unsigned char* ws = a->ws;
        moe_table(F, a);
        typedef pg8::MoeOrder<4, (long)1024 * 2048 * 2, true> Ord;
        pg8::Gemm g{(const pg8::bf16_t*)(ws + WS_GT), (const pg8::bf16_t*)(ws + WS_W13), T, 1024, DM};
        Ord S{(const LAS int*)(L + MOE_OFF), F.G, (int)blockIdx.x, (const int*)(ws + WS_LENT)};
        pg8::EpiG1 E{(pg8::bf16_t*)(ws + WS_XN)};
        pg8::gemm_phase<pg8::EpiG1, Ord, true, true>(L + SCR_OFF, g, S, E);
    } SEAM(7);

    if (IN(8)) {
        KArgs a = FRESH_ARGS(); unsigned char* ws = a->ws;
        moe_table(F, a);
        typedef pg8::MoeOrder<8, (long)2048 * 512 * 2, false> Ord;
        pg8::Gemm g{(const pg8::bf16_t*)(ws + WS_XN), (const pg8::bf16_t*)(ws + WS_W2), PMAX * 256, DM, FF};
        Ord S{(const LAS int*)(L + MOE_OFF), F.G, (int)blockIdx.x, (const int*)(ws + WS_LENT)};
        pg8::EpiG2 E{(pg8::bf16_t*)(ws + WS_YC), (const float*)(ws + WS_LW), (const LAS int*)(L + MOE_OFF)};
        pg8::gemm_phase<pg8::EpiG2, Ord, true, true>(L + SCR_OFF, g, S, E);
    } SEAM(8);

    if (IN(9)) { KArgs a = FRESH_ARGS(); moe_table(F, a); p6_final(F, a); }
#if PROBE_MASK
    if (blockIdx.x == 0 && F.tid == 0) { unsigned tot = 0;
        for (int k = 0; k < 12; ++k) if ((PROBE_MASK >> k) & 1) tot += MISC[10 + k];
        const unsigned long long t0 = __builtin_amdgcn_s_memrealtime(), span = (unsigned long long)tot * PROBE_MUL;
        while (__builtin_amdgcn_s_memrealtime() - t0 < span) __builtin_amdgcn_s_sleep(8); }
#endif
#undef IN
#undef SEAM
}

extern "C" void kernel_launch(void* const* d_in, const int* in_sizes, int n_in, void* d_out, int out_size, void* d_ws, size_t ws_size, hipStream_t stream) {
    static int grid = 0;
    if (grid == 0) {
        if (n_in != 22 || in_sizes[0] != T * DM || out_size != T * DM || ws_size < WS_END) { fprintf(stderr, "kernel_launch: shape mismatch (n_in %d, in0 %d, out %d, ws %zu)\n", n_in, n_in > 0 ? in_sizes[0] : -1, out_size, ws_size); grid = -1; return; }
        int dev = 0, cus = 0, per_cu = 0;
        if (hipGetDevice(&dev) != hipSuccess || hipDeviceGetAttribute(&cus, hipDeviceAttributeMultiprocessorCount, dev) != hipSuccess) { grid = -1; return; }
        if (hipFuncSetAttribute((const void*)fwd_kernel, hipFuncAttributeMaxDynamicSharedMemorySize, LDS_BYTES) != hipSuccess) { fprintf(stderr, "kernel_launch: hipFuncSetAttribute failed\n"); grid = -1; return; }
        if (hipOccupancyMaxActiveBlocksPerMultiprocessor(&per_cu, (const void*)fwd_kernel, NWAVES * 64, LDS_BYTES) != hipSuccess || per_cu < 1) fprintf(stderr, "kernel_launch: occupancy query says %d\n", per_cu);
        (void)hipGetLastError();
        grid = cus;
    }
    if (grid < 0) return;
    if (hipMemsetAsync((char*)d_ws + WS_CTL, 0, CTL_ZERO_BYTES, stream) != hipSuccess) return;
    Args a{};
    for (int i = 0; i < 22; ++i) a.in[i] = (const float*)d_in[i];
    a.out = (float*)d_out; a.ws = (unsigned char*)d_ws; a.pad = 0;
#if MK_ONE_LAUNCH
    a.ph_lo = 0; a.ph_hi = N_PHASES; a.li = 0;
    hipLaunchKernelGGL(fwd_kernel, dim3(grid), dim3(NWAVES * 64), LDS_BYTES, stream, a);
#else
    for (int li = 0; li < N_PHASES; ++li) { a.ph_lo = li; a.ph_hi = li + 1; a.li = li;
        hipLaunchKernelGGL(fwd_kernel, dim3(grid), dim3(NWAVES * 64), LDS_BYTES, stream, a); }
#endif
    const hipError_t le = hipPeekAtLastError();
    if (le != hipSuccess) fprintf(stderr, "kernel_launch: launch failed: %s\n", hipGetErrorName(le));
}
```

```cpp
#include <hip/hip_runtime.h>
#include <cstdio>
#include <cstdint>
#include <cmath>

namespace pg8 {
#define PG8_LAS __attribute__((address_space(3)))
typedef unsigned short bf16_t;
typedef short bf16x8 __attribute__((ext_vector_type(8)));
typedef float f32x4 __attribute__((ext_vector_type(4)));
typedef unsigned u32x4 __attribute__((ext_vector_type(4)));
constexpr int BM = 256, BK = 64, HALF = 128, HTB = HALF * BK * 2  , STAGE_BYTES = 8 * HTB, NXCD = 8, WGM = 8;

__host__ __device__ __forceinline__ int lds_byte(int r, int c) { const int st = (r >> 4) * 2 + (c >> 5), rr = r & 15, cc = c & 31, ob = rr * 64 + cc * 2; return st * 1024 + (ob ^ (((ob >> 9) & 1) << 5)); }
__host__ __device__ __forceinline__ void stage_rc(int b, int& R, int& C) { const int st = b / 1024, sb = b % 1024, swz = sb ^ (((sb >> 9) & 1) << 5); R = (st >> 1) * 16 + swz / 64; C = (st & 1) * 32 + (swz % 64) / 2; }
__host__ __device__ __forceinline__ int perm32(int rho) { const int n = rho >> 4, i = rho & 15; return 8 * (i >> 2) + 4 * n + (i & 3); }

struct Unit { int pm, pn; long bofs; int ex; };
struct Gemm { const bf16_t* A; const bf16_t* Bt; int M, N, K; };

struct StaticOrder {
    static constexpr bool GATHER = false;
    int nM, nN, nwg, G, c;
    __device__ __forceinline__ unsigned row_byteoff(const Unit&, int, int) const { return 0u; }
    __host__ __device__ void init(int M, int N, int G_, int c_) { nM = M / BM; nN = N / BM; nwg = nM * nN; G = G_; c = c_; }
    __host__ __device__ bool next(int i, Unit& u) const {
        const long L = (long)i * G + c; if (L >= nwg) return false;
        int wgid = (int)L; { const int q = nwg / NXCD, r = nwg % NXCD, xcd = wgid % NXCD, off = wgid / NXCD; wgid = (xcd < r ? xcd * (q + 1) : r * (q + 1) + (xcd - r) * q) + off; }
        const int nig = WGM * nN, gid = wgid / nig, fm = gid * WGM, gsz = (nM - fm) < WGM ? (nM - fm) : WGM;
        u.pm = fm + ((wgid % nig) % gsz); u.pn = (wgid % nig) / gsz; u.bofs = 0; u.ex = 0; return true;
    }
    __device__ __forceinline__ void a_ready(const Unit&) const {}
    __device__ __forceinline__ void done(const Unit&) const {}
};

typedef float f32x2v_ __attribute__((ext_vector_type(2))); typedef __bf16 bf16x2v_ __attribute__((ext_vector_type(2)));
__device__ __forceinline__ unsigned cvt_pk_bf16(float lo, float hi) { f32x2v_ v = {lo, hi}; bf16x2v_ b = __builtin_convertvector(v, bf16x2v_); return __builtin_bit_cast(unsigned, b); }
typedef float f32x2 __attribute__((ext_vector_type(2)));

__device__ __forceinline__ float bf_lo(unsigned w) { return __uint_as_float(w << 16); }
__device__ __forceinline__ float bf_hi(unsigned w) { return __uint_as_float(w & 0xffff0000u); }
__device__ __forceinline__ float sigmoid_f(float x) { return __builtin_amdgcn_rcpf(1.0f + __builtin_amdgcn_exp2f(-1.4426950408889634f * x)); }

struct EpiP1 {
    static constexpr bool PERM = true, AFTER_DRAIN = false, MIDK = false;
    bf16_t *QA, *KA, *VA, *QB, *KB, *VB, *GT; const float* bgate;
    __device__ __forceinline__ void operator()(const f32x4 (&acc)[2][2][4][2], const Unit& u, int wr, int wc, int fr, int fq) const {
        const int pn = u.pn; bf16_t* base; int ld, colt; bool gate = false;
        if (pn < 4)       { base = QA; ld = 1024; colt = pn * 256; }
        else if (pn == 4) { base = KA; ld = 256;  colt = 0; }
        else if (pn == 5) { base = VA; ld = 256;  colt = 0; }
        else if (pn < 10) { base = QB; ld = 1024; colt = (pn - 6) * 256; }
        else if (pn < 14) { base = KB; ld = 1024; colt = (pn - 10) * 256; }
        else if (pn < 18) { base = VB; ld = 1024; colt = (pn - 14) * 256; }
        else              { base = GT; ld = 4096; colt = (pn - 18) * 256; gate = true; }
        const int row0 = u.pm * BM + wr * 64 + fr, col0 = colt + wc * 32 + 8 * fq;
        f32x4 bv[2][2];
#pragma unroll
        for (int bj = 0; bj < 2; ++bj)
#pragma unroll
            for (int n = 0; n < 2; ++n) bv[bj][n] = gate ? *(const f32x4*)(bgate + col0 + bj * HALF + 4 * n) : (f32x4){0.f, 0.f, 0.f, 0.f};
#pragma unroll
        for (int ai = 0; ai < 2; ++ai)
#pragma unroll
            for (int m = 0; m < 4; ++m) { bf16_t* rowp = base + (size_t)(row0 + ai * HALF + m * 16) * ld + col0;
#pragma unroll
                for (int bj = 0; bj < 2; ++bj) { f32x4 v0 = acc[ai][bj][m][0] + bv[bj][0], v1 = acc[ai][bj][m][1] + bv[bj][1];
                    if (gate) {
#pragma unroll
                        for (int e = 0; e < 4; ++e) { v0[e] = sigmoid_f(v0[e]); v1[e] = sigmoid_f(v1[e]); } }
                    u32x4 w; w.x = cvt_pk_bf16(v0[0], v0[1]); w.y = cvt_pk_bf16(v0[2], v0[3]); w.z = cvt_pk_bf16(v1[0], v1[1]); w.w = cvt_pk_bf16(v1[2], v1[3]);
                    *(u32x4*)(rowp + bj * HALF) = w; } }
    }
};

struct EpiMerge {
    static constexpr bool PERM = true, AFTER_DRAIN = false, MIDK = true;
    const bf16_t* GT; bf16_t* MG;
    __device__ __forceinline__ void mid(f32x4 (&acc)[2][2][4][2], const Unit& u, int wr, int wc, int fr, int fq) const {
        asm volatile("" : "+v"(fr), "+v"(fq));
        const int row0 = u.pm * BM + wr * 64 + fr, col0 = u.pn * BM + wc * 32 + 8 * fq;
#pragma unroll
        for (int ai = 0; ai < 2; ++ai)
#pragma unroll
            for (int m = 0; m < 4; ++m) { const size_t r = (size_t)(row0 + ai * HALF + m * 16);
#pragma unroll
                for (int bj = 0; bj < 2; ++bj) { const u32x4 ga = *(const u32x4*)(GT + r * 4096 + col0 + bj * HALF), gb = *(const u32x4*)(GT + r * 4096 + 2048 + col0 + bj * HALF);
#define PG8_RT(A_, B_) ((A_) * __builtin_amdgcn_rcpf(fmaxf((B_), 1e-30f)))
                    acc[ai][bj][m][0][0] *= PG8_RT(bf_lo(ga.x), bf_lo(gb.x)); acc[ai][bj][m][0][1] *= PG8_RT(bf_hi(ga.x), bf_hi(gb.x)); acc[ai][bj][m][0][2] *= PG8_RT(bf_lo(ga.y), bf_lo(gb.y)); acc[ai][bj][m][0][3] *= PG8_RT(bf_hi(ga.y), bf_hi(gb.y));
                    acc[ai][bj][m][1][0] *= PG8_RT(bf_lo(ga.z), bf_lo(gb.z)); acc[ai][bj][m][1][1] *= PG8_RT(bf_hi(ga.z), bf_hi(gb.z)); acc[ai][bj][m][1][2] *= PG8_RT(bf_lo(ga.w), bf_lo(gb.w)); acc[ai][bj][m][1][3] *= PG8_RT(bf_hi(ga.w), bf_hi(gb.w));
#undef PG8_RT
                }
                if (m == 3) asm volatile("" ::: "memory"); }
    }
    __device__ __forceinline__ void operator()(const f32x4 (&acc)[2][2][4][2], const Unit& u, int wr, int wc, int fr, int fq) const {
        asm volatile("" : "+v"(fr), "+v"(fq));
        const int row0 = u.pm * BM + wr * 64 + fr, col0 = u.pn * BM + wc * 32 + 8 * fq;
#pragma unroll
        for (int ai = 0; ai < 2; ++ai)
#pragma unroll
            for (int m = 0; m < 4; ++m) { const size_t r = (size_t)(row0 + ai * HALF + m * 16);
#pragma unroll
                for (int bj = 0; bj < 2; ++bj) { const u32x4 g = *(const u32x4*)(GT + r * 4096 + 2048 + col0 + bj * HALF);
                    f32x4 v0 = acc[ai][bj][m][0], v1 = acc[ai][bj][m][1];
                    v0[0] *= fmaxf(bf_lo(g.x), 1e-30f); v0[1] *= fmaxf(bf_hi(g.x), 1e-30f); v0[2] *= fmaxf(bf_lo(g.y), 1e-30f); v0[3] *= fmaxf(bf_hi(g.y), 1e-30f);
                    v1[0] *= fmaxf(bf_lo(g.z), 1e-30f); v1[1] *= fmaxf(bf_hi(g.z), 1e-30f); v1[2] *= fmaxf(bf_lo(g.w), 1e-30f); v1[3] *= fmaxf(bf_hi(g.w), 1e-30f);
                    u32x4 w; w.x = cvt_pk_bf16(v0[0], v0[1]); w.y = cvt_pk_bf16(v0[2], v0[3]); w.z = cvt_pk_bf16(v1[0], v1[1]); w.w = cvt_pk_bf16(v1[2], v1[3]);
                    *(u32x4*)(MG + r * 2048 + col0 + bj * HALF) = w; }
                if (m & 1) asm volatile("" ::: "memory"); }
    }
};
struct EpiOut {
    static constexpr bool PERM = false, AFTER_DRAIN = false, MIDK = false;
    const float* X; float* X1; float* SSQ;
    __device__ __forceinline__ void operator()(const f32x4 (&acc)[2][2][4][2], const Unit& u, int wr, int wc, int fr, int fq) const {
        const int row0 = u.pm * BM + wr * 64 + fr, col0 = u.pn * BM + wc * 32 + 4 * fq;
#pragma unroll
        for (int ai = 0; ai < 2; ++ai)
#pragma unroll
            for (int m = 0; m < 4; ++m) { const size_t r = (size_t)(row0 + ai * HALF + m * 16); float s = 0.f;
#pragma unroll
                for (int bj = 0; bj < 2; ++bj)
#pragma unroll
                    for (int n = 0; n < 2; ++n) { const size_t off = r * 2048 + col0 + bj * HALF + n * 16;
                        const f32x4 v = *(const f32x4*)(X + off) + acc[ai][bj][m][n]; *(f32x4*)(X1 + off) = v;
                        s += (v[0] * v[0] + v[1] * v[1]) + (v[2] * v[2] + v[3] * v[3]); }
                s += __shfl_xor(s, 16); s += __shfl_xor(s, 32);
                if (fq == 0) SSQ[r * 32 + u.pn * 4 + wc] = s;
                if (m & 1) asm volatile("" ::: "memory"); }
    }
};
struct EpiG1 {
    static constexpr bool PERM = true, AFTER_DRAIN = false, MIDK = false;
    bf16_t* U;
    __device__ __forceinline__ void operator()(const f32x4 (&acc)[2][2][4][2], const Unit& u, int wr, int wc, int fr, int fq) const {
        const int row0 = u.pm * BM + wr * 64 + fr, col0 = u.pn * HALF + wc * 32 + 8 * fq;
#pragma unroll
        for (int ai = 0; ai < 2; ++ai)
#pragma unroll
            for (int m = 0; m < 4; ++m) { f32x4 v0, v1;
#pragma unroll
                for (int e = 0; e < 4; ++e) { const float g0 = acc[ai][0][m][0][e], g1 = acc[ai][0][m][1][e];
                    v0[e] = g0 * sigmoid_f(g0) * acc[ai][1][m][0][e]; v1[e] = g1 * sigmoid_f(g1) * acc[ai][1][m][1][e]; }
                u32x4 w; w.x = cvt_pk_bf16(v0[0], v0[1]); w.y = cvt_pk_bf16(v0[2], v0[3]); w.z = cvt_pk_bf16(v1[0], v1[1]); w.w = cvt_pk_bf16(v1[2], v1[3]);
                *(u32x4*)(U + (size_t)(row0 + ai * HALF + m * 16) * 512 + col0) = w; }
    }
};
constexpr int MOE_LCAP = 32768;
struct EpiG2 {
    static constexpr bool PERM = true, AFTER_DRAIN = false, MIDK = false;
    bf16_t* YC; const float* LW; const PG8_LAS int* tab;
    __device__ __forceinline__ void operator()(const f32x4 (&acc)[2][2][4][2], const Unit& u, int wr, int wc, int fr, int fq) const {
        const int row0 = u.pm * BM + wr * 64 + fr, col0 = u.pn * BM + wc * 32 + 8 * fq;
        const int slot0 = (u.pm - tab[32 + u.ex]) * BM + wr * 64 + fr, cnt = tab[u.ex];
#pragma unroll
        for (int ai = 0; ai < 2; ++ai)
#pragma unroll
            for (int m = 0; m < 4; ++m) { const size_t r = (size_t)(row0 + ai * HALF + m * 16); const int slot = slot0 + ai * HALF + m * 16;
                const float wt = slot < cnt ? LW[(size_t)u.ex * MOE_LCAP + slot] : 0.f;
#pragma unroll
                for (int bj = 0; bj < 2; ++bj) { const f32x4 v0 = acc[ai][bj][m][0] * wt, v1 = acc[ai][bj][m][1] * wt;
                    u32x4 w; w.x = cvt_pk_bf16(v0[0], v0[1]); w.y = cvt_pk_bf16(v0[2], v0[3]); w.z = cvt_pk_bf16(v1[0], v1[1]); w.w = cvt_pk_bf16(v1[2], v1[3]);
                    *(u32x4*)(YC + r * 2048 + col0 + bj * HALF) = w; } }
    }
};
template <int NT, long BSTRIDE  , bool GATHER_> struct MoeOrder {
    static constexpr bool GATHER = GATHER_;
    const PG8_LAS int* tab; int G, c; const int* LENT;
    __device__ __forceinline__ bool next(int i, Unit& u) const {
        const int P = tab[64]; const long L = (long)i * G + c; if (L >= (long)P * NT) return false;
        const int p = (int)(L / NT); int e = 0;
#pragma unroll 1
        for (int k = 1; k < 32; ++k) if (tab[32 + k] <= p) e = k;
        u.pm = p; u.pn = (int)(L % NT); u.bofs = (long)e * BSTRIDE; u.ex = e; return true;
    }
    __device__ __forceinline__ unsigned row_byteoff(const Unit& u, int row, int K) const {
        const int slot = (u.pm - tab[32 + u.ex]) * BM + row; const int tok = slot < tab[u.ex] ? (LENT[(size_t)u.ex * MOE_LCAP + slot] >> 1) : 0;
        return (unsigned)tok * (unsigned)(K * 2);
    }
    __device__ __forceinline__ void a_ready(const Unit&) const {}
    __device__ __forceinline__ void done(const Unit&) const {}
};

template <class Epi, class Sched, bool ALIGN_EPI = false, bool SP2 = false>
__device__ __forceinline__ void gemm_phase(PG8_LAS unsigned char* lds, const Gemm g, const Sched& S, const Epi& E) {
    const int tid = threadIdx.x, wid = __builtin_amdgcn_readfirstlane(tid >> 6), lane = tid & 63, wr = wid >> 2, wc = wid & 3, fr = lane & 15, fq = lane >> 4;
    const int K = g.K, nt = K / BK;
    unsigned voffA[2], voffB[2];
#pragma unroll
    for (int i = 0; i < 2; ++i) { int R, C; stage_rc(tid * 16 + i * 8192, R, C); const int Rb = Epi::PERM ? ((R & ~31) + perm32(R & 31)) : R;
        voffA[i] = (unsigned)(R * K + C) * 2u; voffB[i] = (unsigned)(Rb * K + C) * 2u; }
    const size_t kstep = (size_t)(BK * 2);
    const size_t hstep = (size_t)HALF * K * 2;
    const size_t tstep = 2 * hstep;
    const unsigned ldsw = (unsigned)wid * 1024u;
    const int aoff = lds_byte(wr * 64 + fr, fq * 8), boff = lds_byte(wc * 32 + fr, fq * 8);
#define PG8_SA(b, h) (((b) * 2 + (h)) * HTB)
#define PG8_SB(b, h) ((4 + (b) * 2 + (h)) * HTB)
#define PG8_STAGE(bufoff, gbase, voff) do { _Pragma("unroll") for (int _i = 0; _i < 2; ++_i) \
        __builtin_amdgcn_global_load_lds((const unsigned*)((const char*)(gbase) + (voff)[_i]), (PG8_LAS unsigned*)(lds + (bufoff) + ldsw + _i * 8192), 16, 0, 0); } while (0)
#define PG8_STAGEA(bufoff, gbase, h, nx) do { if constexpr (Sched::GATHER) { _Pragma("unroll") for (int _i = 0; _i < 2; ++_i) { const unsigned vo_ = (nx) ? voffAn[h][_i] : voffAc[h][_i]; \
        __builtin_amdgcn_global_load_lds((const unsigned*)((const char*)(gbase) + vo_), (PG8_LAS unsigned*)(lds + (bufoff) + ldsw + _i * 8192), 16, 0, 0); } } \
    else { PG8_STAGE(bufoff, (gbase) + (h) * hstep, voffA); } } while (0)
#define PG8_LDA(dst, b, h) do { _Pragma("unroll") for (int m = 0; m < 4; ++m) _Pragma("unroll") for (int k = 0; k < 2; ++k) dst[m][k] = *(const PG8_LAS bf16x8*)(lds + PG8_SA(b, h) + aoff + m * 2048 + k * 1024); } while (0)
#define PG8_LDB(dst, b, h) do { _Pragma("unroll") for (int n = 0; n < 2; ++n) _Pragma("unroll") for (int k = 0; k < 2; ++k) dst[n][k] = *(const PG8_LAS bf16x8*)(lds + PG8_SB(b, h) + boff + n * 2048 + k * 1024); } while (0)
#define PG8_MMA(ai, bj, At, Bt) do { __builtin_amdgcn_s_setprio(1); _Pragma("unroll") for (int m = 0; m < 4; ++m) _Pragma("unroll") for (int n = 0; n < 2; ++n) _Pragma("unroll") for (int k = 0; k < 2; ++k) \
        acc[ai][bj][m][n] = __builtin_amdgcn_mfma_f32_16x16x32_bf16(Bt[n][k], At[m][k], acc[ai][bj][m][n], 0, 0, 0); __builtin_amdgcn_s_setprio(0); } while (0)
#define PG8_WAIT_V(n) asm volatile("s_waitcnt vmcnt(" #n ")" ::: "memory")
#define PG8_WAIT_L(n) asm volatile("s_waitcnt lgkmcnt(" #n ")" ::: "memory")
#define PG8_BAR __builtin_amdgcn_s_barrier()
#define PG8_SCHED __builtin_amdgcn_sched_barrier(0)
    Unit cur, nxt; int ui = 0;
    if (!S.next(0, cur)) return;
    f32x4 acc[2][2][4][2];
#pragma unroll
    for (int a = 0; a < 2; ++a)
#pragma unroll
        for (int b = 0; b < 2; ++b)
#pragma unroll
            for (int m = 0; m < 4; ++m)
#pragma unroll
                for (int n = 0; n < 2; ++n) acc[a][b][m][n] = (f32x4){0.f, 0.f, 0.f, 0.f};
    bf16x8 At[4][2], B0[2][2], B1[2][2];
    const char* cA = (const char*)g.A + (Sched::GATHER ? (size_t)0 : (size_t)cur.pm * tstep); const char* cB = (const char*)g.Bt + (size_t)cur.pn * tstep + cur.bofs;
    unsigned voffAc[2][2] = {{0u, 0u}, {0u, 0u}}, voffAn[2][2] = {{0u, 0u}, {0u, 0u}};
    if constexpr (Sched::GATHER) {
#pragma unroll
        for (int h = 0; h < 2; ++h)
#pragma unroll
            for (int i = 0; i < 2; ++i) { int R, C; stage_rc(tid * 16 + i * 8192, R, C); voffAc[h][i] = S.row_byteoff(cur, h * HALF + R, K) + (unsigned)C * 2u; }
    }
    S.a_ready(cur);
    if constexpr (SP2) {
        PG8_STAGE(PG8_SB(0, 0), cB, voffB); PG8_STAGE(PG8_SB(0, 1), cB + hstep, voffB); PG8_STAGEA(PG8_SA(0, 0), cA, 0, false); PG8_STAGEA(PG8_SA(0, 1), cA, 1, false);
        if (wr == 1) PG8_BAR;
        PG8_WAIT_V(2); PG8_BAR;
        PG8_STAGE(PG8_SB(1, 0), cB + kstep, voffB); PG8_STAGEA(PG8_SA(1, 0), cA + kstep, 0, false); PG8_STAGE(PG8_SB(1, 1), cB + hstep + kstep, voffB);
        PG8_WAIT_V(6); PG8_BAR;
    } else {
        PG8_STAGE(PG8_SB(0, 0), cB, voffB); PG8_STAGE(PG8_SA(0, 0), cA, voffA); PG8_STAGE(PG8_SB(0, 1), cB + hstep, voffB); PG8_STAGE(PG8_SA(0, 1), cA + hstep, voffA);
        if (wr == 1) PG8_BAR;
        PG8_WAIT_V(4); PG8_BAR;
        PG8_STAGE(PG8_SB(1, 0), cB + kstep, voffB); PG8_STAGE(PG8_SA(1, 0), cA + kstep, voffA); PG8_STAGE(PG8_SB(1, 1), cB + hstep + kstep, voffB);
        PG8_WAIT_V(6); PG8_BAR;
    }
    for (;;) {
        const bool has_next = S.next(ui + 1, nxt);
        if constexpr (Sched::GATHER) { if (has_next) {
#pragma unroll
            for (int h = 0; h < 2; ++h)
#pragma unroll
                for (int i = 0; i < 2; ++i) { int R, C; stage_rc(tid * 16 + i * 8192, R, C); voffAn[h][i] = S.row_byteoff(nxt, h * HALF + R, K) + (unsigned)C * 2u; } }
            else {
#pragma unroll
            for (int h = 0; h < 2; ++h)
#pragma unroll
                for (int i = 0; i < 2; ++i) voffAn[h][i] = voffAc[h][i]; } }
        const char* nA = Sched::GATHER ? cA : (has_next ? (const char*)g.A + (size_t)nxt.pm * tstep : cA); const char* nB = has_next ? (const char*)g.Bt + (size_t)nxt.pn * tstep + nxt.bofs : cB;
        constexpr int NKH = Epi::MIDK ? 2 : 1;
        int t = 0;
#pragma unroll 1
        for (int kh = 0; kh < NKH; ++kh) {
        const int tend = (NKH == 2 && kh == 0) ? nt / 2 : nt;
#pragma unroll 1
        for (; t < tend; t += 2) {
            const bool last = (t == nt - 2);
            const char* a1 = cA + (size_t)(t + 1) * kstep;
            const char* a2 = last ? nA : cA + (size_t)(t + 2) * kstep; const char* b2 = last ? nB : cB + (size_t)(t + 2) * kstep;
            const char* a3 = a2 + kstep; const char* b3 = b2 + kstep;
            if (last && has_next) S.a_ready(nxt);
            if constexpr (SP2) {
            PG8_LDB(B0, 0, 0); PG8_LDB(B1, 0, 1); PG8_SCHED; PG8_LDA(At, 0, 0); PG8_STAGEA(PG8_SA(1, 1), a1, 1, false);
            PG8_WAIT_V(8); PG8_WAIT_L(0); PG8_BAR; PG8_MMA(0, 0, At, B0); PG8_MMA(0, 1, At, B1); PG8_BAR; PG8_SCHED;
            PG8_LDA(At, 0, 1); PG8_STAGE(PG8_SB(0, 0), b2, voffB); PG8_STAGE(PG8_SB(0, 1), b2 + hstep, voffB); PG8_STAGEA(PG8_SA(0, 0), a2, 0, last);
            PG8_WAIT_V(8); PG8_WAIT_L(0); PG8_BAR; PG8_MMA(1, 0, At, B0); PG8_MMA(1, 1, At, B1); PG8_BAR; PG8_SCHED;
            PG8_LDB(B0, 1, 0); PG8_LDB(B1, 1, 1); PG8_SCHED; PG8_LDA(At, 1, 0); PG8_STAGEA(PG8_SA(0, 1), a2, 1, last);
            PG8_WAIT_V(8); PG8_WAIT_L(0); PG8_BAR; PG8_MMA(0, 0, At, B0); PG8_MMA(0, 1, At, B1); PG8_BAR; PG8_SCHED;
            PG8_LDA(At, 1, 1); PG8_STAGE(PG8_SB(1, 0), b3, voffB); PG8_STAGE(PG8_SB(1, 1), b3 + hstep, voffB); PG8_STAGEA(PG8_SA(1, 0), a3, 0, last);
            PG8_WAIT_V(8); PG8_WAIT_L(0); PG8_BAR; PG8_MMA(1, 0, At, B0); PG8_MMA(1, 1, At, B1); PG8_BAR; PG8_SCHED;
            } else {
            PG8_LDB(B0, 0, 0); PG8_SCHED; PG8_LDA(At, 0, 0); PG8_STAGE(PG8_SA(1, 1), a1 + hstep, voffA);
            PG8_WAIT_L(8); PG8_BAR; PG8_WAIT_L(0); PG8_MMA(0, 0, At, B0); PG8_BAR; PG8_SCHED;
            PG8_LDB(B1, 0, 1); PG8_STAGE(PG8_SB(0, 0), b2, voffB);
            PG8_BAR; PG8_WAIT_L(0); PG8_MMA(0, 1, At, B1); PG8_BAR;
            PG8_LDA(At, 0, 1); PG8_STAGE(PG8_SA(0, 0), a2, voffA);
            PG8_BAR; PG8_WAIT_L(0); PG8_MMA(1, 0, At, B0); PG8_BAR; PG8_SCHED;
            PG8_STAGE(PG8_SB(0, 1), b2 + hstep, voffB);
            PG8_WAIT_V(6); PG8_BAR; PG8_MMA(1, 1, At, B1); PG8_BAR;
            PG8_LDB(B0, 1, 0); PG8_SCHED; PG8_LDA(At, 1, 0); PG8_STAGE(PG8_SA(0, 1), a2 + hstep, voffA);
            PG8_WAIT_L(8); PG8_BAR; PG8_WAIT_L(0); PG8_MMA(0, 0, At, B0); PG8_BAR; PG8_SCHED;
            PG8_LDB(B1, 1, 1); PG8_STAGE(PG8_SB(1, 0), b3, voffB);
            PG8_BAR; PG8_WAIT_L(0); PG8_MMA(0, 1, At, B1); PG8_BAR;
            PG8_LDA(At, 1, 1); PG8_STAGE(PG8_SA(1, 0), a3, voffA);
            PG8_BAR; PG8_WAIT_L(0); PG8_MMA(1, 0, At, B0); PG8_BAR; PG8_SCHED;
            PG8_STAGE(PG8_SB(1, 1), b3 + hstep, voffB);
            PG8_WAIT_V(6); PG8_BAR; PG8_MMA(1, 1, At, B1); PG8_BAR;
            }
        }
        if constexpr (Epi::MIDK) { if (kh == 0) E.mid(acc, cur, wr, wc, fr, fq); }
        }
        if constexpr (ALIGN_EPI) { if (wr == 0) PG8_BAR; }
        if constexpr (!Epi::AFTER_DRAIN) { E(acc, cur, wr, wc, fr, fq); S.done(cur); }
        if (!has_next) break;
#pragma unroll
        for (int a = 0; a < 2; ++a)
#pragma unroll
            for (int b = 0; b < 2; ++b)
#pragma unroll
                for (int m = 0; m < 4; ++m)
#pragma unroll
                    for (int n = 0; n < 2; ++n) acc[a][b][m][n] = (f32x4){0.f, 0.f, 0.f, 0.f};
        cur = nxt; cA = nA; cB = nB; ++ui;
        if constexpr (Sched::GATHER) {
#pragma unroll
            for (int h = 0; h < 2; ++h)
#pragma unroll
                for (int i = 0; i < 2; ++i) voffAc[h][i] = voffAn[h][i]; }
        if constexpr (ALIGN_EPI) { if (wr == 1) PG8_BAR; }
    }
    PG8_WAIT_V(0);
    if constexpr (!ALIGN_EPI) { if (wr == 0) PG8_BAR; }
    PG8_BAR;
    if constexpr (Epi::AFTER_DRAIN) { E.fused(acc, cur, wr, wc, fr, fq, lds, wid, lane); S.done(cur); }
#undef PG8_SA
#undef PG8_SB
#undef PG8_STAGE
#undef PG8_STAGEA
#undef PG8_LDA
#undef PG8_LDB
#undef PG8_MMA
#undef PG8_WAIT_V
#undef PG8_WAIT_L
#undef PG8_BAR
#undef PG8_SCHED
}
}

namespace att {
typedef unsigned short bf16;
using bf16x8 = __attribute__((ext_vector_type(8))) short;
using s16x4  = __attribute__((ext_vector_type(4))) short;
using f32x16 = __attribute__((ext_vector_type(16))) float;
using u32x4  = __attribute__((ext_vector_type(4))) unsigned;
constexpr int NW = 8, QBLK = 32, KVBLK = 64, DV = 128;
constexpr int SHM_V = KVBLK * DV * 2;
constexpr int OFF_V = 0, OFF_K = 3 * SHM_V, OFF_STASH = 73728;
constexpr float THR = 8.f;
#define ATT_SBAR() __builtin_amdgcn_sched_barrier(0)
template <int DQK> __device__ __forceinline__ int kswz(int row, int colB) { return row * (DQK * 2) + (colB ^ ((DQK == 128 ? ((row & 7) | (((row >> 4) & 1) << 3)) : ((row >> 1) & 7)) << 4)); }
__device__ __forceinline__ int crow(int r, int hi) { return (r & 3) + 8 * (r >> 2) + 4 * hi; }
typedef float f32x2_t __attribute__((ext_vector_type(2))); typedef __bf16 bf16x2_t __attribute__((ext_vector_type(2)));
__device__ __forceinline__ unsigned cvtpk(float lo, float hi) { f32x2_t v = {lo, hi}; bf16x2_t b = __builtin_convertvector(v, bf16x2_t); return __builtin_bit_cast(unsigned, b); }

template <int DQK> __device__ __forceinline__ void partialSM(f32x16& p0, f32x16& p1, float& m_reg, float& mn, float& alpha) {
  constexpr float SCALE = (DQK == 128) ? 0.088388347648318440f : 0.125f;
  constexpr float C = SCALE * 1.4426950408889634f;
  float pmax = p0[0];
#pragma unroll
  for (int r = 1; r < 16; ++r) pmax = fmaxf(pmax, p0[r]);
#pragma unroll
  for (int r = 0; r < 16; ++r) pmax = fmaxf(pmax, p1[r]);
  { auto rr = __builtin_amdgcn_permlane32_swap(__float_as_uint(pmax), __float_as_uint(pmax), false, false);
    pmax = fmaxf(__uint_as_float(rr[0]), __uint_as_float(rr[1])); }
  if (__builtin_expect(__all(pmax - m_reg <= THR / SCALE), 1)) { mn = m_reg; alpha = 1.f; }
  else { mn = fmaxf(m_reg, pmax); alpha = __builtin_amdgcn_exp2f((m_reg - mn) * C); m_reg = mn; }
  const float mnC = -mn * C;
#pragma unroll
  for (int r = 0; r < 16; ++r) p0[r] = fmaf(p0[r], C, mnC);
#pragma unroll
  for (int r = 0; r < 16; ++r) p1[r] = fmaf(p1[r], C, mnC);
#pragma unroll
  for (int r = 0; r < 16; ++r) p0[r] = __builtin_amdgcn_exp2f(p0[r]);
}
__device__ __forceinline__ void finishSM(f32x16& p0, f32x16& p1, float alpha, float& l_reg, bf16x8& pa0, bf16x8& pa1, bf16x8& pa2, bf16x8& pa3) {
#pragma unroll
  for (int r = 0; r < 16; ++r) p1[r] = __builtin_amdgcn_exp2f(p1[r]);
  float ps = 0;
#pragma unroll
  for (int r = 0; r < 16; ++r) ps += p0[r];
#pragma unroll
  for (int r = 0; r < 16; ++r) ps += p1[r];
  { auto rr = __builtin_amdgcn_permlane32_swap(__float_as_uint(ps), __float_as_uint(ps), false, false);
    ps = __uint_as_float(rr[0]) + __uint_as_float(rr[1]); }
  l_reg = l_reg * alpha + ps;
#define ATT_PK4(P, BASE, OUT) do { unsigned a0 = cvtpk(P[BASE + 0], P[BASE + 1]), a1 = cvtpk(P[BASE + 2], P[BASE + 3]);   \
    unsigned b0 = cvtpk(P[BASE + 4], P[BASE + 5]), b1 = cvtpk(P[BASE + 6], P[BASE + 7]);                              \
    auto r0 = __builtin_amdgcn_permlane32_swap(a0, b0, false, false); auto r1 = __builtin_amdgcn_permlane32_swap(a1, b1, false, false); \
    u32x4 w = {r0[0], r1[0], r0[1], r1[1]}; OUT = *reinterpret_cast<bf16x8*>(&w); } while (0)
  ATT_PK4(p0, 0, pa0); ATT_PK4(p0, 8, pa1); ATT_PK4(p1, 0, pa2); ATT_PK4(p1, 8, pa3);
#undef ATT_PK4
}
template <int DQK> __device__ __forceinline__ void qkt(f32x16& p0, f32x16& p1, const char* Ks, const bf16x8* qr, int r32, int hi) {
  p0 = f32x16{}; p1 = f32x16{};
#pragma unroll
  for (int d0 = 0; d0 < DQK / 16; ++d0) { const int cb = (d0 * 16 + hi * 8) * 2;
    const bf16x8 b0 = *reinterpret_cast<const bf16x8*>(Ks + kswz<DQK>(r32, cb));
    const bf16x8 b1 = *reinterpret_cast<const bf16x8*>(Ks + kswz<DQK>(32 + r32, cb));
    p0 = __builtin_amdgcn_mfma_f32_32x32x16_bf16(b0, qr[d0], p0, 0, 0, 0);
    p1 = __builtin_amdgcn_mfma_f32_32x32x16_bf16(b1, qr[d0], p1, 0, 0, 0); }
}
__device__ __forceinline__ int v_st(int k, int c) { const int kk = (k & ~0xC) | ((k & 4) << 1) | ((k & 8) >> 1); return ((kk >> 3) * 4 + (c >> 5)) * 512 + ((kk & 7) * 32 + (c & 31)) * 2; }
__device__ __forceinline__ int v_rd_base(int lane) { return ((lane & 3) << 3) | (((lane >> 2) & 3) << 6) | (((lane >> 4) & 1) << 5) | (((lane >> 5) & 1) << 8); }
constexpr int v_rd_off(int d0, int ks, int half) { return d0 * 512 + ks * 4096 + half * 2048; }
template <int OFF> __device__ __forceinline__ s16x4 tr_read(int vb) {
  s16x4 r; asm volatile("ds_read_b64_tr_b16 %0, %1 offset:%2" : "=&v"(r) : "v"(vb), "i"(OFF) : "memory"); return r;
}
typedef __attribute__((address_space(3))) const char* lds_cptr;
typedef short v4i16_t __attribute__((ext_vector_type(4)));
__device__ __forceinline__ s16x4 vtr(lds_cptr p) { return __builtin_bit_cast(s16x4, __builtin_amdgcn_ds_read_tr16_b64_v4i16((__attribute__((address_space(3))) v4i16_t*)p)); }
template <int D0> __device__ __forceinline__ void pv_one(f32x16& od, int vb, bf16x8 pa0, bf16x8 pa1, bf16x8 pa2, bf16x8 pa3) {
  const s16x4 l0 = tr_read<v_rd_off(D0, 0, 0)>(vb), h0 = tr_read<v_rd_off(D0, 0, 1)>(vb), l1 = tr_read<v_rd_off(D0, 1, 0)>(vb), h1 = tr_read<v_rd_off(D0, 1, 1)>(vb);
  const s16x4 l2 = tr_read<v_rd_off(D0, 2, 0)>(vb), h2 = tr_read<v_rd_off(D0, 2, 1)>(vb), l3 = tr_read<v_rd_off(D0, 3, 0)>(vb), h3 = tr_read<v_rd_off(D0, 3, 1)>(vb);
  asm volatile("s_waitcnt lgkmcnt(0)" ::: "memory"); ATT_SBAR();
#define ATT_PK(L, H) (bf16x8){L[0], L[1], L[2], L[3], H[0], H[1], H[2], H[3]}
  od = __builtin_amdgcn_mfma_f32_32x32x16_bf16(pa0, ATT_PK(l0, h0), od, 0, 0, 0);
  od = __builtin_amdgcn_mfma_f32_32x32x16_bf16(pa1, ATT_PK(l1, h1), od, 0, 0, 0);
  od = __builtin_amdgcn_mfma_f32_32x32x16_bf16(pa2, ATT_PK(l2, h2), od, 0, 0, 0);
  od = __builtin_amdgcn_mfma_f32_32x32x16_bf16(pa3, ATT_PK(l3, h3), od, 0, 0, 0);
#undef ATT_PK
}
__device__ __forceinline__ void pv_d0(f32x16* o, int vb, bf16x8 pa0, bf16x8 pa1, bf16x8 pa2, bf16x8 pa3) {
  pv_one<0>(o[0], vb, pa0, pa1, pa2, pa3); pv_one<1>(o[1], vb, pa0, pa1, pa2, pa3); pv_one<2>(o[2], vb, pa0, pa1, pa2, pa3); pv_one<3>(o[3], vb, pa0, pa1, pa2, pa3);
}

constexpr float THRL = 11.5f;
__device__ __forceinline__ void softmax_tile(f32x16& p0, f32x16& p1, f32x16& negm, float& alpha, bool first, bf16x8& pa0, bf16x8& pa1, bf16x8& pa2, bf16x8& pa3) {
  float pmax = fmaxf(p0[0], p1[0]);
#pragma unroll
  for (int r = 1; r < 16; ++r) pmax = fmaxf(pmax, fmaxf(p0[r], p1[r]));
  { auto rr = __builtin_amdgcn_permlane32_swap(__float_as_uint(pmax), __float_as_uint(pmax), false, false);
    pmax = fmaxf(__uint_as_float(rr[0]), __uint_as_float(rr[1])); }
  alpha = 1.f;
  if (__builtin_expect(first || !__all(pmax <= THRL), 0)) {
    const float delta = first ? pmax : fmaxf(pmax, 0.f);
    alpha = first ? 1.f : __builtin_amdgcn_exp2f(-delta);
#pragma unroll
    for (int r = 0; r < 16; ++r) { p0[r] -= delta; p1[r] -= delta; negm[r] -= delta; }
  }
#pragma unroll
  for (int r = 0; r < 16; ++r) { p0[r] = __builtin_amdgcn_exp2f(p0[r]); p1[r] = __builtin_amdgcn_exp2f(p1[r]); }
#define ATT_PK4(P, BASE, OUT) do { unsigned a0 = cvtpk(P[BASE + 0], P[BASE + 1]), a1 = cvtpk(P[BASE + 2], P[BASE + 3]);   \
    unsigned b0 = cvtpk(P[BASE + 4], P[BASE + 5]), b1 = cvtpk(P[BASE + 6], P[BASE + 7]);                              \
    auto r0 = __builtin_amdgcn_permlane32_swap(a0, b0, false, false); auto r1 = __builtin_amdgcn_permlane32_swap(a1, b1, false, false); \
    u32x4 w = {r0[0], r1[0], r0[1], r1[1]}; OUT = *reinterpret_cast<bf16x8*>(&w); } while (0)
  ATT_PK4(p0, 0, pa0); ATT_PK4(p0, 8, pa1); ATT_PK4(p1, 0, pa2); ATT_PK4(p1, 8, pa3);
#undef ATT_PK4
}

template <int DQK> __device__ __forceinline__ void q_prepare(bf16x8 (&qr)[DQK / 16], const float* rope, const float* gain, int s, int hi) {
  typedef float f32x4q __attribute__((ext_vector_type(4)));
  constexpr float CS = (DQK == 128) ? 0.12751743074602467f : 0.18033688011112042f;
  float v[DQK / 16][8];
#pragma unroll
  for (int d0 = 0; d0 < DQK / 16; ++d0) { const u32x4 w = *reinterpret_cast<const u32x4*>(&qr[d0]);
    v[d0][0] = __uint_as_float(w.x << 16); v[d0][1] = __uint_as_float(w.x & 0xffff0000u); v[d0][2] = __uint_as_float(w.y << 16); v[d0][3] = __uint_as_float(w.y & 0xffff0000u);
    v[d0][4] = __uint_as_float(w.z << 16); v[d0][5] = __uint_as_float(w.z & 0xffff0000u); v[d0][6] = __uint_as_float(w.w << 16); v[d0][7] = __uint_as_float(w.w & 0xffff0000u); }
  float mul = CS;
  if constexpr (DQK == 128) {
    float ss = 0.f;
#pragma unroll
    for (int d0 = 0; d0 < 8; ++d0)
#pragma unroll
      for (int j = 0; j < 8; ++j) ss += v[d0][j] * v[d0][j];
    ss += __shfl_xor(ss, 32);
    mul = CS / sqrtf(ss * (1.0f / 128.0f) + 1e-6f);
#pragma unroll
    for (int d0 = 0; d0 < 8; ++d0) { const f32x4q g0 = *(const f32x4q*)(gain + 16 * d0 + 8 * hi), g1 = *(const f32x4q*)(gain + 16 * d0 + 8 * hi + 4);
      v[d0][0] *= g0.x; v[d0][1] *= g0.y; v[d0][2] *= g0.z; v[d0][3] *= g0.w; v[d0][4] *= g1.x; v[d0][5] *= g1.y; v[d0][6] *= g1.z; v[d0][7] *= g1.w; }
  }
#pragma unroll
  for (int blk = 0; blk < DQK / 64; ++blk) {
    const int pos = (DQK == 128) ? (blk == 0 ? (s >> 6) : (s & 63)) : s;
#pragma unroll
    for (int dd = 0; dd < 2; ++dd) {
      const f32x4q* tp = (const f32x4q*)(rope + ((size_t)pos * 32 + 16 * dd + 8 * hi) * 2);
      const f32x4q t0 = tp[0], t1 = tp[1], t2 = tp[2], t3 = tp[3];
      const float cs[8] = {t0.x, t0.z, t1.x, t1.z, t2.x, t2.z, t3.x, t3.z}, sn[8] = {t0.y, t0.w, t1.y, t1.w, t2.y, t2.w, t3.y, t3.w};
#pragma unroll
      for (int j = 0; j < 8; ++j) { const float x1 = v[4 * blk + dd][j], x2 = v[4 * blk + dd + 2][j];
        v[4 * blk + dd][j] = x1 * cs[j] - x2 * sn[j]; v[4 * blk + dd + 2][j] = x2 * cs[j] + x1 * sn[j]; }
    }
  }
#pragma unroll
  for (int d0 = 0; d0 < DQK / 16; ++d0) { u32x4 w = {cvtpk(v[d0][0] * mul, v[d0][1] * mul), cvtpk(v[d0][2] * mul, v[d0][3] * mul), cvtpk(v[d0][4] * mul, v[d0][5] * mul), cvtpk(v[d0][6] * mul, v[d0][7] * mul)};
    qr[d0] = *reinterpret_cast<bf16x8*>(&w); }
}

template <int DQK, int LDQ, int LDK, int LDV, int ABL = 0>
__device__ __forceinline__ void attn_pass(const bf16* __restrict__ Qb, const bf16* __restrict__ Kh, const bf16* __restrict__ Vh, int seq, char* lds, float* wsf, f32x16 (&o)[4], float (&rli)[16], const float* rope, const float* gain, int s0) {
  constexpr int SHM_K = KVBLK * DQK * 2, NKF = DQK / 8;
  int tid_ = threadIdx.x; asm volatile("" : "+v"(tid_));
  const int tid = tid_, lane = tid & 63, r32 = lane & 31, hi = lane >> 5;
  const int wid = __builtin_amdgcn_readfirstlane(tid >> 6), grp = wid >> 2;
  char* V_lds = lds + OFF_V; char* K_lds = lds + OFF_K;
  float* al_l = wsf + 32;
  bf16x8 qr[DQK / 16];
  const bf16* Qw = Qb + (long)(wid * QBLK + r32) * LDQ + hi * 8;
#pragma unroll
  for (int d0 = 0; d0 < DQK / 16; ++d0) qr[d0] = *reinterpret_cast<const bf16x8*>(Qw + d0 * 16);
  q_prepare<DQK>(qr, rope, gain, s0 + wid * QBLK + r32, hi);
#pragma unroll
  for (int d0 = 0; d0 < DQK / 16; ++d0) asm volatile("" : "+v"(qr[d0]));
  f32x16 lacc = f32x16{}, negm = f32x16{}; asm volatile("" : "+v"(lacc));
#pragma unroll
  for (int d = 0; d < 4; ++d) o[d] = f32x16{};
  const int sr = tid >> 4, sc = (tid & 15) * 8, vst0 = v_st(sr, sc), vst1 = v_st(32 + sr, sc);
  const int kr = (DQK == 128) ? sr : (tid >> 3), kc = (DQK == 128) ? sc : (tid & 7) * 8;
  const int vb0 = (int)(uintptr_t)V_lds + v_rd_base(lane);
  bf16x8 sv0, sv1, sk0, sk1;
  const bf16* kp = Kh + (long)kr * LDK + kc; const bf16* vp = Vh + (long)sr * LDV + sc;
#define ATT_LOAD_K(t) do { sk0 = *reinterpret_cast<const bf16x8*>(kp + (long)(t) * (KVBLK * LDK)); if constexpr (DQK == 128) sk1 = *reinterpret_cast<const bf16x8*>(kp + (long)(t) * (KVBLK * LDK) + 32 * LDK); } while (0)
#define ATT_LOAD_V(t) do { sv0 = *reinterpret_cast<const bf16x8*>(vp + (long)(t) * (KVBLK * LDV)); sv1 = *reinterpret_cast<const bf16x8*>(vp + (long)(t) * (KVBLK * LDV) + 32 * LDV); } while (0)
#define ATT_WRITE_K(so) do { *(bf16x8*)(K_lds + (so) + kswz<DQK>(kr, kc * 2)) = sk0; if constexpr (DQK == 128) *(bf16x8*)(K_lds + (so) + kswz<DQK>(32 + kr, kc * 2)) = sk1; } while (0)
#define ATT_WRITE_V(so) do { *(bf16x8*)(V_lds + (so) + vst0) = sv0; *(bf16x8*)(V_lds + (so) + vst1) = sv1; } while (0)
#define ATT_BAR() do { ATT_SBAR(); asm volatile("s_barrier" ::: "memory"); ATT_SBAR(); } while (0)
#define ATT_RESC(a) do { if (__any((a) < 1.f)) { if (hi == 0) al_l[r32] = (a); asm volatile("s_waitcnt lgkmcnt(0)" ::: "memory"); \
    _Pragma("unroll") for (int r = 0; r < 16; ++r) { const float f_ = al_l[crow(r, hi)]; lacc[r] *= f_; _Pragma("unroll") for (int d = 0; d < 4; ++d) o[d][r] *= f_; } } } while (0)
#define ATT_MF(A_, B_, C_) do { if constexpr (ABL & 2) { asm volatile("" :: "v"(A_), "v"(B_)); } else { C_ = __builtin_amdgcn_mfma_f32_32x32x16_bf16(A_, B_, C_, 0, 0, 0); } } while (0)
#define ATT_VF(buf, ks) (bf16x8){buf[2 * ks][0], buf[2 * ks][1], buf[2 * ks][2], buf[2 * ks][3], buf[2 * ks + 1][0], buf[2 * ks + 1][1], buf[2 * ks + 1][2], buf[2 * ks + 1][3]}
  const int NT = seq / KVBLK;
  f32x16 p0, p1; float alpha; bf16x8 pa0, pa1, pa2, pa3;
  const bf16x8 ones = {0x3F80, 0x3F80, 0x3F80, 0x3F80, 0x3F80, 0x3F80, 0x3F80, 0x3F80};
  ATT_LOAD_K(0); ATT_LOAD_V(0); ATT_WRITE_K(0); ATT_WRITE_V(0);
  ATT_LOAD_K(1); ATT_WRITE_K(SHM_K);
  ATT_LOAD_K(2); ATT_LOAD_V(1);
  asm volatile("s_waitcnt lgkmcnt(0)" ::: "memory"); ATT_BAR();
  if (grp == 1) ATT_BAR();
  qkt<DQK>(p0, p1, K_lds, qr, r32, hi);
  ATT_BAR();
  int k1 = SHM_K, k2 = 2 * SHM_K, k0 = 0, v0 = 0, v1 = SHM_V, v2 = 2 * SHM_V;
  const lds_cptr kq0 = (lds_cptr)K_lds, vq0 = (lds_cptr)V_lds + v_rd_base(lane);
  bf16x8 kf[8]; s16x4 va[8], vc[8];
#define ATT_KFRAG(i, so) do { if constexpr (!(ABL & 8)) { const int d0_ = (i) >> 1, cb_ = (d0_ * 16 + hi * 8) * 2; kf[(i) & 7] = *(const __attribute__((address_space(3))) bf16x8*)(kq0 + (so) + kswz<DQK>(((i) & 1) * 32 + r32, cb_)); } } while (0)
#define ATT_VPAIR(buf, so, blk, ks) do { if constexpr (!(ABL & 8)) { buf[2 * (ks)] = vtr(vq0 + (so) + v_rd_off(blk, ks, 0)); buf[2 * (ks) + 1] = vtr(vq0 + (so) + v_rd_off(blk, ks, 1)); } } while (0)
#define ATT_PA(ks) ((ks) == 0 ? pa0 : (ks) == 1 ? pa1 : (ks) == 2 ? pa2 : pa3)
#define ATT_XSECTION(WITH_QK) do { __builtin_amdgcn_s_setprio(2); \
    _Pragma("unroll") for (int g = 0; g < 20; ++g) { const int blk = g >> 2, ks = g & 3; \
      if (blk == 4) { ATT_MF(ATT_PA(ks), ones, lacc); } \
      else if (blk == 0 || blk == 2) { ATT_MF(ATT_PA(ks), ATT_VF(va, ks), o[blk]); } \
      else { ATT_MF(ATT_PA(ks), ATT_VF(vc, ks), o[blk]); } \
      if (blk < 3) { if (blk == 0 || blk == 2) ATT_VPAIR(vc, v0, blk + 1, ks); else ATT_VPAIR(va, v0, blk + 1, ks); } \
      if (WITH_QK) { if (g >= 12 && g - 12 < NKF) ATT_KFRAG(g - 12, k1); } \
      ATT_SBAR(); } \
    if (WITH_QK) { _Pragma("unroll") for (int i = 0; i < NKF; ++i) { \
      if (i < 2) { if (i == 0) { if constexpr (ABL & 2) { asm volatile("" :: "v"(kf[0])); p0 = negm; } else p0 = __builtin_amdgcn_mfma_f32_32x32x16_bf16(kf[0], qr[0], negm, 0, 0, 0); } \
                   else        { if constexpr (ABL & 2) { asm volatile("" :: "v"(kf[1])); p1 = negm; } else p1 = __builtin_amdgcn_mfma_f32_32x32x16_bf16(kf[1], qr[0], negm, 0, 0, 0); } } \
      else if (i & 1) { ATT_MF(kf[i & 7], qr[i >> 1], p1); } else { ATT_MF(kf[i & 7], qr[i >> 1], p0); } \
      if (i + 8 < NKF) ATT_KFRAG(i + 8, k1); \
      ATT_SBAR(); } } __builtin_amdgcn_s_setprio(0); } while (0)
  for (int t = 0; t + 1 < NT; ++t) {
    if constexpr (ABL & 1) { u32x4 w0 = {cvtpk(p0[0], p0[1]), cvtpk(p0[2], p0[3]), cvtpk(p0[4], p0[5]), cvtpk(p0[6], p0[7])}, w1 = {cvtpk(p0[8], p0[9]), cvtpk(p0[10], p0[11]), cvtpk(p0[12], p0[13]), cvtpk(p0[14], p0[15])};
        u32x4 w2 = {cvtpk(p1[0], p1[1]), cvtpk(p1[2], p1[3]), cvtpk(p1[4], p1[5]), cvtpk(p1[6], p1[7])}, w3 = {cvtpk(p1[8], p1[9]), cvtpk(p1[10], p1[11]), cvtpk(p1[12], p1[13]), cvtpk(p1[14], p1[15])};
        pa0 = *reinterpret_cast<bf16x8*>(&w0); pa1 = *reinterpret_cast<bf16x8*>(&w1); pa2 = *reinterpret_cast<bf16x8*>(&w2); pa3 = *reinterpret_cast<bf16x8*>(&w3); alpha = 1.f; }
    else { softmax_tile(p0, p1, negm, alpha, t == 0, pa0, pa1, pa2, pa3);
    ATT_RESC(alpha); }
    if constexpr (!(ABL & 4)) { ATT_WRITE_K(k2); ATT_WRITE_V(v1); }
    ATT_SBAR();
#pragma unroll
    for (int ks = 0; ks < 4; ++ks) ATT_VPAIR(va, v0, 0, ks);
    asm volatile("s_waitcnt lgkmcnt(0)" ::: "memory"); ATT_BAR();
    ATT_XSECTION(true);
    if constexpr (!(ABL & 4)) { const int tk = (t + 3 < NT) ? t + 3 : NT - 1, tv = (t + 2 < NT) ? t + 2 : NT - 1; ATT_LOAD_K(tk); ATT_LOAD_V(tv); }
    ATT_BAR();
    { const int tk_ = k0; k0 = k1; k1 = k2; k2 = tk_; const int tv_ = v0; v0 = v1; v1 = v2; v2 = tv_; }
  }
  softmax_tile(p0, p1, negm, alpha, false, pa0, pa1, pa2, pa3);
  ATT_RESC(alpha);
#pragma unroll
  for (int ks = 0; ks < 4; ++ks) ATT_VPAIR(va, v0, 0, ks);
  asm volatile("s_waitcnt lgkmcnt(0)" ::: "memory"); ATT_BAR();
  ATT_XSECTION(false);
  ATT_BAR();
  if (grp == 0) ATT_BAR();
#pragma unroll
  for (int r = 0; r < 16; ++r) rli[r] = __builtin_amdgcn_rcpf(lacc[r]);
#undef ATT_LOAD_K
#undef ATT_LOAD_V
#undef ATT_WRITE_K
#undef ATT_WRITE_V
#undef ATT_BAR
#undef ATT_RESC
#undef ATT_MF
#undef ATT_VF
#undef ATT_KFRAG
#undef ATT_VPAIR
#undef ATT_PA
#undef ATT_XSECTION
}
}

constexpr int NWAVES = 8;
constexpr int DM = 2048, BATCH = 4, SEQ = 8192, T = BATCH * SEQ;
constexpr int NCOL1 = 4608 + 4096;
constexpr int NEXP = 32, FF = 512, LCAP = 32768;
constexpr int PMAX = 288;
constexpr float EPS = 1e-6f;
constexpr float LAM_INIT = 0.2f;
#ifndef MK_ONE_LAUNCH
#define MK_ONE_LAUNCH 1
#endif
constexpr int N_PHASES = 10;
#ifndef ATT_DUMMY
#define ATT_DUMMY -1
#define ATT_DUMMY_B 0
#endif
#ifndef PROBE_MASK
#define PROBE_MASK 0
#define PROBE_MUL 1
#endif

constexpr size_t MiB = 1u << 20;
constexpr size_t WS_CTL = 0, CTL_ZERO_BYTES = 1 * MiB;
constexpr size_t WS_ROPE = 2 * MiB;
constexpr size_t WS_WRT = 4 * MiB;
constexpr size_t WS_TOKROW = 5 * MiB;
constexpr size_t WS_ROWW = 6 * MiB;
constexpr size_t WS_WIN = 8 * MiB;
constexpr size_t WS_WA = 42 * MiB, WS_WB = 46 * MiB, WS_WO = 50 * MiB;
constexpr size_t WS_W13 = 58 * MiB;
constexpr size_t WS_W2 = 186 * MiB;
constexpr size_t WS_SSQ = 250 * MiB;
constexpr size_t WS_LENT = 254 * MiB, WS_LW = 258 * MiB;
constexpr size_t WS_XN = 264 * MiB;
constexpr size_t WS_QA = 392 * MiB, WS_KA = 456 * MiB, WS_VA = 472 * MiB, WS_QB = 488 * MiB, WS_KB = 552 * MiB, WS_VB = 616 * MiB;
constexpr size_t WS_XG = 392 * MiB;
constexpr size_t WS_GT = 680 * MiB;
constexpr size_t WS_YC = WS_XG;
constexpr size_t WS_END = 936 * MiB;
constexpr int CW_CNT = 64;
constexpr int CW_BAR = 4096;

constexpr int SCR_OFF = 0, SCR_BYTES = 139264;
constexpr int AWS_OFF = 139264;
constexpr int MOE_OFF = AWS_OFF + 2048;
constexpr int MISC_OFF = MOE_OFF + 512;
constexpr int LDS_BYTES = 147456;
static_assert(MISC_OFF + 128 <= LDS_BYTES, "LDS map");

#define GAS __attribute__((address_space(1)))
#define LAS __attribute__((address_space(3)))
typedef unsigned short bf16;
typedef unsigned v4u __attribute__((ext_vector_type(4)));
typedef unsigned v2u __attribute__((ext_vector_type(2)));
typedef float f32x4 __attribute__((ext_vector_type(4)));
typedef short bf16x8 __attribute__((ext_vector_type(8)));
typedef GAS unsigned gu32;
#define RLX_AGENT __ATOMIC_RELAXED, __HIP_MEMORY_SCOPE_AGENT
#define LDS_WAIT() asm volatile("s_waitcnt lgkmcnt(0)" ::: "memory")
#define VM_WAIT() asm volatile("s_waitcnt vmcnt(0)" ::: "memory")
__device__ __forceinline__ unsigned f2bf(float f) { unsigned u = __builtin_bit_cast(unsigned, f); return (u + 0x7fffu + ((u >> 16) & 1u)) >> 16; }
__device__ __forceinline__ unsigned pk2(float lo, float hi) { return f2bf(lo) | (f2bf(hi) << 16); }
__device__ __forceinline__ float bflo(unsigned w) { return __uint_as_float(w << 16); }
__device__ __forceinline__ float bfhi(unsigned w) { return __uint_as_float(w & 0xffff0000u); }
__device__ __forceinline__ float wave_sum(float v) {
#pragma unroll
    for (int o = 1; o < 64; o <<= 1) v += __shfl_xor(v, o);
    return v;
}

#define XB_TMO      128
#define XB_XCNT(j)  (256  + 64 * (j))
#define XB_XSUB(j)  (1280 + 64 * (j))
#define XB_XGEN(j)  (2304 + 64 * (j))
#define XB_TOP      3328
#define XB_TOPGEN   3392
#define XCD_BAR_WORDS 3456
#define XB_SPIN_CAP (1u << 18)

__device__ __forceinline__ unsigned xb_ld(unsigned* p)              { return __hip_atomic_load(p, __ATOMIC_RELAXED, __HIP_MEMORY_SCOPE_AGENT); }
__device__ __forceinline__ unsigned xb_add(unsigned* p, unsigned v) { return __hip_atomic_fetch_add(p, v, __ATOMIC_RELAXED, __HIP_MEMORY_SCOPE_AGENT); }
__device__ __forceinline__ unsigned xb_xcc_id() { return (unsigned)__builtin_amdgcn_s_getreg((3 << 11) | 20) & 0xFu; }
#define XB_SPIN(cond, bar) do { unsigned _sp = 0; while (cond) { __builtin_amdgcn_s_sleep(1); \
    if ((++_sp & 255u) == 0u) { if (xb_ld(&(bar)[XB_TMO])) break; if (_sp > XB_SPIN_CAP) { atomicAdd(&(bar)[XB_TMO], 1u); break; } } } } while (0)

struct XcdBarrier {
    unsigned* bar; unsigned x;
    volatile LAS unsigned* st;
};

__device__ __forceinline__ XcdBarrier xcd_barrier_post(unsigned* bar, volatile LAS unsigned* st) {
    XcdBarrier b; b.bar = bar; b.x = xb_xcc_id(); b.st = st;
    if (threadIdx.x == 0) (void)xb_add(&bar[XB_XCNT(b.x)], 1u);
    return b;
}
__device__ __forceinline__ void xcd_barrier_complete(unsigned* bar, unsigned x, unsigned& nloc, unsigned& nx) {
    const unsigned G = gridDim.x * gridDim.y * gridDim.z;
    unsigned sum, cnt, mine, sp = 0u;
    for (;;) {
        sum = 0u; cnt = 0u; mine = 0u;
#pragma unroll
        for (unsigned j = 0; j < 16; ++j) { const unsigned c = xb_ld(&bar[XB_XCNT(j)]); sum += c; cnt += (c > 0u) ? 1u : 0u; mine = (j == x) ? c : mine; }
        if (sum == G) break;
        __builtin_amdgcn_s_sleep(1);
        if ((++sp & 255u) == 0u) { if (xb_ld(&bar[XB_TMO])) break; if (sp > XB_SPIN_CAP) { atomicAdd(&bar[XB_TMO], 1u); break; } }
    }
    nloc = mine > 0u ? mine : 1u; nx = cnt > 0u ? cnt : 1u;
}

__device__ __forceinline__ void xcd_barrier(const XcdBarrier& b) {
    asm volatile("s_waitcnt vmcnt(0)" ::: "memory");
    __syncthreads();
    if (threadIdx.x == 0) {
        unsigned* bar = b.bar;
        __builtin_amdgcn_s_waitcnt(0);
        unsigned nloc = b.st[0], nx = b.st[1];
        if (nloc == 0u) { xcd_barrier_complete(bar, b.x, nloc, nx); b.st[0] = nloc; b.st[1] = nx; }
        const unsigned old = xb_add(&bar[XB_XSUB(b.x)], 1u);
        const unsigned gen = old / nloc;
        if (old + 1u == (gen + 1u) * nloc) {
            __builtin_amdgcn_fence(__ATOMIC_RELEASE, "agent");
            asm volatile("s_waitcnt vmcnt(0)" ::: "memory");
            const unsigned og = xb_add(&bar[XB_TOP], 1u);
            const unsigned tg = og / nx;
            if (og + 1u == (tg + 1u) * nx) xb_add(&bar[XB_TOPGEN], 1u);
            else XB_SPIN(xb_ld(&bar[XB_TOPGEN]) == tg, bar);
            __builtin_amdgcn_fence(__ATOMIC_ACQUIRE, "agent");
            xb_add(&bar[XB_XGEN(b.x)], 1u);
            asm volatile("s_waitcnt vmcnt(0)" ::: "memory");
        } else {
            XB_SPIN(xb_ld(&bar[XB_XGEN(b.x)]) == gen, bar);
            __builtin_amdgcn_fence(__ATOMIC_ACQUIRE, "agent");
            asm volatile("s_waitcnt vmcnt(0)" ::: "memory");
        }
    }
    __syncthreads();
}

struct Args { const float* in[22]; float* out; unsigned char* ws; int ph_lo, ph_hi, li, pad; };
struct Frame { unsigned char* lds; int tid, lane, wave, vcu, G, gw, NGW; };
typedef const Args __attribute__((address_space(4)))* KArgs;
#define FRESH_ARGS() ({ KArgs p_ = (KArgs)__builtin_amdgcn_kernarg_segment_ptr(); asm volatile("" : "+s"(p_)); p_; })

__device__ __forceinline__ void p0_transpose_item(const float* W, int N, int k0, int n0, bf16* WT, int K, int dst_row0, LAS float* scr, int lane) {
    typedef float f32x4t __attribute__((ext_vector_type(4)));
#pragma unroll
    for (int i = 0; i < 8; ++i) { const int kk = 8 * i + (lane >> 3), nn = (lane & 7) * 4;
        *(LAS f32x4t*)(scr + kk * 36 + nn) = *(const GAS f32x4t*)(W + (size_t)(k0 + kk) * N + n0 + nn); }
    LDS_WAIT(); asm volatile("" ::: "memory");
    const int c = lane & 7;
#pragma unroll
    for (int j = 0; j < 4; ++j) { const int n = (lane >> 3) + 8 * j; const LAS float* s = scr + (8 * c) * 36 + n;
        v4u o; o.x = pk2(s[0 * 36], s[1 * 36]); o.y = pk2(s[2 * 36], s[3 * 36]); o.z = pk2(s[4 * 36], s[5 * 36]); o.w = pk2(s[6 * 36], s[7 * 36]);
        *(GAS v4u*)(WT + (size_t)(dst_row0 + n) * K + k0 + 8 * c) = o; }
    LDS_WAIT(); asm volatile("" ::: "memory");
}
__device__ __forceinline__ void p0_prologue(const Frame& F, KArgs a) {
    unsigned char* ws = a->ws;
    LAS float* scr = (LAS float*)((LAS unsigned char*)F.lds + SCR_OFF + F.wave * 16384);
    constexpr int I_IN = 32 * 144, I_GT = 32 * 128, I_BA = 16 * 64, I_WO = 32 * 64, I_E = 32 * 512;
    constexpr int NITEMS = I_IN + I_GT + 2 * I_BA + I_WO + 3 * I_E;
    for (int it = F.gw; it < NITEMS; it += F.NGW) {
        int r = it;
        if (r < I_IN) { const int kb = r / 144, nb = r % 144; p0_transpose_item(a->in[2], 4608, 64 * kb, 32 * nb, (bf16*)(ws + WS_WIN), 2048, 32 * nb, scr, F.lane); continue; } r -= I_IN;
        if (r < I_GT) { const int kb = r / 128, nb = r % 128; p0_transpose_item(a->in[12], 4096, 64 * kb, 32 * nb, (bf16*)(ws + WS_WIN), 2048, 4608 + 32 * nb, scr, F.lane); continue; } r -= I_GT;
        if (r < I_BA) { const int kb = r / 64, nb = r % 64; p0_transpose_item(a->in[10], 2048, 64 * kb, 32 * nb, (bf16*)(ws + WS_WA), 2048, 32 * nb, scr, F.lane); continue; } r -= I_BA;
        if (r < I_BA) { const int kb = r / 64, nb = r % 64; p0_transpose_item(a->in[11], 2048, 64 * kb, 32 * nb, (bf16*)(ws + WS_WA) + 1024, 2048, 32 * nb, scr, F.lane); continue; } r -= I_BA;
        if (r < I_WO) { const int kb = r / 64, nb = r % 64; p0_transpose_item(a->in[14], 2048, 64 * kb, 32 * nb, (bf16*)(ws + WS_WO), 2048, 32 * nb, scr, F.lane); continue; } r -= I_WO;
        if (r < I_E)  { const int e = r / 512, q = r % 512, kb = q / 16, nb = q % 16, n0 = 32 * nb;
                        p0_transpose_item(a->in[18] + (size_t)e * 2048 * 512, 512, 64 * kb, n0, (bf16*)(ws + WS_W13), 2048, e * 1024 + (n0 >> 7) * 256 + (n0 & 127), scr, F.lane); continue; } r -= I_E;
        if (r < I_E)  { const int e = r / 512, q = r % 512, kb = q / 16, nb = q % 16, n0 = 32 * nb;
                        p0_transpose_item(a->in[19] + (size_t)e * 2048 * 512, 512, 64 * kb, n0, (bf16*)(ws + WS_W13), 2048, e * 1024 + (n0 >> 7) * 256 + 128 + (n0 & 127), scr, F.lane); continue; } r -= I_E;
        { const int e = r / 512, q = r % 512, kb = q / 64, nb = q % 64;
          p0_transpose_item(a->in[20] + (size_t)e * 512 * 2048, 2048, 64 * kb, 32 * nb, (bf16*)(ws + WS_W2), 512, e * 2048 + 32 * nb, scr, F.lane); }
    }
    { float2* tab = (float2*)(ws + WS_ROPE);
      for (int idx = F.gw * 64 + F.lane; idx < SEQ * 32; idx += F.NGW * 64) { const int pos = idx >> 5, i = idx & 31;
          const float inv = powf(10000.0f, -(float)(2 * i) / 64.0f); const float ang = (float)pos * inv;
          double s, c; sincos((double)ang, &s, &c); tab[idx] = make_float2((float)c, (float)s); } }
    { bf16* wh = (bf16*)(ws + WS_WRT); bf16* wl = wh + 48 * 2048;
      for (int idx = F.gw * 64 + F.lane; idx < 48 * 2048; idx += F.NGW * 64) { const int c = idx >> 11, k = idx & 2047;
          const float v = c < 4 ? a->in[16][k * 4 + c] : (c < 36 ? a->in[17][k * 32 + (c - 4)] : 0.f);
          const unsigned h = f2bf(v); const float hf = __uint_as_float(h << 16); wh[idx] = (bf16)h; wl[idx] = (bf16)f2bf(v - hf); } }
    { const float* x = a->in[0]; const GAS f32x4* g4 = (const GAS f32x4*)a->in[1] + F.lane; bf16* XN = (bf16*)(ws + WS_XN);
      for (int m = F.gw; m < T; m += F.NGW) {
          const GAS f32x4* xr = (const GAS f32x4*)(x + (size_t)m * DM) + F.lane; f32x4 v[8]; float s = 0.f;
#pragma unroll
          for (int j = 0; j < 8; ++j) { v[j] = xr[64 * j]; s += (v[j].x * v[j].x + v[j].y * v[j].y) + (v[j].z * v[j].z + v[j].w * v[j].w); }
          const float rstd = 1.0f / sqrtf(wave_sum(s) * (1.0f / DM) + EPS);
          GAS v2u* o8 = (GAS v2u*)(XN + (size_t)m * DM) + F.lane;
#pragma unroll
          for (int j = 0; j < 8; ++j) { const f32x4 g = g4[64 * j]; v2u w; w.x = pk2(v[j].x * rstd * g.x, v[j].y * rstd * g.y); w.y = pk2(v[j].z * rstd * g.z, v[j].w * rstd * g.w); o8[64 * j] = w; } } }
}

__device__ __forceinline__ void rope8(float (&v)[8], const float2* tab, int pos, int cc) {
    const GAS f32x4* tp = (const GAS f32x4*)(tab + (size_t)pos * 32 + 8 * (cc & 3));
    const f32x4 t0 = tp[0], t1 = tp[1], t2 = tp[2], t3 = tp[3];
    const float cs[8] = {t0.x, t0.z, t1.x, t1.z, t2.x, t2.z, t3.x, t3.z}, sn[8] = {t0.y, t0.w, t1.y, t1.w, t2.y, t2.w, t3.y, t3.w};
    const float sg = (cc & 4) ? 1.f : -1.f;
#pragma unroll
    for (int e = 0; e < 8; ++e) { const float p = __shfl_xor(v[e], 4); v[e] = v[e] * cs[e] + sg * p * sn[e]; }
}
__device__ __forceinline__ void unpack8(const v4u w, float (&v)[8]) { v[0] = bflo(w.x); v[1] = bfhi(w.x); v[2] = bflo(w.y); v[3] = bfhi(w.y); v[4] = bflo(w.z); v[5] = bfhi(w.z); v[6] = bflo(w.w); v[7] = bfhi(w.w); }
__device__ __forceinline__ v4u pack8(const float (&v)[8]) { v4u w; w.x = pk2(v[0], v[1]); w.y = pk2(v[2], v[3]); w.z = pk2(v[4], v[5]); w.w = pk2(v[6], v[7]); return w; }
__device__ __forceinline__ void p1b_normrope(const Frame& F, KArgs a) {
    unsigned char* ws = a->ws; const float2* tab = (const float2*)(ws + WS_ROPE);
    bf16* KA = (bf16*)(ws + WS_KA); bf16* KB = (bf16*)(ws + WS_KB);
    const float* kg = a->in[4];
    const int cc16 = F.lane & 15;
    float gk[8];
#pragma unroll
    for (int e = 0; e < 8; ++e) gk[e] = kg[cc16 * 8 + e];
    for (int tA = F.gw; tA < T; tA += 2 * F.NGW) {
        const int tB = (tA + F.NGW < T) ? tA + F.NGW : tA;
        v4u raw[2][3];
#pragma unroll
        for (int u = 0; u < 2; ++u) { const int t = u ? tB : tA;
            raw[u][0] = *(const GAS v4u*)(KA + (size_t)t * 256 + (F.lane & 31) * 8);
            raw[u][1] = *(const GAS v4u*)(KB + (size_t)t * 1024 + F.lane * 8); raw[u][2] = *(const GAS v4u*)(KB + (size_t)t * 1024 + (F.lane + 64) * 8); }
#pragma unroll
        for (int u = 0; u < 2; ++u) { const int t = u ? tB : tA;
            if (u == 1 && tB == tA) break;
            const int s = t & (SEQ - 1), prow = s >> 6, pcol = s & 63;
            const int posA = (cc16 < 8) ? prow : pcol;
            {
                bf16* p = KA + (size_t)t * 256 + (F.lane & 31) * 8;
                float v[8]; unpack8(raw[u][0], v);
                float ss = 0.f;
#pragma unroll
                for (int e = 0; e < 8; ++e) ss += v[e] * v[e];
                ss += __shfl_xor(ss, 1); ss += __shfl_xor(ss, 2); ss += __shfl_xor(ss, 4); ss += __shfl_xor(ss, 8);
                const float rstd = 1.0f / sqrtf(ss * (1.0f / 128.0f) + EPS);
#pragma unroll
                for (int e = 0; e < 8; ++e) v[e] = v[e] * rstd * gk[e];
                rope8(v, tab, posA, cc16 & 7);
                if (F.lane < 32) *(GAS v4u*)p = pack8(v);
            }
#pragma unroll
            for (int j = 0; j < 2; ++j) {
                bf16* p = KB + (size_t)t * 1024 + (F.lane + 64 * j) * 8;
                float v[8]; unpack8(raw[u][1 + j], v);
                rope8(v, tab, s, F.lane & 7);
                *(GAS v4u*)p = pack8(v);
            }
        }
    }
}

template <int ABL = 0> __device__ __forceinline__ void attn_unit_A(const Frame& F, KArgs a, int b, int h, int qb, att::bf16* Obase) {
    using namespace att;
    int tid_ = threadIdx.x; asm volatile("" : "+v"(tid_));
    const int lane_ = tid_ & 63, wave_ = __builtin_amdgcn_readfirstlane(tid_ >> 6);
    unsigned char* ws = a->ws; char* lds = (char*)F.lds + SCR_OFF; float* wsf = (float*)((char*)F.lds + AWS_OFF) + wave_ * 64;
    const int r32 = lane_ & 31, hi = lane_ >> 5, kvh = h >> 2;
    const att::bf16* Qb = (const att::bf16*)(ws + WS_QA) + ((size_t)b * SEQ + (size_t)qb * 256) * 1024 + h * 128;
    const att::bf16* Kh = (const att::bf16*)(ws + WS_KA) + (size_t)b * SEQ * 256 + kvh * 128;
    const att::bf16* Vh = (const att::bf16*)(ws + WS_VA) + (size_t)b * SEQ * 256 + kvh * 128;
    f32x16 o[4]; float rli[16];
    attn_pass<128, 1024, 256, 256, ABL>(Qb, Kh, Vh, SEQ, lds, wsf, o, rli, (const float*)(ws + WS_ROPE), a->in[3], qb * 256);
    att::bf16* Ow = Obase + ((size_t)b * SEQ + (size_t)qb * 256 + wave_ * 32) * 2048 + h * 128;
#pragma unroll
    for (int r = 0; r < 16; ++r) { const int orow = crow(r, hi);
#pragma unroll
        for (int d0 = 0; d0 < 4; ++d0) Ow[(size_t)orow * 2048 + d0 * 32 + r32] = (att::bf16)f2bf(o[d0][r] * rli[r]); }
}
template <int ABL = 0> __device__ __forceinline__ void attn_unit_B(const Frame& F, KArgs a, int b, int h, int qb, float lam, att::bf16* Obase) {
    using namespace att;
    int tid_ = threadIdx.x; asm volatile("" : "+v"(tid_));
    const int lane_ = tid_ & 63, wave_ = __builtin_amdgcn_readfirstlane(tid_ >> 6);
    unsigned char* ws = a->ws; char* lds = (char*)F.lds + SCR_OFF; float* wsf = (float*)((char*)F.lds + AWS_OFF) + wave_ * 64;
    unsigned* stash = (unsigned*)(lds + OFF_STASH) + wave_ * 2048;
    const int r32 = lane_ & 31, hi = lane_ >> 5;
    const att::bf16* Qb = (const att::bf16*)(ws + WS_QB) + ((size_t)b * SEQ + (size_t)qb * 256) * 1024 + h * 128;
    const att::bf16* Kh = (const att::bf16*)(ws + WS_KB) + (size_t)b * SEQ * 1024 + h * 128;
    const att::bf16* Vh = (const att::bf16*)(ws + WS_VB) + (size_t)b * SEQ * 1024 + h * 128;
    f32x16 o[4]; float rli[16];
    attn_pass<64, 1024, 1024, 1024, ABL>(Qb, Kh, Vh, SEQ, lds, wsf, o, rli, (const float*)(ws + WS_ROPE), nullptr, qb * 256);
#pragma unroll
    for (int d0 = 0; d0 < 4; ++d0)
#pragma unroll
        for (int r = 0; r < 16; r += 2) stash[(d0 * 8 + (r >> 1)) * 64 + lane_] = att::cvtpk(o[d0][r] * rli[r], o[d0][r + 1] * rli[r + 1]);
    attn_pass<64, 1024, 1024, 1024, ABL>(Qb + 64, Kh + 64, Vh, SEQ, lds, wsf, o, rli, (const float*)(ws + WS_ROPE), nullptr, qb * 256);
    asm volatile("s_waitcnt lgkmcnt(0)" ::: "memory");
    float ss[16];
#pragma unroll
    for (int r = 0; r < 16; ++r) ss[r] = 0.f;
#pragma unroll
    for (int d0 = 0; d0 < 4; ++d0)
#pragma unroll
        for (int r = 0; r < 16; r += 2) { const unsigned w = stash[(d0 * 8 + (r >> 1)) * 64 + lane_];
            const float x0 = bflo(w) - lam * (o[d0][r] * rli[r]), x1 = bfhi(w) - lam * (o[d0][r + 1] * rli[r + 1]);
            o[d0][r] = x0; o[d0][r + 1] = x1; ss[r] += x0 * x0; ss[r + 1] += x1 * x1; }
#pragma unroll
    for (int r = 0; r < 16; ++r) { float s = ss[r]; s += __shfl_xor(s, 1); s += __shfl_xor(s, 2); s += __shfl_xor(s, 4); s += __shfl_xor(s, 8); s += __shfl_xor(s, 16);
        ss[r] = (1.0f - LAM_INIT) / sqrtf(s * (1.0f / 128.0f) + EPS); }
    const float* sg = a->in[9]; float g4[4];
#pragma unroll
    for (int d0 = 0; d0 < 4; ++d0) g4[d0] = sg[d0 * 32 + r32];
    att::bf16* Ow = Obase + ((size_t)b * SEQ + (size_t)qb * 256 + wave_ * 32) * 2048 + 1024 + h * 128;
#pragma unroll
    for (int r = 0; r < 16; ++r) { const int orow = crow(r, hi);
#pragma unroll
        for (int d0 = 0; d0 < 4; ++d0) Ow[(size_t)orow * 2048 + d0 * 32 + r32] = (att::bf16)f2bf(o[d0][r] * ss[r] * g4[d0]); }
}
__device__ __forceinline__ void p2_attention(const Frame& F, KArgs a) {
    const float lam = __uint_as_float(__builtin_amdgcn_readfirstlane(__float_as_uint(expf(wave_sum(a->in[5][F.lane] * a->in[6][F.lane])) - expf(wave_sum(a->in[7][F.lane] * a->in[8][F.lane])) + LAM_INIT)));
#if ATT_DUMMY >= 0
#if ATT_DUMMY_B
    for (int L = F.vcu; L < 1024; L += F.G) { const int i = L >> 8, v = L & 255, x = v >> 5, qb = v & 31, b = x >> 1; attn_unit_B<ATT_DUMMY>(F, a, b, 4 * (x & 1) + i, qb, lam, (att::bf16*)a->out); }
#else
    for (int L = F.vcu; L < 1024; L += F.G) { const int i = L >> 8, v = L & 255, x = v >> 5, qb = v & 31, b = x >> 1; attn_unit_A<ATT_DUMMY>(F, a, b, 4 * (x & 1) + i, qb, (att::bf16*)a->out); }
#endif
#endif
    for (int L = F.vcu; L < 2048; L += F.G) {
#if PROBE_MASK
        if (L >> 8 == 4 && blockIdx.x == 0 && F.tid == 0) { volatile LAS unsigned* M_ = (volatile LAS unsigned*)((LAS unsigned char*)F.lds + MISC_OFF); M_[21] = (unsigned)__builtin_amdgcn_s_memrealtime() - M_[20]; }
#endif
        const int i = L >> 8, v = L & 255, x = v >> 5, qb = v & 31, b = x >> 1;
#ifndef ATT_SKIP_A
        if (i < 4) attn_unit_A(F, a, b, 4 * (x & 1) + i, qb, (att::bf16*)(a->ws + WS_XN));
#endif
#ifndef ATT_SKIP_B
        if (i >= 4) attn_unit_B(F, a, b, 4 * (x & 1) + (i - 4), qb, lam, (att::bf16*)(a->ws + WS_XN));
#endif
    }
}

__device__ __forceinline__ void moe_table(const Frame& F, KArgs a) {
    LAS int* tab = (LAS int*)((LAS unsigned char*)F.lds + MOE_OFF);
    if (F.tid == 0) { const gu32* cnt = (const gu32*)(a->ws + WS_CTL) + CW_CNT; int acc = 0;
        for (int e = 0; e < NEXP; ++e) { const int c = (int)__hip_atomic_load(cnt + e, RLX_AGENT); tab[e] = c; tab[32 + e] = acc; acc += (c + 255) >> 8; }
        tab[64] = acc; }
    __syncthreads();
}

__device__ __forceinline__ void p4_router(const Frame& F, KArgs a) {
    typedef float f32x4v __attribute__((ext_vector_type(4)));
    unsigned char* ws = a->ws; const float* X1 = a->out; const float* SSQ = (const float*)(ws + WS_SSQ); const float* gf = a->in[15];
    bf16* H2 = (bf16*)(ws + WS_GT); const bf16* wh = (const bf16*)(ws + WS_WRT);
    gu32* cnt = (gu32*)(ws + WS_CTL) + CW_CNT; int* LENT = (int*)(ws + WS_LENT); float* LW = (float*)(ws + WS_LW); int* TOKES = (int*)(ws + WS_TOKROW);
    LAS float* LG = (LAS float*)((LAS unsigned char*)F.lds + SCR_OFF) + F.wave * (16 * 48);
    LAS int* lcnt = (LAS int*)((LAS unsigned char*)F.lds + SCR_OFF + 32768);
    const int row = F.lane & 15, kq = F.lane >> 4;
    const int NTASK = T / 16, rounds = (NTASK + F.NGW - 1) / F.NGW;
    for (int it = 0; it < rounds; ++it) {
        const int task = it * F.NGW + F.gw; const bool valid = task < NTASK; const int t0 = valid ? task * 16 : 0;
        if (F.tid < 64) lcnt[F.tid] = 0;
        __syncthreads();
        int e0 = 0, e1 = 0, r0 = 0, r1 = 0; float w0 = 0.f, w1 = 0.f;
        {
            const GAS f32x4v* sp = (const GAS f32x4v*)(SSQ + (size_t)(t0 + row) * 32); float s = 0.f;
#pragma unroll
            for (int j = 0; j < 8; ++j) { const f32x4v q = sp[j]; s += (q.x + q.y) + (q.z + q.w); }
            const float rstd = 1.0f / sqrtf(s * (1.0f / DM) + EPS);
            f32x4v acc[3] = {{0.f, 0.f, 0.f, 0.f}, {0.f, 0.f, 0.f, 0.f}, {0.f, 0.f, 0.f, 0.f}};
            const float* xrow = X1 + (size_t)(t0 + row) * DM + 8 * kq; bf16* hrow = H2 + (size_t)(t0 + row) * DM + 8 * kq;
            f32x4v xw[8][2];
#pragma unroll
            for (int i = 0; i < 8; ++i) { xw[i][0] = *(const GAS f32x4v*)(xrow + 32 * i); xw[i][1] = *(const GAS f32x4v*)(xrow + 32 * i + 4); }
            LAS unsigned char* RB = (LAS unsigned char*)F.lds + SCR_OFF + 36864;
            for (int c = 0; c < 4; ++c) {
                __syncthreads();
#pragma unroll
                for (int i = 0; i < 12; ++i) { const int idx = F.tid + 512 * i, arr = idx / 3072, rr = (idx % 3072) >> 6, seg = idx & 63;
                    *(LAS v4u*)(RB + arr * 49920 + rr * 1040 + seg * 16) = *(const GAS v4u*)(wh + (size_t)arr * 48 * 2048 + (size_t)rr * 2048 + c * 512 + seg * 8); }
                __syncthreads();
                const LAS unsigned char* rbh = RB + row * 1040 + kq * 16;
#pragma unroll 8
                for (int ksl = 0; ksl < 16; ++ksl) { const int ks = c * 16 + ksl;
                const f32x4v x0 = xw[ksl & 7][0], x1 = xw[ksl & 7][1];
                { const int kn = (ks + 8 < 64) ? ks + 8 : ks; xw[ksl & 7][0] = *(const GAS f32x4v*)(xrow + 32 * kn); xw[ksl & 7][1] = *(const GAS f32x4v*)(xrow + 32 * kn + 4); }
                const f32x4v g0 = *(const GAS f32x4v*)(gf + 32 * ks + 8 * kq), g1 = *(const GAS f32x4v*)(gf + 32 * ks + 8 * kq + 4);
                float h[8] = {x0.x * rstd * g0.x, x0.y * rstd * g0.y, x0.z * rstd * g0.z, x0.w * rstd * g0.w, x1.x * rstd * g1.x, x1.y * rstd * g1.y, x1.z * rstd * g1.z, x1.w * rstd * g1.w};
                unsigned hh[8], hl[8];
#pragma unroll
                for (int e = 0; e < 8; ++e) { hh[e] = f2bf(h[e]); hl[e] = f2bf(h[e] - __uint_as_float(hh[e] << 16)); }
                v4u ah, al; ah.x = hh[0] | (hh[1] << 16); ah.y = hh[2] | (hh[3] << 16); ah.z = hh[4] | (hh[5] << 16); ah.w = hh[6] | (hh[7] << 16);
                al.x = hl[0] | (hl[1] << 16); al.y = hl[2] | (hl[3] << 16); al.z = hl[4] | (hl[5] << 16); al.w = hl[6] | (hl[7] << 16);
                if (valid) *(GAS v4u*)(hrow + 32 * ks) = ah;
                const bf16x8 Ah = __builtin_bit_cast(bf16x8, ah), Al = __builtin_bit_cast(bf16x8, al);
#pragma unroll
                for (int blk = 0; blk < 3; ++blk) {
                    const bf16x8 Bh = *(const LAS bf16x8*)(rbh + blk * 16 * 1040 + ksl * 64), Bl = *(const LAS bf16x8*)(rbh + 49920 + blk * 16 * 1040 + ksl * 64);
                    acc[blk] = __builtin_amdgcn_mfma_f32_16x16x32_bf16(Ah, Bh, acc[blk], 0, 0, 0);
                    acc[blk] = __builtin_amdgcn_mfma_f32_16x16x32_bf16(Al, Bh, acc[blk], 0, 0, 0);
                    acc[blk] = __builtin_amdgcn_mfma_f32_16x16x32_bf16(Ah, Bl, acc[blk], 0, 0, 0);
                }
                }
            }
#pragma unroll
            for (int blk = 0; blk < 3; ++blk)
#pragma unroll
                for (int i = 0; i < 4; ++i) LG[(4 * kq + i) * 48 + 16 * blk + row] = acc[blk][i];
            LDS_WAIT();
            if (F.lane < 16) {
                const LAS float* lg = LG + F.lane * 48;
                float gl[4];
#pragma unroll
                for (int i = 0; i < 4; ++i) gl[i] = lg[i];
                int gi = 0; float gm = gl[0];
#pragma unroll
                for (int i = 1; i < 4; ++i) if (gl[i] > gm) { gm = gl[i]; gi = i; }
                float gs = 0.f;
#pragma unroll
                for (int i = 0; i < 4; ++i) gs += expf(gl[i] - gm);
                const float gw_ = 1.0f / gs;
                const LAS float* el = lg + 4 + gi * 8;
                float ev[8];
#pragma unroll
                for (int i = 0; i < 8; ++i) ev[i] = el[i];
                int i0 = 0; float v0 = ev[0];
#pragma unroll
                for (int i = 1; i < 8; ++i) if (ev[i] > v0) { v0 = ev[i]; i0 = i; }
                int i1 = -1; float v1 = -3.0e38f;
#pragma unroll
                for (int i = 0; i < 8; ++i) if (i != i0 && ev[i] > v1) { v1 = ev[i]; i1 = i; }
                const float ex = expf(v1 - v0), den = 1.0f / (1.0f + ex);
                w0 = den * gw_; w1 = ex * den * gw_; e0 = gi * 8 + i0; e1 = gi * 8 + i1;
                if (valid) { r0 = atomicAdd((int*)&lcnt[e0], 1); r1 = atomicAdd((int*)&lcnt[e1], 1); }
            }
        }
        __syncthreads();
        if (F.tid < 32) { const int c = lcnt[F.tid]; lcnt[32 + F.tid] = c ? (int)__hip_atomic_fetch_add(cnt + F.tid, (unsigned)c, RLX_AGENT) : 0; }
        __syncthreads();
        if (valid && F.lane < 16) { const int tok = t0 + F.lane;
            const int s0 = lcnt[32 + e0] + r0, s1 = lcnt[32 + e1] + r1;
            LENT[(size_t)e0 * LCAP + s0] = tok * 2; LW[(size_t)e0 * LCAP + s0] = w0; TOKES[2 * tok] = (e0 << 16) | s0;
            LENT[(size_t)e1 * LCAP + s1] = tok * 2 + 1; LW[(size_t)e1 * LCAP + s1] = w1; TOKES[2 * tok + 1] = (e1 << 16) | s1; }
        __syncthreads();
    }
}

__device__ __forceinline__ void p6_final(const Frame& F, KArgs a) {
    unsigned char* ws = a->ws; const bf16* YC = (const bf16*)(ws + WS_YC); const int* TOKES = (const int*)(ws + WS_TOKROW); const LAS int* tab = (const LAS int*)((LAS unsigned char*)F.lds + MOE_OFF);
    const GAS f32x4* g4 = (const GAS f32x4*)a->in[21] + F.lane;
    for (int t0 = F.gw; t0 < T; t0 += 2 * F.NGW) {
        const int t1 = (t0 + F.NGW < T) ? t0 + F.NGW : t0;
        const int ea0 = TOKES[2 * t0], ea1 = TOKES[2 * t0 + 1], eb0 = TOKES[2 * t1], eb1 = TOKES[2 * t1 + 1];
        GAS f32x4* xa = (GAS f32x4*)(a->out + (size_t)t0 * DM) + F.lane; GAS f32x4* xb = (GAS f32x4*)(a->out + (size_t)t1 * DM) + F.lane;
        f32x4 va[8], vb[8];
#pragma unroll
        for (int j = 0; j < 8; ++j) { va[j] = xa[64 * j]; vb[j] = xb[64 * j]; }
        const GAS v2u* ya0 = (const GAS v2u*)(YC + (size_t)(tab[32 + (ea0 >> 16)] * 256 + (ea0 & 0xffff)) * DM) + F.lane; const GAS v2u* ya1 = (const GAS v2u*)(YC + (size_t)(tab[32 + (ea1 >> 16)] * 256 + (ea1 & 0xffff)) * DM) + F.lane;
        const GAS v2u* yb0 = (const GAS v2u*)(YC + (size_t)(tab[32 + (eb0 >> 16)] * 256 + (eb0 & 0xffff)) * DM) + F.lane; const GAS v2u* yb1 = (const GAS v2u*)(YC + (size_t)(tab[32 + (eb1 >> 16)] * 256 + (eb1 & 0xffff)) * DM) + F.lane;
        v2u pa[8], qa[8], pb[8], qb[8];
#pragma unroll
        for (int j = 0; j < 8; ++j) { pa[j] = ya0[64 * j]; qa[j] = ya1[64 * j]; pb[j] = yb0[64 * j]; qb[j] = yb1[64 * j]; }
        float sa = 0.f, sb = 0.f;
#pragma unroll
        for (int j = 0; j < 8; ++j) {
            va[j].x += bflo(pa[j].x) + bflo(qa[j].x); va[j].y += bfhi(pa[j].x) + bfhi(qa[j].x); va[j].z += bflo(pa[j].y) + bflo(qa[j].y); va[j].w += bfhi(pa[j].y) + bfhi(qa[j].y);
            vb[j].x += bflo(pb[j].x) + bflo(qb[j].x); vb[j].y += bfhi(pb[j].x) + bfhi(qb[j].x); vb[j].z += bflo(pb[j].y) + bflo(qb[j].y); vb[j].w += bfhi(pb[j].y) + bfhi(qb[j].y);
            sa += (va[j].x * va[j].x + va[j].y * va[j].y) + (va[j].z * va[j].z + va[j].w * va[j].w); sb += (vb[j].x * vb[j].x + vb[j].y * vb[j].y) + (vb[j].z * vb[j].z + vb[j].w * vb[j].w); }
        const float ra = 1.0f / sqrtf(wave_sum(sa) * (1.0f / DM) + EPS), rb = 1.0f / sqrtf(wave_sum(sb) * (1.0f / DM) + EPS);
#pragma unroll
        for (int j = 0; j < 8; ++j) { const f32x4 g = g4[64 * j]; xa[64 * j] = (f32x4){va[j].x * ra * g.x, va[j].y * ra * g.y, va[j].z * ra * g.z, va[j].w * ra * g.w};
            if (t1 != t0) xb[64 * j] = (f32x4){vb[j].x * rb * g.x, vb[j].y * rb * g.y, vb[j].z * rb * g.z, vb[j].w * rb * g.w}; }
    }
}

__global__ void __launch_bounds__(NWAVES * 64, 2) fwd_kernel(Args args) {
    extern __shared__ __attribute__((aligned(16))) unsigned char lds[];
    Frame F;
    F.lds = lds; F.tid = threadIdx.x; F.lane = F.tid & 63; F.wave = __builtin_amdgcn_readfirstlane(F.tid >> 6);
    F.G = gridDim.x; { const int bx = blockIdx.x; F.vcu = (F.G % 8 == 0) ? (bx % 8) * (F.G / 8) + bx / 8 : bx; }
    F.gw = F.vcu * NWAVES + F.wave; F.NGW = F.G * NWAVES;
    LAS unsigned char* L = (LAS unsigned char*)lds;
    volatile LAS unsigned* MISC = (volatile LAS unsigned*)(L + MISC_OFF);
    for (int u = F.tid; u < (LDS_BYTES - MISC_OFF) / 4; u += NWAVES * 64) ((LAS unsigned*)(L + MISC_OFF))[u] = 0u;
    __syncthreads();
    int lo, hi, li; unsigned* ctl;
    { KArgs a = FRESH_ARGS(); lo = a->ph_lo; hi = a->ph_hi; li = a->li; ctl = (unsigned*)(a->ws + WS_CTL); }
    XcdBarrier bar; bar.bar = ctl + CW_BAR + li * XCD_BAR_WORDS; bar.x = 0; bar.st = nullptr;
    if (hi - lo > 1) bar = xcd_barrier_post(ctl + CW_BAR + li * XCD_BAR_WORDS, MISC + 8);
#ifndef PH_MASK
#define PH_MASK 0x3ff
#endif
#define IN(k) (((PH_MASK >> (k)) & 1) && lo <= (k) && (k) < hi)
#if PROBE_MASK
    if (blockIdx.x == 0 && F.tid == 0) MISC[20] = (unsigned)__builtin_amdgcn_s_memrealtime();
#define STAMP(k) do { if (blockIdx.x == 0 && F.tid == 0) { const unsigned now_ = (unsigned)__builtin_amdgcn_s_memrealtime(); MISC[10 + (k)] = now_ - MISC[20]; MISC[20] = now_; } } while (0)
#else
#define STAMP(k) do { } while (0)
#endif
#define SEAM(k) do { if (IN(k) && IN((k) + 1)) { xcd_barrier(bar); STAMP(k); } } while (0)

    if (IN(0)) { KArgs a = FRESH_ARGS(); p0_prologue(F, a); } SEAM(0);

    if (IN(1)) {
        KArgs a = FRESH_ARGS(); unsigned char* ws = a->ws;
        pg8::Gemm g{(const pg8::bf16_t*)(ws + WS_XN), (const pg8::bf16_t*)(ws + WS_WIN), T, NCOL1, DM}; pg8::StaticOrder S; S.init(T, NCOL1, F.G, (int)blockIdx.x);
        pg8::EpiP1 E{(pg8::bf16_t*)(ws + WS_QA), (pg8::bf16_t*)(ws + WS_KA), (pg8::bf16_t*)(ws + WS_VA), (pg8::bf16_t*)(ws + WS_QB), (pg8::bf16_t*)(ws + WS_KB), (pg8::bf16_t*)(ws + WS_VB), (pg8::bf16_t*)(ws + WS_GT), a->in[13]};
        pg8::gemm_phase<pg8::EpiP1, pg8::StaticOrder, true, true>(L + SCR_OFF, g, S, E);
    } SEAM(1);

    if (IN(2)) { KArgs a = FRESH_ARGS(); p1b_normrope(F, a); } SEAM(2);

    if (IN(3)) { KArgs a = FRESH_ARGS(); p2_attention(F, a); } SEAM(3);

    if (IN(4)) {
        KArgs a = FRESH_ARGS(); unsigned char* ws = a->ws;
        pg8::Gemm g{(const pg8::bf16_t*)(ws + WS_XN), (const pg8::bf16_t*)(ws + WS_WA), T, DM, DM}; pg8::StaticOrder S; S.init(T, DM, F.G, (int)blockIdx.x);
        pg8::EpiMerge E{(const pg8::bf16_t*)(ws + WS_GT), (pg8::bf16_t*)(ws + WS_KB)};
        pg8::gemm_phase<pg8::EpiMerge, pg8::StaticOrder, true, true>(L + SCR_OFF, g, S, E);
    } SEAM(4);

    if (IN(5)) {
        KArgs a = FRESH_ARGS(); unsigned char* ws = a->ws;
        pg8::Gemm g{(const pg8::bf16_t*)(ws + WS_KB), (const pg8::bf16_t*)(ws + WS_WO), T, DM, DM}; pg8::StaticOrder S; S.init(T, DM, F.G, (int)blockIdx.x);
        pg8::EpiOut E{a->in[0], a->out, (float*)(ws + WS_SSQ)};
        pg8::gemm_phase<pg8::EpiOut, pg8::StaticOrder, true, true>(L + SCR_OFF, g, S, E);
    } SEAM(5);

    if (IN(6)) { KArgs a = FRESH_ARGS(); p4_router(F, a); } SEAM(6);

    if (IN(7)) {
        KArgs a = FRESH_ARGS(); unsigned char* ws = a->ws;
        moe_table(F, a);
        typedef pg8::MoeOrder<4, (long)1024 * 2048 * 2, true> Ord;
        pg8::Gemm g{(const pg8::bf16_t*)(ws + WS_GT), (const pg8::bf16_t*)(ws + WS_W13), T, 1024, DM};
        Ord S{(const LAS int*)(L + MOE_OFF), F.G, (int)blockIdx.x, (const int*)(ws + WS_LENT)};
        pg8::EpiG1 E{(pg8::bf16_t*)(ws + WS_XN)};
        pg8::gemm_phase<pg8::EpiG1, Ord, true, true>(L + SCR_OFF, g, S, E);
    } SEAM(7);

    if (IN(8)) {
        KArgs a = FRESH_ARGS(); unsigned char* ws = a->ws;
        moe_table(F, a);
        typedef pg8::MoeOrder<8, (long)2048 * 512 * 2, false> Ord;
        pg8::Gemm g{(const pg8::bf16_t*)(ws + WS_XN), (const pg8::bf16_t*)(ws + WS_W2), PMAX * 256, DM, FF};
        Ord S{(const LAS int*)(L + MOE_OFF), F.G, (int)blockIdx.x, (const int*)(ws + WS_LENT)};
        pg8::EpiG2 E{(pg8::bf16_t*)(ws + WS_YC), (const float*)(ws + WS_LW), (const LAS int*)(L + MOE_OFF)};
        pg8::gemm_phase<pg8::EpiG2, Ord, true, true>(L + SCR_OFF, g, S, E);
    } SEAM(8);

    if (IN(9)) { KArgs a = FRESH_ARGS(); moe_table(F, a); p6_final(F, a); }
#if PROBE_MASK
    if (blockIdx.x == 0 && F.tid == 0) { unsigned tot = 0;
        for (int k = 0; k < 12; ++k) if ((PROBE_MASK >> k) & 1) tot += MISC[10 + k];
        const unsigned long long t0 = __builtin_amdgcn_s_memrealtime(), span = (unsigned long long)tot * PROBE_MUL;
        while (__builtin_amdgcn_s_memrealtime() - t0 < span) __builtin_amdgcn_s_sleep(8); }
#endif
#undef IN
#undef SEAM
}

extern "C" void kernel_launch(void* const* d_in, const int* in_sizes, int n_in, void* d_out, int out_size, void* d_ws, size_t ws_size, hipStream_t stream) {
    static int grid = 0;
    if (grid == 0) {
        if (n_in != 22 || in_sizes[0] != T * DM || out_size != T * DM || ws_size < WS_END) { fprintf(stderr, "kernel_launch: shape mismatch (n_in %d, in0 %d, out %d, ws %zu)\n", n_in, n_in > 0 ? in_sizes[0] : -1, out_size, ws_size); grid = -1; return; }
        int dev = 0, cus = 0, per_cu = 0;
        if (hipGetDevice(&dev) != hipSuccess || hipDeviceGetAttribute(&cus, hipDeviceAttributeMultiprocessorCount, dev) != hipSuccess) { grid = -1; return; }
        if (hipFuncSetAttribute((const void*)fwd_kernel, hipFuncAttributeMaxDynamicSharedMemorySize, LDS_BYTES) != hipSuccess) { fprintf(stderr, "kernel_launch: hipFuncSetAttribute failed\n"); grid = -1; return; }
        if (hipOccupancyMaxActiveBlocksPerMultiprocessor(&per_cu, (const void*)fwd_kernel, NWAVES * 64, LDS_BYTES) != hipSuccess || per_cu < 1) fprintf(stderr, "kernel_launch: occupancy query says %d\n", per_cu);
        (void)hipGetLastError();
        grid = cus;
    }
    if (grid < 0) return;
    if (hipMemsetAsync((char*)d_ws + WS_CTL, 0, CTL_ZERO_BYTES, stream) != hipSuccess) return;
    Args a{};
    for (int i = 0; i < 22; ++i) a.in[i] = (const float*)d_in[i];
    a.out = (float*)d_out; a.ws = (unsigned char*)d_ws; a.pad = 0;
#if MK_ONE_LAUNCH
    a.ph_lo = 0; a.ph_hi = N_PHASES; a.li = 0;
    hipLaunchKernelGGL(fwd_kernel, dim3(grid), dim3(NWAVES * 64), LDS_BYTES, stream, a);
#else
    for (int li = 0; li < N_PHASES; ++li) { a.ph_lo = li; a.ph_hi = li + 1; a.li = li;
        hipLaunchKernelGGL(fwd_kernel, dim3(grid), dim3(NWAVES * 64), LDS_BYTES, stream, a); }
#endif
    const hipError_t le = hipPeekAtLastError();
    if (le != hipSuccess) fprintf(stderr, "kernel_launch: launch failed: %s\n", hipGetErrorName(le));
}
```

```cpp
#include <hip/hip_runtime.h>
#include <cstdio>
#include <cstdint>
#include <cmath>

namespace pg8 {
#define PG8_LAS __attribute__((address_space(3)))
typedef unsigned short bf16_t;
typedef short bf16x8 __attribute__((ext_vector_type(8)));
typedef float f32x4 __attribute__((ext_vector_type(4)));
typedef unsigned u32x4 __attribute__((ext_vector_type(4)));
constexpr int BM = 256, BK = 64, HALF = 128, HTB = HALF * BK * 2  , STAGE_BYTES = 8 * HTB, NXCD = 8, WGM = 8;

__host__ __device__ __forceinline__ int lds_byte(int r, int c) { const int st = (r >> 4) * 2 + (c >> 5), rr = r & 15, cc = c & 31, ob = rr * 64 + cc * 2; return st * 1024 + (ob ^ (((ob >> 9) & 1) << 5)); }
__host__ __device__ __forceinline__ void stage_rc(int b, int& R, int& C) { const int st = b / 1024, sb = b % 1024, swz = sb ^ (((sb >> 9) & 1) << 5); R = (st >> 1) * 16 + swz / 64; C = (st & 1) * 32 + (swz % 64) / 2; }
__host__ __device__ __forceinline__ int perm32(int rho) { const int n = rho >> 4, i = rho & 15; return 8 * (i >> 2) + 4 * n + (i & 3); }

struct Unit { int pm, pn; long bofs; int ex; };
struct Gemm { const bf16_t* A; const bf16_t* Bt; int M, N, K; };

struct StaticOrder {
    static constexpr bool GATHER = false;
    int nM, nN, nwg, G, c;
    __device__ __forceinline__ unsigned row_byteoff(const Unit&, int, int) const { return 0u; }
    __host__ __device__ void init(int M, int N, int G_, int c_) { nM = M / BM; nN = N / BM; nwg = nM * nN; G = G_; c = c_; }
    __host__ __device__ bool next(int i, Unit& u) const {
        const long L = (long)i * G + c; if (L >= nwg) return false;
        int wgid = (int)L; { const int q = nwg / NXCD, r = nwg % NXCD, xcd = wgid % NXCD, off = wgid / NXCD; wgid = (xcd < r ? xcd * (q + 1) : r * (q + 1) + (xcd - r) * q) + off; }
        const int nig = WGM * nN, gid = wgid / nig, fm = gid * WGM, gsz = (nM - fm) < WGM ? (nM - fm) : WGM;
        u.pm = fm + ((wgid % nig) % gsz); u.pn = (wgid % nig) / gsz; u.bofs = 0; u.ex = 0; return true;
    }
    __device__ __forceinline__ void a_ready(const Unit&) const {}
    __device__ __forceinline__ void done(const Unit&) const {}
};

typedef float f32x2v_ __attribute__((ext_vector_type(2))); typedef __bf16 bf16x2v_ __attribute__((ext_vector_type(2)));
__device__ __forceinline__ unsigned cvt_pk_bf16(float lo, float hi) { f32x2v_ v = {lo, hi}; bf16x2v_ b = __builtin_convertvector(v, bf16x2v_); return __builtin_bit_cast(unsigned, b); }
typedef float f32x2 __attribute__((ext_vector_type(2)));

__device__ __forceinline__ float bf_lo(unsigned w) { return __uint_as_float(w << 16); }
__device__ __forceinline__ float bf_hi(unsigned w) { return __uint_as_float(w & 0xffff0000u); }
__device__ __forceinline__ float sigmoid_f(float x) { return __builtin_amdgcn_rcpf(1.0f + __builtin_amdgcn_exp2f(-1.4426950408889634f * x)); }

struct EpiP1 {
    static constexpr bool PERM = true, AFTER_DRAIN = false, MIDK = false;
    bf16_t *QA, *KA, *VA, *QB, *KB, *VB, *GT; const float* bgate;
    __device__ __forceinline__ void operator()(const f32x4 (&acc)[2][2][4][2], const Unit& u, int wr, int wc, int fr, int fq) const {
        const int pn = u.pn; bf16_t* base; int ld, colt; bool gate = false;
        if (pn < 4)       { base = QA; ld = 1024; colt = pn * 256; }
        else if (pn == 4) { base = KA; ld = 256;  colt = 0; }
        else if (pn == 5) { base = VA; ld = 256;  colt = 0; }
        else if (pn < 10) { base = QB; ld = 1024; colt = (pn - 6) * 256; }
        else if (pn < 14) { base = KB; ld = 1024; colt = (pn - 10) * 256; }
        else if (pn < 18) { base = VB; ld = 1024; colt = (pn - 14) * 256; }
        else              { base = GT; ld = 4096; colt = (pn - 18) * 256; gate = true; }
        const int row0 = u.pm * BM + wr * 64 + fr, col0 = colt + wc * 32 + 8 * fq;
        f32x4 bv[2][2];
#pragma unroll
        for (int bj = 0; bj < 2; ++bj)
#pragma unroll
            for (int n = 0; n < 2; ++n) bv[bj][n] = gate ? *(const f32x4*)(bgate + col0 + bj * HALF + 4 * n) : (f32x4){0.f, 0.f, 0.f, 0.f};
#pragma unroll
        for (int ai = 0; ai < 2; ++ai)
#pragma unroll
            for (int m = 0; m < 4; ++m) { bf16_t* rowp = base + (size_t)(row0 + ai * HALF + m * 16) * ld + col0;
#pragma unroll
                for (int bj = 0; bj < 2; ++bj) { f32x4 v0 = acc[ai][bj][m][0] + bv[bj][0], v1 = acc[ai][bj][m][1] + bv[bj][1];
                    if (gate) {
#pragma unroll
                        for (int e = 0; e < 4; ++e) { v0[e] = sigmoid_f(v0[e]); v1[e] = sigmoid_f(v1[e]); } }
                    u32x4 w; w.x = cvt_pk_bf16(v0[0], v0[1]); w.y = cvt_pk_bf16(v0[2], v0[3]); w.z = cvt_pk_bf16(v1[0], v1[1]); w.w = cvt_pk_bf16(v1[2], v1[3]);
                    *(u32x4*)(rowp + bj * HALF) = w; } }
    }
};

struct EpiMerge {
    static constexpr bool PERM = true, AFTER_DRAIN = false, MIDK = true;
    const bf16_t* GT; bf16_t* MG;
    __device__ __forceinline__ void mid(f32x4 (&acc)[2][2][4][2], const Unit& u, int wr, int wc, int fr, int fq) const {
        asm volatile("" : "+v"(fr), "+v"(fq));
        const int row0 = u.pm * BM + wr * 64 + fr, col0 = u.pn * BM + wc * 32 + 8 * fq;
#pragma unroll
        for (int ai = 0; ai < 2; ++ai)
#pragma unroll
            for (int m = 0; m < 4; ++m) { const size_t r = (size_t)(row0 + ai * HALF + m * 16);
#pragma unroll
                for (int bj = 0; bj < 2; ++bj) { const u32x4 ga = *(const u32x4*)(GT + r * 4096 + col0 + bj * HALF), gb = *(const u32x4*)(GT + r * 4096 + 2048 + col0 + bj * HALF);
#define PG8_RT(A_, B_) ((A_) * __builtin_amdgcn_rcpf(fmaxf((B_), 1e-30f)))
                    acc[ai][bj][m][0][0] *= PG8_RT(bf_lo(ga.x), bf_lo(gb.x)); acc[ai][bj][m][0][1] *= PG8_RT(bf_hi(ga.x), bf_hi(gb.x)); acc[ai][bj][m][0][2] *= PG8_RT(bf_lo(ga.y), bf_lo(gb.y)); acc[ai][bj][m][0][3] *= PG8_RT(bf_hi(ga.y), bf_hi(gb.y));
                    acc[ai][bj][m][1][0] *= PG8_RT(bf_lo(ga.z), bf_lo(gb.z)); acc[ai][bj][m][1][1] *= PG8_RT(bf_hi(ga.z), bf_hi(gb.z)); acc[ai][bj][m][1][2] *= PG8_RT(bf_lo(ga.w), bf_lo(gb.w)); acc[ai][bj][m][1][3] *= PG8_RT(bf_hi(ga.w), bf_hi(gb.w));
#undef PG8_RT
                }
                if (m == 3) asm volatile("" ::: "memory"); }
    }
    __device__ __forceinline__ void operator()(const f32x4 (&acc)[2][2][4][2], const Unit& u, int wr, int wc, int fr, int fq) const {
        asm volatile("" : "+v"(fr), "+v"(fq));
        const int row0 = u.pm * BM + wr * 64 + fr, col0 = u.pn * BM + wc * 32 + 8 * fq;
#pragma unroll
        for (int ai = 0; ai < 2; ++ai)
#pragma unroll
            for (int m = 0; m < 4; ++m) { const size_t r = (size_t)(row0 + ai * HALF + m * 16);
#pragma unroll
                for (int bj = 0; bj < 2; ++bj) { const u32x4 g = *(const u32x4*)(GT + r * 4096 + 2048 + col0 + bj * HALF);
                    f32x4 v0 = acc[ai][bj][m][0], v1 = acc[ai][bj][m][1];
                    v0[0] *= fmaxf(bf_lo(g.x), 1e-30f); v0[1] *= fmaxf(bf_hi(g.x), 1e-30f); v0[2] *= fmaxf(bf_lo(g.y), 1e-30f); v0[3] *= fmaxf(bf_hi(g.y), 1e-30f);
                    v1[0] *= fmaxf(bf_lo(g.z), 1e-30f); v1[1] *= fmaxf(bf_hi(g.z), 1e-30f); v1[2] *= fmaxf(bf_lo(g.w), 1e-30f); v1[3] *= fmaxf(bf_hi(g.w), 1e-30f);
                    u32x4 w; w.x = cvt_pk_bf16(v0[0], v0[1]); w.y = cvt_pk_bf16(v0[2], v0[3]); w.z = cvt_pk_bf16(v1[0], v1[1]); w.w = cvt_pk_bf16(v1[2], v1[3]);
                    *(u32x4*)(MG + r * 2048 + col0 + bj * HALF) = w; }
                if (m & 1) asm volatile("" ::: "memory"); }
    }
};
struct EpiOut {
    static constexpr bool PERM = false, AFTER_DRAIN = false, MIDK = false;
    const float* X; float* X1; float* SSQ;
    __device__ __forceinline__ void operator()(const f32x4 (&acc)[2][2][4][2], const Unit& u, int wr, int wc, int fr, int fq) const {
        const int row0 = u.pm * BM + wr * 64 + fr, col0 = u.pn * BM + wc * 32 + 4 * fq;
#pragma unroll
        for (int ai = 0; ai < 2; ++ai)
#pragma unroll
            for (int m = 0; m < 4; ++m) { const size_t r = (size_t)(row0 + ai * HALF + m * 16); float s = 0.f;
#pragma unroll
                for (int bj = 0; bj < 2; ++bj)
#pragma unroll
                    for (int n = 0; n < 2; ++n) { const size_t off = r * 2048 + col0 + bj * HALF + n * 16;
                        const f32x4 v = *(const f32x4*)(X + off) + acc[ai][bj][m][n]; *(f32x4*)(X1 + off) = v;
                        s += (v[0] * v[0] + v[1] * v[1]) + (v[2] * v[2] + v[3] * v[3]); }
                s += __shfl_xor(s, 16); s += __shfl_xor(s, 32);
                if (fq == 0) SSQ[r * 32 + u.pn * 4 + wc] = s;
                if (m & 1) asm volatile("" ::: "memory"); }
    }
};
struct EpiG1 {
    static constexpr bool PERM = true, AFTER_DRAIN = false, MIDK = false;
    bf16_t* U;
    __device__ __forceinline__ void operator()(const f32x4 (&acc)[2][2][4][2], const Unit& u, int wr, int wc, int fr, int fq) const {
        const int row0 = u.pm * BM + wr * 64 + fr, col0 = u.pn * HALF + wc * 32 + 8 * fq;
#pragma unroll
        for (int ai = 0; ai < 2; ++ai)
#pragma unroll
            for (int m = 0; m < 4; ++m) { f32x4 v0, v1;
#pragma unroll
                for (int e = 0; e < 4; ++e) { const float g0 = acc[ai][0][m][0][e], g1 = acc[ai][0][m][1][e];
                    v0[e] = g0 * sigmoid_f(g0) * acc[ai][1][m][0][e]; v1[e] = g1 * sigmoid_f(g1) * acc[ai][1][m][1][e]; }
                u32x4 w; w.x = cvt_pk_bf16(v0[0], v0[1]); w.y = cvt_pk_bf16(v0[2], v0[3]); w.z = cvt_pk_bf16(v1[0], v1[1]); w.w = cvt_pk_bf16(v1[2], v1[3]);
                *(u32x4*)(U + (size_t)(row0 + ai * HALF + m * 16) * 512 + col0) = w; }
    }
};
constexpr int MOE_LCAP = 32768;
struct EpiG2 {
    static constexpr bool PERM = true, AFTER_DRAIN = false, MIDK = false;
    bf16_t* YC; const float* LW; const PG8_LAS int* tab;
    __device__ __forceinline__ void operator()(const f32x4 (&acc)[2][2][4][2], const Unit& u, int wr, int wc, int fr, int fq) const {
        const int row0 = u.pm * BM + wr * 64 + fr, col0 = u.pn * BM + wc * 32 + 8 * fq;
        const int slot0 = (u.pm - tab[32 + u.ex]) * BM + wr * 64 + fr, cnt = tab[u.ex];
#pragma unroll
        for (int ai = 0; ai < 2; ++ai)
#pragma unroll
            for (int m = 0; m < 4; ++m) { const size_t r = (size_t)(row0 + ai * HALF + m * 16); const int slot = slot0 + ai * HALF + m * 16;
                const float wt = slot < cnt ? LW[(size_t)u.ex * MOE_LCAP + slot] : 0.f;
#pragma unroll
                for (int bj = 0; bj < 2; ++bj) { const f32x4 v0 = acc[ai][bj][m][0] * wt, v1 = acc[ai][bj][m][1] * wt;
                    u32x4 w; w.x = cvt_pk_bf16(v0[0], v0[1]); w.y = cvt_pk_bf16(v0[2], v0[3]); w.z = cvt_pk_bf16(v1[0], v1[1]); w.w = cvt_pk_bf16(v1[2], v1[3]);
                    *(u32x4*)(YC + r * 2048 + col0 + bj * HALF) = w; } }
    }
};
template <int NT, long BSTRIDE  , bool GATHER_> struct MoeOrder {
    static constexpr bool GATHER = GATHER_;
    const PG8_LAS int* tab; int G, c; const int* LENT;
    __device__ __forceinline__ bool next(int i, Unit& u) const {
        const int P = tab[64]; const long L = (long)i * G + c; if (L >= (long)P * NT) return false;
        const int p = (int)(L / NT); int e = 0;
#pragma unroll 1
        for (int k = 1; k < 32; ++k) if (tab[32 + k] <= p) e = k;
        u.pm = p; u.pn = (int)(L % NT); u.bofs = (long)e * BSTRIDE; u.ex = e; return true;
    }
    __device__ __forceinline__ unsigned row_byteoff(const Unit& u, int row, int K) const {
        const int slot = (u.pm - tab[32 + u.ex]) * BM + row; const int tok = slot < tab[u.ex] ? (LENT[(size_t)u.ex * MOE_LCAP + slot] >> 1) : 0;
        return (unsigned)tok * (unsigned)(K * 2);
    }
    __device__ __forceinline__ void a_ready(const Unit&) const {}
    __device__ __forceinline__ void done(const Unit&) const {}
};

template <class Epi, class Sched, bool ALIGN_EPI = false, bool SP2 = false>
__device__ __forceinline__ void gemm_phase(PG8_LAS unsigned char* lds, const Gemm g, const Sched& S, const Epi& E) {
    const int tid = threadIdx.x, wid = __builtin_amdgcn_readfirstlane(tid >> 6), lane = tid & 63, wr = wid >> 2, wc = wid & 3, fr = lane & 15, fq = lane >> 4;
    const int K = g.K, nt = K / BK;
    unsigned voffA[2], voffB[2];
#pragma unroll
    for (int i = 0; i < 2; ++i) { int R, C; stage_rc(tid * 16 + i * 8192, R, C); const int Rb = Epi::PERM ? ((R & ~31) + perm32(R & 31)) : R;
        voffA[i] = (unsigned)(R * K + C) * 2u; voffB[i] = (unsigned)(Rb * K + C) * 2u; }
    const size_t kstep = (size_t)(BK * 2);
    const size_t hstep = (size_t)HALF * K * 2;
    const size_t tstep = 2 * hstep;
    const unsigned ldsw = (unsigned)wid * 1024u;
    const int aoff = lds_byte(wr * 64 + fr, fq * 8), boff = lds_byte(wc * 32 + fr, fq * 8);
#define PG8_SA(b, h) (((b) * 2 + (h)) * HTB)
#define PG8_SB(b, h) ((4 + (b) * 2 + (h)) * HTB)
#define PG8_STAGE(bufoff, gbase, voff) do { _Pragma("unroll") for (int _i = 0; _i < 2; ++_i) \
        __builtin_amdgcn_global_load_lds((const unsigned*)((const char*)(gbase) + (voff)[_i]), (PG8_LAS unsigned*)(lds + (bufoff) + ldsw + _i * 8192), 16, 0, 0); } while (0)
#define PG8_STAGEA(bufoff, gbase, h, nx) do { if constexpr (Sched::GATHER) { _Pragma("unroll") for (int _i = 0; _i < 2; ++_i) { const unsigned vo_ = (nx) ? voffAn[h][_i] : voffAc[h][_i]; \
        __builtin_amdgcn_global_load_lds((const unsigned*)((const char*)(gbase) + vo_), (PG8_LAS unsigned*)(lds + (bufoff) + ldsw + _i * 8192), 16, 0, 0); } } \
    else { PG8_STAGE(bufoff, (gbase) + (h) * hstep, voffA); } } while (0)
#define PG8_LDA(dst, b, h) do { _Pragma("unroll") for (int m = 0; m < 4; ++m) _Pragma("unroll") for (int k = 0; k < 2; ++k) dst[m][k] = *(const PG8_LAS bf16x8*)(lds + PG8_SA(b, h) + aoff + m * 2048 + k * 1024); } while (0)
#define PG8_LDB(dst, b, h) do { _Pragma("unroll") for (int n = 0; n < 2; ++n) _Pragma("unroll") for (int k = 0; k < 2; ++k) dst[n][k] = *(const PG8_LAS bf16x8*)(lds + PG8_SB(b, h) + boff + n * 2048 + k * 1024); } while (0)
#define PG8_MMA(ai, bj, At, Bt) do { __builtin_amdgcn_s_setprio(1); _Pragma("unroll") for (int m = 0; m < 4; ++m) _Pragma("unroll") for (int n = 0; n < 2; ++n) _Pragma("unroll") for (int k = 0; k < 2; ++k) \
        acc[ai][bj][m][n] = __builtin_amdgcn_mfma_f32_16x16x32_bf16(Bt[n][k], At[m][k], acc[ai][bj][m][n], 0, 0, 0); __builtin_amdgcn_s_setprio(0); } while (0)
#define PG8_WAIT_V(n) asm volatile("s_waitcnt vmcnt(" #n ")" ::: "memory")
#define PG8_WAIT_L(n) asm volatile("s_waitcnt lgkmcnt(" #n ")" ::: "memory")
#define PG8_BAR __builtin_amdgcn_s_barrier()
#define PG8_SCHED __builtin_amdgcn_sched_barrier(0)
    Unit cur, nxt; int ui = 0;
    if (!S.next(0, cur)) return;
    f32x4 acc[2][2][4][2];
#pragma unroll
    for (int a = 0; a < 2; ++a)
#pragma unroll
        for (int b = 0; b < 2; ++b)
#pragma unroll
            for (int m = 0; m < 4; ++m)
#pragma unroll
                for (int n = 0; n < 2; ++n) acc[a][b][m][n] = (f32x4){0.f, 0.f, 0.f, 0.f};
    bf16x8 At[4][2], B0[2][2], B1[2][2];
    const char* cA = (const char*)g.A + (Sched::GATHER ? (size_t)0 : (size_t)cur.pm * tstep); const char* cB = (const char*)g.Bt + (size_t)cur.pn * tstep + cur.bofs;
    unsigned voffAc[2][2] = {{0u, 0u}, {0u, 0u}}, voffAn[2][2] = {{0u, 0u}, {0u, 0u}};
    if constexpr (Sched::GATHER) {
#pragma unroll
        for (int h = 0; h < 2; ++h)
#pragma unroll
            for (int i = 0; i < 2; ++i) { int R, C; stage_rc(tid * 16 + i * 8192, R, C); voffAc[h][i] = S.row_byteoff(cur, h * HALF + R, K) + (unsigned)C * 2u; }
    }
    S.a_ready(cur);
    if constexpr (SP2) {
        PG8_STAGE(PG8_SB(0, 0), cB, voffB); PG8_STAGE(PG8_SB(0, 1), cB + hstep, voffB); PG8_STAGEA(PG8_SA(0, 0), cA, 0, false); PG8_STAGEA(PG8_SA(0, 1), cA, 1, false);
        if (wr == 1) PG8_BAR;
        PG8_WAIT_V(2); PG8_BAR;
        PG8_STAGE(PG8_SB(1, 0), cB + kstep, voffB); PG8_STAGEA(PG8_SA(1, 0), cA + kstep, 0, false); PG8_STAGE(PG8_SB(1, 1), cB + hstep + kstep, voffB);
        PG8_WAIT_V(6); PG8_BAR;
    } else {
        PG8_STAGE(PG8_SB(0, 0), cB, voffB); PG8_STAGE(PG8_SA(0, 0), cA, voffA); PG8_STAGE(PG8_SB(0, 1), cB + hstep, voffB); PG8_STAGE(PG8_SA(0, 1), cA + hstep, voffA);
        if (wr == 1) PG8_BAR;
        PG8_WAIT_V(4); PG8_BAR;
        PG8_STAGE(PG8_SB(1, 0), cB + kstep, voffB); PG8_STAGE(PG8_SA(1, 0), cA + kstep, voffA); PG8_STAGE(PG8_SB(1, 1), cB + hstep + kstep, voffB);
        PG8_WAIT_V(6); PG8_BAR;
    }
    for (;;) {
        const bool has_next = S.next(ui + 1, nxt);
        if constexpr (Sched::GATHER) { if (has_next) {
#pragma unroll
            for (int h = 0; h < 2; ++h)
#pragma unroll
                for (int i = 0; i < 2; ++i) { int R, C; stage_rc(tid * 16 + i * 8192, R, C); voffAn[h][i] = S.row_byteoff(nxt, h * HALF + R, K) + (unsigned)C * 2u; } }
            else {
#pragma unroll
            for (int h = 0; h < 2; ++h)
#pragma unroll
                for (int i = 0; i < 2; ++i) voffAn[h][i] = voffAc[h][i]; } }
        const char* nA = Sched::GATHER ? cA : (has_next ? (const char*)g.A + (size_t)nxt.pm * tstep : cA); const char* nB = has_next ? (const char*)g.Bt + (size_t)nxt.pn * tstep + nxt.bofs : cB;
        constexpr int NKH = Epi::MIDK ? 2 : 1;
        int t = 0;
#pragma unroll 1
        for (int kh = 0; kh < NKH; ++kh) {
        const int tend = (NKH == 2 && kh == 0) ? nt / 2 : nt;
#pragma unroll 1
        for (; t < tend; t += 2) {
            const bool last = (t == nt - 2);
            const char* a1 = cA + (size_t)(t + 1) * kstep;
            const char* a2 = last ? nA : cA + (size_t)(t + 2) * kstep; const char* b2 = last ? nB : cB + (size_t)(t + 2) * kstep;
            const char* a3 = a2 + kstep; const char* b3 = b2 + kstep;
            if (last && has_next) S.a_ready(nxt);
            if constexpr (SP2) {
            PG8_LDB(B0, 0, 0); PG8_LDB(B1, 0, 1); PG8_SCHED; PG8_LDA(At, 0, 0); PG8_STAGEA(PG8_SA(1, 1), a1, 1, false);
            PG8_WAIT_V(8); PG8_WAIT_L(0); PG8_BAR; PG8_MMA(0, 0, At, B0); PG8_MMA(0, 1, At, B1); PG8_BAR; PG8_SCHED;
            PG8_LDA(At, 0, 1); PG8_STAGE(PG8_SB(0, 0), b2, voffB); PG8_STAGE(PG8_SB(0, 1), b2 + hstep, voffB); PG8_STAGEA(PG8_SA(0, 0), a2, 0, last);
            PG8_WAIT_V(8); PG8_WAIT_L(0); PG8_BAR; PG8_MMA(1, 0, At, B0); PG8_MMA(1, 1, At, B1); PG8_BAR; PG8_SCHED;
            PG8_LDB(B0, 1, 0); PG8_LDB(B1, 1, 1); PG8_SCHED; PG8_LDA(At, 1, 0); PG8_STAGEA(PG8_SA(0, 1), a2, 1, last);
            PG8_WAIT_V(8); PG8_WAIT_L(0); PG8_BAR; PG8_MMA(0, 0, At, B0); PG8_MMA(0, 1, At, B1); PG8_BAR; PG8_SCHED;
            PG8_LDA(At, 1, 1); PG8_STAGE(PG8_SB(1, 0), b3, voffB); PG8_STAGE(PG8_SB(1, 1), b3 + hstep, voffB); PG8_STAGEA(PG8_SA(1, 0), a3, 0, last);
            PG8_WAIT_V(8); PG8_WAIT_L(0); PG8_BAR; PG8_MMA(1, 0, At, B0); PG8_MMA(1, 1, At, B1); PG8_BAR; PG8_SCHED;
            } else {
            PG8_LDB(B0, 0, 0); PG8_SCHED; PG8_LDA(At, 0, 0); PG8_STAGE(PG8_SA(1, 1), a1 + hstep, voffA);
            PG8_WAIT_L(8); PG8_BAR; PG8_WAIT_L(0); PG8_MMA(0, 0, At, B0); PG8_BAR; PG8_SCHED;
            PG8_LDB(B1, 0, 1); PG8_STAGE(PG8_SB(0, 0), b2, voffB);
            PG8_BAR; PG8_WAIT_L(0); PG8_MMA(0, 1, At, B1); PG8_BAR;
            PG8_LDA(At, 0, 1); PG8_STAGE(PG8_SA(0, 0), a2, voffA);
            PG8_BAR; PG8_WAIT_L(0); PG8_MMA(1, 0, At, B0); PG8_BAR; PG8_SCHED;
            PG8_STAGE(PG8_SB(0, 1), b2 + hstep, voffB);
            PG8_WAIT_V(6); PG8_BAR; PG8_MMA(1, 1, At, B1); PG8_BAR;
            PG8_LDB(B0, 1, 0); PG8_SCHED; PG8_LDA(At, 1, 0); PG8_STAGE(PG8_SA(0, 1), a2 + hstep, voffA);
            PG8_WAIT_L(8); PG8_BAR; PG8_WAIT_L(0); PG8_MMA(0, 0, At, B0); PG8_BAR; PG8_SCHED;
            PG8_LDB(B1, 1, 1); PG8_STAGE(PG8_SB(1, 0), b3, voffB);
            PG8_BAR; PG8_WAIT_L(0); PG8_MMA(0, 1, At, B1); PG8_BAR;
            PG8_LDA(At, 1, 1); PG8_STAGE(PG8_SA(1, 0), a3, voffA);
            PG8_BAR; PG8_WAIT_L(0); PG8_MMA(1, 0, At, B0); PG8_BAR; PG8_SCHED;
            PG8_STAGE(PG8_SB(1, 1), b3 + hstep, voffB);
            PG8_WAIT_V(6); PG8_BAR; PG8_MMA(1, 1, At, B1); PG8_BAR;
            }
        }
        if constexpr (Epi::MIDK) { if (kh == 0) E.mid(acc, cur, wr, wc, fr, fq); }
        }
        if constexpr (ALIGN_EPI) { if (wr == 0) PG8_BAR; }
        if constexpr (!Epi::AFTER_DRAIN) { E(acc, cur, wr, wc, fr, fq); S.done(cur); }
        if (!has_next) break;
#pragma unroll
        for (int a = 0; a < 2; ++a)
#pragma unroll
            for (int b = 0; b < 2; ++b)
#pragma unroll
                for (int m = 0; m < 4; ++m)
#pragma unroll
                    for (int n = 0; n < 2; ++n) acc[a][b][m][n] = (f32x4){0.f, 0.f, 0.f, 0.f};
        cur = nxt; cA = nA; cB = nB; ++ui;
        if constexpr (Sched::GATHER) {
#pragma unroll
            for (int h = 0; h < 2; ++h)
#pragma unroll
                for (int i = 0; i < 2; ++i) voffAc[h][i] = voffAn[h][i]; }
        if constexpr (ALIGN_EPI) { if (wr == 1) PG8_BAR; }
    }
    PG8_WAIT_V(0);
    if constexpr (!ALIGN_EPI) { if (wr == 0) PG8_BAR; }
    PG8_BAR;
    if constexpr (Epi::AFTER_DRAIN) { E.fused(acc, cur, wr, wc, fr, fq, lds, wid, lane); S.done(cur); }
#undef PG8_SA
#undef PG8_SB
#undef PG8_STAGE
#undef PG8_STAGEA
#undef PG8_LDA
#undef PG8_LDB
#undef PG8_MMA
#undef PG8_WAIT_V
#undef PG8_WAIT_L
#undef PG8_BAR
#undef PG8_SCHED
}
}

namespace att {
typedef unsigned short bf16;
using bf16x8 = __attribute__((ext_vector_type(8))) short;
using s16x4  = __attribute__((ext_vector_type(4))) short;
using f32x16 = __attribute__((ext_vector_type(16))) float;
using u32x4  = __attribute__((ext_vector_type(4))) unsigned;
constexpr int NW = 8, QBLK = 32, KVBLK = 64, DV = 128;
constexpr int SHM_V = KVBLK * DV * 2;
constexpr int OFF_V = 0, OFF_K = 3 * SHM_V, OFF_STASH = 73728;
constexpr float THR = 8.f;
#define ATT_SBAR() __builtin_amdgcn_sched_barrier(0)
template <int DQK> __device__ __forceinline__ int kswz(int row, int colB) { return row * (DQK * 2) + (colB ^ ((DQK == 128 ? ((row & 7) | (((row >> 4) & 1) << 3)) : ((row >> 1) & 7)) << 4)); }
__device__ __forceinline__ int crow(int r, int hi) { return (r & 3) + 8 * (r >> 2) + 4 * hi; }
typedef float f32x2_t __attribute__((ext_vector_type(2))); typedef __bf16 bf16x2_t __attribute__((ext_vector_type(2)));
__device__ __forceinline__ unsigned cvtpk(float lo, float hi) { f32x2_t v = {lo, hi}; bf16x2_t b = __builtin_convertvector(v, bf16x2_t); return __builtin_bit_cast(unsigned, b); }

template <int DQK> __device__ __forceinline__ void partialSM(f32x16& p0, f32x16& p1, float& m_reg, float& mn, float& alpha) {
  constexpr float SCALE = (DQK == 128) ? 0.088388347648318440f : 0.125f;
  constexpr float C = SCALE * 1.4426950408889634f;
  float pmax = p0[0];
#pragma unroll
  for (int r = 1; r < 16; ++r) pmax = fmaxf(pmax, p0[r]);
#pragma unroll
  for (int r = 0; r < 16; ++r) pmax = fmaxf(pmax, p1[r]);
  { auto rr = __builtin_amdgcn_permlane32_swap(__float_as_uint(pmax), __float_as_uint(pmax), false, false);
    pmax = fmaxf(__uint_as_float(rr[0]), __uint_as_float(rr[1])); }
  if (__builtin_expect(__all(pmax - m_reg <= THR / SCALE), 1)) { mn = m_reg; alpha = 1.f; }
  else { mn = fmaxf(m_reg, pmax); alpha = __builtin_amdgcn_exp2f((m_reg - mn) * C); m_reg = mn; }
  const float mnC = -mn * C;
#pragma unroll
  for (int r = 0; r < 16; ++r) p0[r] = fmaf(p0[r], C, mnC);
#pragma unroll
  for (int r = 0; r < 16; ++r) p1[r] = fmaf(p1[r], C, mnC);
#pragma unroll
  for (int r = 0; r < 16; ++r) p0[r] = __builtin_amdgcn_exp2f(p0[r]);
}
__device__ __forceinline__ void finishSM(f32x16& p0, f32x16& p1, float alpha, float& l_reg, bf16x8& pa0, bf16x8& pa1, bf16x8& pa2, bf16x8& pa3) {
#pragma unroll
  for (int r = 0; r < 16; ++r) p1[r] = __builtin_amdgcn_exp2f(p1[r]);
  float ps = 0;
#pragma unroll
  for (int r = 0; r < 16; ++r) ps += p0[r];
#pragma unroll
  for (int r = 0; r < 16; ++r) ps += p1[r];
  { auto rr = __builtin_amdgcn_permlane32_swap(__float_as_uint(ps), __float_as_uint(ps), false, false);
    ps = __uint_as_float(rr[0]) + __uint_as_float(rr[1]); }
  l_reg = l_reg * alpha + ps;
#define ATT_PK4(P, BASE, OUT) do { unsigned a0 = cvtpk(P[BASE + 0], P[BASE + 1]), a1 = cvtpk(P[BASE + 2], P[BASE + 3]);   \
    unsigned b0 = cvtpk(P[BASE + 4], P[BASE + 5]), b1 = cvtpk(P[BASE + 6], P[BASE + 7]);                              \
    auto r0 = __builtin_amdgcn_permlane32_swap(a0, b0, false, false); auto r1 = __builtin_amdgcn_permlane32_swap(a1, b1, false, false); \
    u32x4 w = {r0[0], r1[0], r0[1], r1[1]}; OUT = *reinterpret_cast<bf16x8*>(&w); } while (0)
  ATT_PK4(p0, 0, pa0); ATT_PK4(p0, 8, pa1); ATT_PK4(p1, 0, pa2); ATT_PK4(p1, 8, pa3);
#undef ATT_PK4
}
template <int DQK> __device__ __forceinline__ void qkt(f32x16& p0, f32x16& p1, const char* Ks, const bf16x8* qr, int r32, int hi) {
  p0 = f32x16{}; p1 = f32x16{};
#pragma unroll
  for (int d0 = 0; d0 < DQK / 16; ++d0) { const int cb = (d0 * 16 + hi * 8) * 2;
    const bf16x8 b0 = *reinterpret_cast<const bf16x8*>(Ks + kswz<DQK>(r32, cb));
    const bf16x8 b1 = *reinterpret_cast<const bf16x8*>(Ks + kswz<DQK>(32 + r32, cb));
    p0 = __builtin_amdgcn_mfma_f32_32x32x16_bf16(b0, qr[d0], p0, 0, 0, 0);
    p1 = __builtin_amdgcn_mfma_f32_32x32x16_bf16(b1, qr[d0], p1, 0, 0, 0); }
}
__device__ __forceinline__ int v_st(int k, int c) { const int kk = (k & ~0xC) | ((k & 4) << 1) | ((k & 8) >> 1); return ((kk >> 3) * 4 + (c >> 5)) * 512 + ((kk & 7) * 32 + (c & 31)) * 2; }
__device__ __forceinline__ int v_rd_base(int lane) { return ((lane & 3) << 3) | (((lane >> 2) & 3) << 6) | (((lane >> 4) & 1) << 5) | (((lane >> 5) & 1) << 8); }
constexpr int v_rd_off(int d0, int ks, int half) { return d0 * 512 + ks * 4096 + half * 2048; }
template <int OFF> __device__ __forceinline__ s16x4 tr_read(int vb) {
  s16x4 r; asm volatile("ds_read_b64_tr_b16 %0, %1 offset:%2" : "=&v"(r) : "v"(vb), "i"(OFF) : "memory"); return r;
}
typedef __attribute__((address_space(3))) const char* lds_cptr;
typedef short v4i16_t __attribute__((ext_vector_type(4)));
__device__ __forceinline__ s16x4 vtr(lds_cptr p) { return __builtin_bit_cast(s16x4, __builtin_amdgcn_ds_read_tr16_b64_v4i16((__attribute__((address_space(3))) v4i16_t*)p)); }
template <int D0> __device__ __forceinline__ void pv_one(f32x16& od, int vb, bf16x8 pa0, bf16x8 pa1, bf16x8 pa2, bf16x8 pa3) {
  const s16x4 l0 = tr_read<v_rd_off(D0, 0, 0)>(vb), h0 = tr_read<v_rd_off(D0, 0, 1)>(vb), l1 = tr_read<v_rd_off(D0, 1, 0)>(vb), h1 = tr_read<v_rd_off(D0, 1, 1)>(vb);
  const s16x4 l2 = tr_read<v_rd_off(D0, 2, 0)>(vb), h2 = tr_read<v_rd_off(D0, 2, 1)>(vb), l3 = tr_read<v_rd_off(D0, 3, 0)>(vb), h3 = tr_read<v_rd_off(D0, 3, 1)>(vb);
  asm volatile("s_waitcnt lgkmcnt(0)" ::: "memory"); ATT_SBAR();
#define ATT_PK(L, H) (bf16x8){L[0], L[1], L[2], L[3], H[0], H[1], H[2], H[3]}
  od = __builtin_amdgcn_mfma_f32_32x32x16_bf16(pa0, ATT_PK(l0, h0), od, 0, 0, 0);
  od = __builtin_amdgcn_mfma_f32_32x32x16_bf16(pa1, ATT_PK(l1, h1), od, 0, 0, 0);
  od = __builtin_amdgcn_mfma_f32_32x32x16_bf16(pa2, ATT_PK(l2, h2), od, 0, 0, 0);
  od = __builtin_amdgcn_mfma_f32_32x32x16_bf16(pa3, ATT_PK(l3, h3), od, 0, 0, 0);
#undef ATT_PK
}
__device__ __forceinline__ void pv_d0(f32x16* o, int vb, bf16x8 pa0, bf16x8 pa1, bf16x8 pa2, bf16x8 pa3) {
  pv_one<0>(o[0], vb, pa0, pa1, pa2, pa3); pv_one<1>(o[1], vb, pa0, pa1, pa2, pa3); pv_one<2>(o[2], vb, pa0, pa1, pa2, pa3); pv_one<3>(o[3], vb, pa0, pa1, pa2, pa3);
}

constexpr float THRL = 11.5f;
__device__ __forceinline__ void softmax_tile(f32x16& p0, f32x16& p1, f32x16& negm, float& alpha, bool first, bf16x8& pa0, bf16x8& pa1, bf16x8& pa2, bf16x8& pa3) {
  float pmax = fmaxf(p0[0], p1[0]);
#pragma unroll
  for (int r = 1; r < 16; ++r) pmax = fmaxf(pmax, fmaxf(p0[r], p1[r]));
  { auto rr = __builtin_amdgcn_permlane32_swap(__float_as_uint(pmax), __float_as_uint(pmax), false, false);
    pmax = fmaxf(__uint_as_float(rr[0]), __uint_as_float(rr[1])); }
  alpha = 1.f;
  if (__builtin_expect(first || !__all(pmax <= THRL), 0)) {
    const float delta = first ? pmax : fmaxf(pmax, 0.f);
    alpha = first ? 1.f : __builtin_amdgcn_exp2f(-delta);
#pragma unroll
    for (int r = 0; r < 16; ++r) { p0[r] -= delta; p1[r] -= delta; negm[r] -= delta; }
  }
#pragma unroll
  for (int r = 0; r < 16; ++r) { p0[r] = __builtin_amdgcn_exp2f(p0[r]); p1[r] = __builtin_amdgcn_exp2f(p1[r]); }
#define ATT_PK4(P, BASE, OUT) do { unsigned a0 = cvtpk(P[BASE + 0], P[BASE + 1]), a1 = cvtpk(P[BASE + 2], P[BASE + 3]);   \
    unsigned b0 = cvtpk(P[BASE + 4], P[BASE + 5]), b1 = cvtpk(P[BASE + 6], P[BASE + 7]);                              \
    auto r0 = __builtin_amdgcn_permlane32_swap(a0, b0, false, false); auto r1 = __builtin_amdgcn_permlane32_swap(a1, b1, false, false); \
    u32x4 w = {r0[0], r1[0], r0[1], r1[1]}; OUT = *reinterpret_cast<bf16x8*>(&w); } while (0)
  ATT_PK4(p0, 0, pa0); ATT_PK4(p0, 8, pa1); ATT_PK4(p1, 0, pa2); ATT_PK4(p1, 8, pa3);
#undef ATT_PK4
}

template <int DQK> __device__ __forceinline__ void q_prepare(bf16x8 (&qr)[DQK / 16], const float* rope, const float* gain, int s, int hi) {
  typedef float f32x4q __attribute__((ext_vector_type(4)));
  constexpr float CS = (DQK == 128) ? 0.12751743074602467f : 0.18033688011112042f;
  float v[DQK / 16][8];
#pragma unroll
  for (int d0 = 0; d0 < DQK / 16; ++d0) { const u32x4 w = *reinterpret_cast<const u32x4*>(&qr[d0]);
    v[d0][0] = __uint_as_float(w.x << 16); v[d0][1] = __uint_as_float(w.x & 0xffff0000u); v[d0][2] = __uint_as_float(w.y << 16); v[d0][3] = __uint_as_float(w.y & 0xffff0000u);
    v[d0][4] = __uint_as_float(w.z << 16); v[d0][5] = __uint_as_float(w.z & 0xffff0000u); v[d0][6] = __uint_as_float(w.w << 16); v[d0][7] = __uint_as_float(w.w & 0xffff0000u); }
  float mul = CS;
  if constexpr (DQK == 128) {
    float ss = 0.f;
#pragma unroll
    for (int d0 = 0; d0 < 8; ++d0)
#pragma unroll
      for (int j = 0; j < 8; ++j) ss += v[d0][j] * v[d0][j];
    ss += __shfl_xor(ss, 32);
    mul = CS / sqrtf(ss * (1.0f / 128.0f) + 1e-6f);
#pragma unroll
    for (int d0 = 0; d0 < 8; ++d0) { const f32x4q g0 = *(const f32x4q*)(gain + 16 * d0 + 8 * hi), g1 = *(const f32x4q*)(gain + 16 * d0 + 8 * hi + 4);
      v[d0][0] *= g0.x; v[d0][1] *= g0.y; v[d0][2] *= g0.z; v[d0][3] *= g0.w; v[d0][4] *= g1.x; v[d0][5] *= g1.y; v[d0][6] *= g1.z; v[d0][7] *= g1.w; }
  }
#pragma unroll
  for (int blk = 0; blk < DQK / 64; ++blk) {
    const int pos = (DQK == 128) ? (blk == 0 ? (s >> 6) : (s & 63)) : s;
#pragma unroll
    for (int dd = 0; dd < 2; ++dd) {
      const f32x4q* tp = (const f32x4q*)(rope + ((size_t)pos * 32 + 16 * dd + 8 * hi) * 2);
      const f32x4q t0 = tp[0], t1 = tp[1], t2 = tp[2], t3 = tp[3];
      const float cs[8] = {t0.x, t0.z, t1.x, t1.z, t2.x, t2.z, t3.x, t3.z}, sn[8] = {t0.y, t0.w, t1.y, t1.w, t2.y, t2.w, t3.y, t3.w};
#pragma unroll
      for (int j = 0; j < 8; ++j) { const float x1 = v[4 * blk + dd][j], x2 = v[4 * blk + dd + 2][j];
        v[4 * blk + dd][j] = x1 * cs[j] - x2 * sn[j]; v[4 * blk + dd + 2][j] = x2 * cs[j] + x1 * sn[j]; }
    }
  }
#pragma unroll
  for (int d0 = 0; d0 < DQK / 16; ++d0) { u32x4 w = {cvtpk(v[d0][0] * mul, v[d0][1] * mul), cvtpk(v[d0][2] * mul, v[d0][3] * mul), cvtpk(v[d0][4] * mul, v[d0][5] * mul), cvtpk(v[d0][6] * mul, v[d0][7] * mul)};
    qr[d0] = *reinterpret_cast<bf16x8*>(&w); }
}

template <int DQK, int LDQ, int LDK, int LDV, int ABL = 0>
__device__ __forceinline__ void attn_pass(const bf16* __restrict__ Qb, const bf16* __restrict__ Kh, const bf16* __restrict__ Vh, int seq, char* lds, float* wsf, f32x16 (&o)[4], float (&rli)[16], const float* rope, const float* gain, int s0) {
  constexpr int SHM_K = KVBLK * DQK * 2, NKF = DQK / 8;
  int tid_ = threadIdx.x; asm volatile("" : "+v"(tid_));
  const int tid = tid_, lane = tid & 63, r32 = lane & 31, hi = lane >> 5;
  const int wid = __builtin_amdgcn_readfirstlane(tid >> 6), grp = wid >> 2;
  char* V_lds = lds + OFF_V; char* K_lds = lds + OFF_K;
  float* al_l = wsf + 32;
  bf16x8 qr[DQK / 16];
  const bf16* Qw = Qb + (long)(wid * QBLK + r32) * LDQ + hi * 8;
#pragma unroll
  for (int d0 = 0; d0 < DQK / 16; ++d0) qr[d0] = *reinterpret_cast<const bf16x8*>(Qw + d0 * 16);
  q_prepare<DQK>(qr, rope, gain, s0 + wid * QBLK + r32, hi);
#pragma unroll
  for (int d0 = 0; d0 < DQK / 16; ++d0) asm volatile("" : "+v"(qr[d0]));
  f32x16 lacc = f32x16{}, negm = f32x16{}; asm volatile("" : "+v"(lacc));
#pragma unroll
  for (int d = 0; d < 4; ++d) o[d] = f32x16{};
  const int sr = tid >> 4, sc = (tid & 15) * 8, vst0 = v_st(sr, sc), vst1 = v_st(32 + sr, sc);
  const int kr = (DQK == 128) ? sr : (tid >> 3), kc = (DQK == 128) ? sc : (tid & 7) * 8;
  const int vb0 = (int)(uintptr_t)V_lds + v_rd_base(lane);
  bf16x8 sv0, sv1, sk0, sk1;
  const bf16* kp = Kh + (long)kr * LDK + kc; const bf16* vp = Vh + (long)sr * LDV + sc;
#define ATT_LOAD_K(t) do { sk0 = *reinterpret_cast<const bf16x8*>(kp + (long)(t) * (KVBLK * LDK)); if constexpr (DQK == 128) sk1 = *reinterpret_cast<const bf16x8*>(kp + (long)(t) * (KVBLK * LDK) + 32 * LDK); } while (0)
#define ATT_LOAD_V(t) do { sv0 = *reinterpret_cast<const bf16x8*>(vp + (long)(t) * (KVBLK * LDV)); sv1 = *reinterpret_cast<const bf16x8*>(vp + (long)(t) * (KVBLK * LDV) + 32 * LDV); } while (0)
#define ATT_WRITE_K(so) do { *(bf16x8*)(K_lds + (so) + kswz<DQK>(kr, kc * 2)) = sk0; if constexpr (DQK == 128) *(bf16x8*)(K_lds + (so) + kswz<DQK>(32 + kr, kc * 2)) = sk1; } while (0)
#define ATT_WRITE_V(so) do { *(bf16x8*)(V_lds + (so) + vst0) = sv0; *(bf16x8*)(V_lds + (so) + vst1) = sv1; } while (0)
#define ATT_BAR() do { ATT_SBAR(); asm volatile("s_barrier" ::: "memory"); ATT_SBAR(); } while (0)
#define ATT_RESC(a) do { if (__any((a) < 1.f)) { if (hi == 0) al_l[r32] = (a); asm volatile("s_waitcnt lgkmcnt(0)" ::: "memory"); \
    _Pragma("unroll") for (int r = 0; r < 16; ++r) { const float f_ = al_l[crow(r, hi)]; lacc[r] *= f_; _Pragma("unroll") for (int d = 0; d < 4; ++d) o[d][r] *= f_; } } } while (0)
#define ATT_MF(A_, B_, C_) do { if constexpr (ABL & 2) { asm volatile("" :: "v"(A_), "v"(B_)); } else { C_ = __builtin_amdgcn_mfma_f32_32x32x16_bf16(A_, B_, C_, 0, 0, 0); } } while (0)
#define ATT_VF(buf, ks) (bf16x8){buf[2 * ks][0], buf[2 * ks][1], buf[2 * ks][2], buf[2 * ks][3], buf[2 * ks + 1][0], buf[2 * ks + 1][1], buf[2 * ks + 1][2], buf[2 * ks + 1][3]}
  const int NT = seq / KVBLK;
  f32x16 p0, p1; float alpha; bf16x8 pa0, pa1, pa2, pa3;
  const bf16x8 ones = {0x3F80, 0x3F80, 0x3F80, 0x3F80, 0x3F80, 0x3F80, 0x3F80, 0x3F80};
  ATT_LOAD_K(0); ATT_LOAD_V(0); ATT_WRITE_K(0); ATT_WRITE_V(0);
  ATT_LOAD_K(1); ATT_WRITE_K(SHM_K);
  ATT_LOAD_K(2); ATT_LOAD_V(1);
  asm volatile("s_waitcnt lgkmcnt(0)" ::: "memory"); ATT_BAR();
  if (grp == 1) ATT_BAR();
  qkt<DQK>(p0, p1, K_lds, qr, r32, hi);
  ATT_BAR();
  int k1 = SHM_K, k2 = 2 * SHM_K, k0 = 0, v0 = 0, v1 = SHM_V, v2 = 2 * SHM_V;
  const lds_cptr kq0 = (lds_cptr)K_lds, vq0 = (lds_cptr)V_lds + v_rd_base(lane);
  bf16x8 kf[8]; s16x4 va[8], vc[8];
#define ATT_KFRAG(i, so) do { if constexpr (!(ABL & 8) && !(ABL & 16)) { const int d0_ = (i) >> 1, cb_ = (d0_ * 16 + hi * 8) * 2; kf[(i) & 7] = *(const __attribute__((address_space(3))) bf16x8*)(kq0 + (so) + kswz<DQK>(((i) & 1) * 32 + r32, cb_)); } } while (0)
#define ATT_VPAIR(buf, so, blk, ks) do { if constexpr (!(ABL & 8) && !(ABL & 32)) { buf[2 * (ks)] = vtr(vq0 + (so) + v_rd_off(blk, ks, 0)); buf[2 * (ks) + 1] = vtr(vq0 + (so) + v_rd_off(blk, ks, 1)); } } while (0)
#define ATT_PA(ks) ((ks) == 0 ? pa0 : (ks) == 1 ? pa1 : (ks) == 2 ? pa2 : pa3)
#define ATT_XSECTION(WITH_QK) do { __builtin_amdgcn_s_setprio(2); \
    _Pragma("unroll") for (int g = 0; g < 20; ++g) { const int blk = g >> 2, ks = g & 3; \
      if (blk == 4) { ATT_MF(ATT_PA(ks), ones, lacc); } \
      else if (blk == 0 || blk == 2) { ATT_MF(ATT_PA(ks), ATT_VF(va, ks), o[blk]); } \
      else { ATT_MF(ATT_PA(ks), ATT_VF(vc, ks), o[blk]); } \
      if (blk < 3) { if (blk == 0 || blk == 2) ATT_VPAIR(vc, v0, blk + 1, ks); else ATT_VPAIR(va, v0, blk + 1, ks); } \
      if (WITH_QK) { if (g >= 12 && g - 12 < NKF) ATT_KFRAG(g - 12, k1); } \
      ATT_SBAR(); } \
    if (WITH_QK) { _Pragma("unroll") for (int i = 0; i < NKF; ++i) { \
      if (i < 2) { if (i == 0) { if constexpr (ABL & 2) { asm volatile("" :: "v"(kf[0])); p0 = negm; } else p0 = __builtin_amdgcn_mfma_f32_32x32x16_bf16(kf[0], qr[0], negm, 0, 0, 0); } \
                   else        { if constexpr (ABL & 2) { asm volatile("" :: "v"(kf[1])); p1 = negm; } else p1 = __builtin_amdgcn_mfma_f32_32x32x16_bf16(kf[1], qr[0], negm, 0, 0, 0); } } \
      else if (i & 1) { ATT_MF(kf[i & 7], qr[i >> 1], p1); } else { ATT_MF(kf[i & 7], qr[i >> 1], p0); } \
      if (i + 8 < NKF) ATT_KFRAG(i + 8, k1); \
      ATT_SBAR(); } } __builtin_amdgcn_s_setprio(0); } while (0)
  for (int t = 0; t + 1 < NT; ++t) {
    if constexpr (ABL & 1) { u32x4 w0 = {cvtpk(p0[0], p0[1]), cvtpk(p0[2], p0[3]), cvtpk(p0[4], p0[5]), cvtpk(p0[6], p0[7])}, w1 = {cvtpk(p0[8], p0[9]), cvtpk(p0[10], p0[11]), cvtpk(p0[12], p0[13]), cvtpk(p0[14], p0[15])};
        u32x4 w2 = {cvtpk(p1[0], p1[1]), cvtpk(p1[2], p1[3]), cvtpk(p1[4], p1[5]), cvtpk(p1[6], p1[7])}, w3 = {cvtpk(p1[8], p1[9]), cvtpk(p1[10], p1[11]), cvtpk(p1[12], p1[13]), cvtpk(p1[14], p1[15])};
        pa0 = *reinterpret_cast<bf16x8*>(&w0); pa1 = *reinterpret_cast<bf16x8*>(&w1); pa2 = *reinterpret_cast<bf16x8*>(&w2); pa3 = *reinterpret_cast<bf16x8*>(&w3); alpha = 1.f; }
    else { softmax_tile(p0, p1, negm, alpha, t == 0, pa0, pa1, pa2, pa3);
    ATT_RESC(alpha); }
    if constexpr (!(ABL & 4)) { ATT_WRITE_K(k2); ATT_WRITE_V(v1); }
    ATT_SBAR();
#pragma unroll
    for (int ks = 0; ks < 4; ++ks) ATT_VPAIR(va, v0, 0, ks);
    asm volatile("s_waitcnt lgkmcnt(0)" ::: "memory"); ATT_BAR();
    ATT_XSECTION(true);
    if constexpr (!(ABL & 4)) { const int tk = (t + 3 < NT) ? t + 3 : NT - 1, tv = (t + 2 < NT) ? t + 2 : NT - 1; ATT_LOAD_K(tk); ATT_LOAD_V(tv); }
    ATT_BAR();
    { const int tk_ = k0; k0 = k1; k1 = k2; k2 = tk_; const int tv_ = v0; v0 = v1; v1 = v2; v2 = tv_; }
  }
  softmax_tile(p0, p1, negm, alpha, false, pa0, pa1, pa2, pa3);
  ATT_RESC(alpha);
#pragma unroll
  for (int ks = 0; ks < 4; ++ks) ATT_VPAIR(va, v0, 0, ks);
  asm volatile("s_waitcnt lgkmcnt(0)" ::: "memory"); ATT_BAR();
  ATT_XSECTION(false);
  ATT_BAR();
  if (grp == 0) ATT_BAR();
#pragma unroll
  for (int r = 0; r < 16; ++r) rli[r] = __builtin_amdgcn_rcpf(lacc[r]);
#undef ATT_LOAD_K
#undef ATT_LOAD_V
#undef ATT_WRITE_K
#undef ATT_WRITE_V
#undef ATT_BAR
#undef ATT_RESC
#undef ATT_MF
#undef ATT_VF
#undef ATT_KFRAG
#undef ATT_VPAIR
#undef ATT_PA
#undef ATT_XSECTION
}
}

constexpr int NWAVES = 8;
constexpr int DM = 2048, BATCH = 4, SEQ = 8192, T = BATCH * SEQ;
constexpr int NCOL1 = 4608 + 4096;
constexpr int NEXP = 32, FF = 512, LCAP = 32768;
constexpr int PMAX = 288;
constexpr float EPS = 1e-6f;
constexpr float LAM_INIT = 0.2f;
#ifndef MK_ONE_LAUNCH
#define MK_ONE_LAUNCH 1
#endif
constexpr int N_PHASES = 10;
#ifndef ATT_DUMMY
#define ATT_DUMMY -1
#define ATT_DUMMY_B 0
#endif
#ifndef PROBE_MASK
#define PROBE_MASK 0
#define PROBE_MUL 1
#define PROBE_BLOCK 0
#endif

constexpr size_t MiB = 1u << 20;
constexpr size_t WS_CTL = 0, CTL_ZERO_BYTES = 1 * MiB;
constexpr size_t WS_ROPE = 2 * MiB;
constexpr size_t WS_WRT = 4 * MiB;
constexpr size_t WS_TOKROW = 5 * MiB;
constexpr size_t WS_ROWW = 6 * MiB;
constexpr size_t WS_WIN = 8 * MiB;
constexpr size_t WS_WA = 42 * MiB, WS_WB = 46 * MiB, WS_WO = 50 * MiB;
constexpr size_t WS_W13 = 58 * MiB;
constexpr size_t WS_W2 = 186 * MiB;
constexpr size_t WS_SSQ = 250 * MiB;
constexpr size_t WS_LENT = 254 * MiB, WS_LW = 258 * MiB;
constexpr size_t WS_XN = 264 * MiB;
constexpr size_t WS_QA = 392 * MiB, WS_KA = 456 * MiB, WS_VA = 472 * MiB, WS_QB = 488 * MiB, WS_KB = 552 * MiB, WS_VB = 616 * MiB;
constexpr size_t WS_XG = 392 * MiB;
constexpr size_t WS_GT = 680 * MiB;
constexpr size_t WS_YC = WS_XG;
constexpr size_t WS_END = 936 * MiB;
constexpr int CW_CNT = 64;
constexpr int CW_BAR = 4096;

constexpr int SCR_OFF = 0, SCR_BYTES = 139264;
constexpr int AWS_OFF = 139264;
constexpr int MOE_OFF = AWS_OFF + 2048;
constexpr int MISC_OFF = MOE_OFF + 512;
constexpr int LDS_BYTES = 147456;
static_assert(MISC_OFF + 128 <= LDS_BYTES, "LDS map");

#define GAS __attribute__((address_space(1)))
#define LAS __attribute__((address_space(3)))
typedef unsigned short bf16;
typedef unsigned v4u __attribute__((ext_vector_type(4)));
typedef unsigned v2u __attribute__((ext_vector_type(2)));
typedef float f32x4 __attribute__((ext_vector_type(4)));
typedef short bf16x8 __attribute__((ext_vector_type(8)));
typedef GAS unsigned gu32;
#define RLX_AGENT __ATOMIC_RELAXED, __HIP_MEMORY_SCOPE_AGENT
#define LDS_WAIT() asm volatile("s_waitcnt lgkmcnt(0)" ::: "memory")
#define VM_WAIT() asm volatile("s_waitcnt vmcnt(0)" ::: "memory")
__device__ __forceinline__ unsigned f2bf(float f) { unsigned u = __builtin_bit_cast(unsigned, f); return (u + 0x7fffu + ((u >> 16) & 1u)) >> 16; }
__device__ __forceinline__ unsigned pk2(float lo, float hi) { return f2bf(lo) | (f2bf(hi) << 16); }
__device__ __forceinline__ float bflo(unsigned w) { return __uint_as_float(w << 16); }
__device__ __forceinline__ float bfhi(unsigned w) { return __uint_as_float(w & 0xffff0000u); }
__device__ __forceinline__ float wave_sum(float v) {
#pragma unroll
    for (int o = 1; o < 64; o <<= 1) v += __shfl_xor(v, o);
    return v;
}

#define XB_TMO      128
#define XB_XCNT(j)  (256  + 64 * (j))
#define XB_XSUB(j)  (1280 + 64 * (j))
#define XB_XGEN(j)  (2304 + 64 * (j))
#define XB_TOP      3328
#define XB_TOPGEN   3392
#define XCD_BAR_WORDS 3456
#define XB_SPIN_CAP (1u << 18)

__device__ __forceinline__ unsigned xb_ld(unsigned* p)              { return __hip_atomic_load(p, __ATOMIC_RELAXED, __HIP_MEMORY_SCOPE_AGENT); }
__device__ __forceinline__ unsigned xb_add(unsigned* p, unsigned v) { return __hip_atomic_fetch_add(p, v, __ATOMIC_RELAXED, __HIP_MEMORY_SCOPE_AGENT); }
__device__ __forceinline__ unsigned xb_xcc_id() { return (unsigned)__builtin_amdgcn_s_getreg((3 << 11) | 20) & 0xFu; }
#define XB_SPIN(cond, bar) do { unsigned _sp = 0; while (cond) { __builtin_amdgcn_s_sleep(1); \
    if ((++_sp & 255u) == 0u) { if (xb_ld(&(bar)[XB_TMO])) break; if (_sp > XB_SPIN_CAP) { atomicAdd(&(bar)[XB_TMO], 1u); break; } } } } while (0)

struct XcdBarrier {
    unsigned* bar; unsigned x;
    volatile LAS unsigned* st;
};

__device__ __forceinline__ XcdBarrier xcd_barrier_post(unsigned* bar, volatile LAS unsigned* st) {
    XcdBarrier b; b.bar = bar; b.x = xb_xcc_id(); b.st = st;
    if (threadIdx.x == 0) (void)xb_add(&bar[XB_XCNT(b.x)], 1u);
    return b;
}
__device__ __forceinline__ void xcd_barrier_complete(unsigned* bar, unsigned x, unsigned& nloc, unsigned& nx) {
    const unsigned G = gridDim.x * gridDim.y * gridDim.z;
    unsigned sum, cnt, mine, sp = 0u;
    for (;;) {
        sum = 0u; cnt = 0u; mine = 0u;
#pragma unroll
        for (unsigned j = 0; j < 16; ++j) { const unsigned c = xb_ld(&bar[XB_XCNT(j)]); sum += c; cnt += (c > 0u) ? 1u : 0u; mine = (j == x) ? c : mine; }
        if (sum == G) break;
        __builtin_amdgcn_s_sleep(1);
        if ((++sp & 255u) == 0u) { if (xb_ld(&bar[XB_TMO])) break; if (sp > XB_SPIN_CAP) { atomicAdd(&bar[XB_TMO], 1u); break; } }
    }
    nloc = mine > 0u ? mine : 1u; nx = cnt > 0u ? cnt : 1u;
}

__device__ __forceinline__ void xcd_barrier(const XcdBarrier& b) {
    asm volatile("s_waitcnt vmcnt(0)" ::: "memory");
    __syncthreads();
    if (threadIdx.x == 0) {
        unsigned* bar = b.bar;
        __builtin_amdgcn_s_waitcnt(0);
        unsigned nloc = b.st[0], nx = b.st[1];
        if (nloc == 0u) { xcd_barrier_complete(bar, b.x, nloc, nx); b.st[0] = nloc; b.st[1] = nx; }
        const unsigned old = xb_add(&bar[XB_XSUB(b.x)], 1u);
        const unsigned gen = old / nloc;
        if (old + 1u == (gen + 1u) * nloc) {
            __builtin_amdgcn_fence(__ATOMIC_RELEASE, "agent");
            asm volatile("s_waitcnt vmcnt(0)" ::: "memory");
            const unsigned og = xb_add(&bar[XB_TOP], 1u);
            const unsigned tg = og / nx;
            if (og + 1u == (tg + 1u) * nx) xb_add(&bar[XB_TOPGEN], 1u);
            else XB_SPIN(xb_ld(&bar[XB_TOPGEN]) == tg, bar);
            __builtin_amdgcn_fence(__ATOMIC_ACQUIRE, "agent");
            xb_add(&bar[XB_XGEN(b.x)], 1u);
            asm volatile("s_waitcnt vmcnt(0)" ::: "memory");
        } else {
            XB_SPIN(xb_ld(&bar[XB_XGEN(b.x)]) == gen, bar);
            __builtin_amdgcn_fence(__ATOMIC_ACQUIRE, "agent");
            asm volatile("s_waitcnt vmcnt(0)" ::: "memory");
        }
    }
    __syncthreads();
}

struct Args { const float* in[22]; float* out; unsigned char* ws; int ph_lo, ph_hi, li, pad; };
struct Frame { unsigned char* lds; int tid, lane, wave, vcu, G, gw, NGW; };
typedef const Args __attribute__((address_space(4)))* KArgs;
#define FRESH_ARGS() ({ KArgs p_ = (KArgs)__builtin_amdgcn_kernarg_segment_ptr(); asm volatile("" : "+s"(p_)); p_; })

__device__ __forceinline__ void p0_transpose_item(const float* W, int N, int k0, int n0, bf16* WT, int K, int dst_row0, LAS float* scr, int lane) {
    typedef float f32x4t __attribute__((ext_vector_type(4)));
#pragma unroll
    for (int i = 0; i < 8; ++i) { const int kk = 8 * i + (lane >> 3), nn = (lane & 7) * 4;
        *(LAS f32x4t*)(scr + kk * 36 + nn) = *(const GAS f32x4t*)(W + (size_t)(k0 + kk) * N + n0 + nn); }
    LDS_WAIT(); asm volatile("" ::: "memory");
    const int c = lane & 7;
#pragma unroll
    for (int j = 0; j < 4; ++j) { const int n = (lane >> 3) + 8 * j; const LAS float* s = scr + (8 * c) * 36 + n;
        v4u o; o.x = pk2(s[0 * 36], s[1 * 36]); o.y = pk2(s[2 * 36], s[3 * 36]); o.z = pk2(s[4 * 36], s[5 * 36]); o.w = pk2(s[6 * 36], s[7 * 36]);
        *(GAS v4u*)(WT + (size_t)(dst_row0 + n) * K + k0 + 8 * c) = o; }
    LDS_WAIT(); asm volatile("" ::: "memory");
}
__device__ __forceinline__ void p0_prologue(const Frame& F, KArgs a) {
    unsigned char* ws = a->ws;
    LAS float* scr = (LAS float*)((LAS unsigned char*)F.lds + SCR_OFF + F.wave * 16384);
    constexpr int I_IN = 32 * 144, I_GT = 32 * 128, I_BA = 16 * 64, I_WO = 32 * 64, I_E = 32 * 512;
    constexpr int NITEMS = I_IN + I_GT + 2 * I_BA + I_WO + 3 * I_E;
    for (int it = F.gw; it < NITEMS; it += F.NGW) {
        int r = it;
        if (r < I_IN) { const int kb = r / 144, nb = r % 144; p0_transpose_item(a->in[2], 4608, 64 * kb, 32 * nb, (bf16*)(ws + WS_WIN), 2048, 32 * nb, scr, F.lane); continue; } r -= I_IN;
        if (r < I_GT) { const int kb = r / 128, nb = r % 128; p0_transpose_item(a->in[12], 4096, 64 * kb, 32 * nb, (bf16*)(ws + WS_WIN), 2048, 4608 + 32 * nb, scr, F.lane); continue; } r -= I_GT;
        if (r < I_BA) { const int kb = r / 64, nb = r % 64; p0_transpose_item(a->in[10], 2048, 64 * kb, 32 * nb, (bf16*)(ws + WS_WA), 2048, 32 * nb, scr, F.lane); continue; } r -= I_BA;
        if (r < I_BA) { const int kb = r / 64, nb = r % 64; p0_transpose_item(a->in[11], 2048, 64 * kb, 32 * nb, (bf16*)(ws + WS_WA) + 1024, 2048, 32 * nb, scr, F.lane); continue; } r -= I_BA;
        if (r < I_WO) { const int kb = r / 64, nb = r % 64; p0_transpose_item(a->in[14], 2048, 64 * kb, 32 * nb, (bf16*)(ws + WS_WO), 2048, 32 * nb, scr, F.lane); continue; } r -= I_WO;
        if (r < I_E)  { const int e = r / 512, q = r % 512, kb = q / 16, nb = q % 16, n0 = 32 * nb;
                        p0_transpose_item(a->in[18] + (size_t)e * 2048 * 512, 512, 64 * kb, n0, (bf16*)(ws + WS_W13), 2048, e * 1024 + (n0 >> 7) * 256 + (n0 & 127), scr, F.lane); continue; } r -= I_E;
        if (r < I_E)  { const int e = r / 512, q = r % 512, kb = q / 16, nb = q % 16, n0 = 32 * nb;
                        p0_transpose_item(a->in[19] + (size_t)e * 2048 * 512, 512, 64 * kb, n0, (bf16*)(ws + WS_W13), 2048, e * 1024 + (n0 >> 7) * 256 + 128 + (n0 & 127), scr, F.lane); continue; } r -= I_E;
        { const int e = r / 512, q = r % 512, kb = q / 64, nb = q % 64;
          p0_transpose_item(a->in[20] + (size_t)e * 512 * 2048, 2048, 64 * kb, 32 * nb, (bf16*)(ws + WS_W2), 512, e * 2048 + 32 * nb, scr, F.lane); }
    }
    { float2* tab = (float2*)(ws + WS_ROPE);
      for (int idx = F.gw * 64 + F.lane; idx < SEQ * 32; idx += F.NGW * 64) { const int pos = idx >> 5, i = idx & 31;
          const float inv = powf(10000.0f, -(float)(2 * i) / 64.0f); const float ang = (float)pos * inv;
          double s, c; sincos((double)ang, &s, &c); tab[idx] = make_float2((float)c, (float)s); } }
    { bf16* wh = (bf16*)(ws + WS_WRT); bf16* wl = wh + 48 * 2048;
      for (int idx = F.gw * 64 + F.lane; idx < 48 * 2048; idx += F.NGW * 64) { const int c = idx >> 11, k = idx & 2047;
          const float v = c < 4 ? a->in[16][k * 4 + c] : (c < 36 ? a->in[17][k * 32 + (c - 4)] : 0.f);
          const unsigned h = f2bf(v); const float hf = __uint_as_float(h << 16); wh[idx] = (bf16)h; wl[idx] = (bf16)f2bf(v - hf); } }
    { const float* x = a->in[0]; const GAS f32x4* g4 = (const GAS f32x4*)a->in[1] + F.lane; bf16* XN = (bf16*)(ws + WS_XN);
      for (int m = F.gw; m < T; m += F.NGW) {
          const GAS f32x4* xr = (const GAS f32x4*)(x + (size_t)m * DM) + F.lane; f32x4 v[8]; float s = 0.f;
#pragma unroll
          for (int j = 0; j < 8; ++j) { v[j] = xr[64 * j]; s += (v[j].x * v[j].x + v[j].y * v[j].y) + (v[j].z * v[j].z + v[j].w * v[j].w); }
          const float rstd = 1.0f / sqrtf(wave_sum(s) * (1.0f / DM) + EPS);
          GAS v2u* o8 = (GAS v2u*)(XN + (size_t)m * DM) + F.lane;
#pragma unroll
          for (int j = 0; j < 8; ++j) { const f32x4 g = g4[64 * j]; v2u w; w.x = pk2(v[j].x * rstd * g.x, v[j].y * rstd * g.y); w.y = pk2(v[j].z * rstd * g.z, v[j].w * rstd * g.w); o8[64 * j] = w; } } }
}

__device__ __forceinline__ void rope8(float (&v)[8], const float2* tab, int pos, int cc) {
    const GAS f32x4* tp = (const GAS f32x4*)(tab + (size_t)pos * 32 + 8 * (cc & 3));
    const f32x4 t0 = tp[0], t1 = tp[1], t2 = tp[2], t3 = tp[3];
    const float cs[8] = {t0.x, t0.z, t1.x, t1.z, t2.x, t2.z, t3.x, t3.z}, sn[8] = {t0.y, t0.w, t1.y, t1.w, t2.y, t2.w, t3.y, t3.w};
    const float sg = (cc & 4) ? 1.f : -1.f;
#pragma unroll
    for (int e = 0; e < 8; ++e) { const float p = __shfl_xor(v[e], 4); v[e] = v[e] * cs[e] + sg * p * sn[e]; }
}
__device__ __forceinline__ void unpack8(const v4u w, float (&v)[8]) { v[0] = bflo(w.x); v[1] = bfhi(w.x); v[2] = bflo(w.y); v[3] = bfhi(w.y); v[4] = bflo(w.z); v[5] = bfhi(w.z); v[6] = bflo(w.w); v[7] = bfhi(w.w); }
__device__ __forceinline__ v4u pack8(const float (&v)[8]) { v4u w; w.x = pk2(v[0], v[1]); w.y = pk2(v[2], v[3]); w.z = pk2(v[4], v[5]); w.w = pk2(v[6], v[7]); return w; }
__device__ __forceinline__ void p1b_normrope(const Frame& F, KArgs a) {
    unsigned char* ws = a->ws; const float2* tab = (const float2*)(ws + WS_ROPE);
    bf16* KA = (bf16*)(ws + WS_KA); bf16* KB = (bf16*)(ws + WS_KB);
    const float* kg = a->in[4];
    const int cc16 = F.lane & 15;
    float gk[8];
#pragma unroll
    for (int e = 0; e < 8; ++e) gk[e] = kg[cc16 * 8 + e];
    for (int tA = F.gw; tA < T; tA += 2 * F.NGW) {
        const int tB = (tA + F.NGW < T) ? tA + F.NGW : tA;
        v4u raw[2][3];
#pragma unroll
        for (int u = 0; u < 2; ++u) { const int t = u ? tB : tA;
            raw[u][0] = *(const GAS v4u*)(KA + (size_t)t * 256 + (F.lane & 31) * 8);
            raw[u][1] = *(const GAS v4u*)(KB + (size_t)t * 1024 + F.lane * 8); raw[u][2] = *(const GAS v4u*)(KB + (size_t)t * 1024 + (F.lane + 64) * 8); }
#pragma unroll
        for (int u = 0; u < 2; ++u) { const int t = u ? tB : tA;
            if (u == 1 && tB == tA) break;
            const int s = t & (SEQ - 1), prow = s >> 6, pcol = s & 63;
            const int posA = (cc16 < 8) ? prow : pcol;
            {
                bf16* p = KA + (size_t)t * 256 + (F.lane & 31) * 8;
                float v[8]; unpack8(raw[u][0], v);
                float ss = 0.f;
#pragma unroll
                for (int e = 0; e < 8; ++e) ss += v[e] * v[e];
                ss += __shfl_xor(ss, 1); ss += __shfl_xor(ss, 2); ss += __shfl_xor(ss, 4); ss += __shfl_xor(ss, 8);
                const float rstd = 1.0f / sqrtf(ss * (1.0f / 128.0f) + EPS);
#pragma unroll
                for (int e = 0; e < 8; ++e) v[e] = v[e] * rstd * gk[e];
                rope8(v, tab, posA, cc16 & 7);
                if (F.lane < 32) *(GAS v4u*)p = pack8(v);
            }
#pragma unroll
            for (int j = 0; j < 2; ++j) {
                bf16* p = KB + (size_t)t * 1024 + (F.lane + 64 * j) * 8;
                float v[8]; unpack8(raw[u][1 + j], v);
                rope8(v, tab, s, F.lane & 7);
                *(GAS v4u*)p = pack8(v);
            }
        }
    }
}

template <int ABL = 0> __device__ __forceinline__ void attn_unit_A(const Frame& F, KArgs a, int b, int h, int qb, att::bf16* Obase) {
    using namespace att;
    int tid_ = threadIdx.x; asm volatile("" : "+v"(tid_));
    const int lane_ = tid_ & 63, wave_ = __builtin_amdgcn_readfirstlane(tid_ >> 6);
    unsigned char* ws = a->ws; char* lds = (char*)F.lds + SCR_OFF; float* wsf = (float*)((char*)F.lds + AWS_OFF) + wave_ * 64;
    const int r32 = lane_ & 31, hi = lane_ >> 5, kvh = h >> 2;
    const att::bf16* Qb = (const att::bf16*)(ws + WS_QA) + ((size_t)b * SEQ + (size_t)qb * 256) * 1024 + h * 128;
    const att::bf16* Kh = (const att::bf16*)(ws + WS_KA) + (size_t)b * SEQ * 256 + kvh * 128;
    const att::bf16* Vh = (const att::bf16*)(ws + WS_VA) + (size_t)b * SEQ * 256 + kvh * 128;
    f32x16 o[4]; float rli[16];
    attn_pass<128, 1024, 256, 256, ABL>(Qb, Kh, Vh, SEQ, lds, wsf, o, rli, (const float*)(ws + WS_ROPE), a->in[3], qb * 256);
    att::bf16* Ow = Obase + ((size_t)b * SEQ + (size_t)qb * 256 + wave_ * 32) * 2048 + h * 128;
#pragma unroll
    for (int r = 0; r < 16; ++r) { const int orow = crow(r, hi);
#pragma unroll
        for (int d0 = 0; d0 < 4; ++d0) Ow[(size_t)orow * 2048 + d0 * 32 + r32] = (att::bf16)f2bf(o[d0][r] * rli[r]); }
}
template <int ABL = 0> __device__ __forceinline__ void attn_unit_B(const Frame& F, KArgs a, int b, int h, int qb, float lam, att::bf16* Obase) {
    using namespace att;
    int tid_ = threadIdx.x; asm volatile("" : "+v"(tid_));
    const int lane_ = tid_ & 63, wave_ = __builtin_amdgcn_readfirstlane(tid_ >> 6);
    unsigned char* ws = a->ws; char* lds = (char*)F.lds + SCR_OFF; float* wsf = (float*)((char*)F.lds + AWS_OFF) + wave_ * 64;
    unsigned* stash = (unsigned*)(lds + OFF_STASH) + wave_ * 2048;
    const int r32 = lane_ & 31, hi = lane_ >> 5;
    const att::bf16* Qb = (const att::bf16*)(ws + WS_QB) + ((size_t)b * SEQ + (size_t)qb * 256) * 1024 + h * 128;
    const att::bf16* Kh = (const att::bf16*)(ws + WS_KB) + (size_t)b * SEQ * 1024 + h * 128;
    const att::bf16* Vh = (const att::bf16*)(ws + WS_VB) + (size_t)b * SEQ * 1024 + h * 128;
    f32x16 o[4]; float rli[16];
    attn_pass<64, 1024, 1024, 1024, ABL>(Qb, Kh, Vh, SEQ, lds, wsf, o, rli, (const float*)(ws + WS_ROPE), nullptr, qb * 256);
#pragma unroll
    for (int d0 = 0; d0 < 4; ++d0)
#pragma unroll
        for (int r = 0; r < 16; r += 2) stash[(d0 * 8 + (r >> 1)) * 64 + lane_] = att::cvtpk(o[d0][r] * rli[r], o[d0][r + 1] * rli[r + 1]);
    attn_pass<64, 1024, 1024, 1024, ABL>(Qb + 64, Kh + 64, Vh, SEQ, lds, wsf, o, rli, (const float*)(ws + WS_ROPE), nullptr, qb * 256);
    asm volatile("s_waitcnt lgkmcnt(0)" ::: "memory");
    float ss[16];
#pragma unroll
    for (int r = 0; r < 16; ++r) ss[r] = 0.f;
#pragma unroll
    for (int d0 = 0; d0 < 4; ++d0)
#pragma unroll
        for (int r = 0; r < 16; r += 2) { const unsigned w = stash[(d0 * 8 + (r >> 1)) * 64 + lane_];
            const float x0 = bflo(w) - lam * (o[d0][r] * rli[r]), x1 = bfhi(w) - lam * (o[d0][r + 1] * rli[r + 1]);
            o[d0][r] = x0; o[d0][r + 1] = x1; ss[r] += x0 * x0; ss[r + 1] += x1 * x1; }
#pragma unroll
    for (int r = 0; r < 16; ++r) { float s = ss[r]; s += __shfl_xor(s, 1); s += __shfl_xor(s, 2); s += __shfl_xor(s, 4); s += __shfl_xor(s, 8); s += __shfl_xor(s, 16);
        ss[r] = (1.0f - LAM_INIT) / sqrtf(s * (1.0f / 128.0f) + EPS); }
    const float* sg = a->in[9]; float g4[4];
#pragma unroll
    for (int d0 = 0; d0 < 4; ++d0) g4[d0] = sg[d0 * 32 + r32];
    att::bf16* Ow = Obase + ((size_t)b * SEQ + (size_t)qb * 256 + wave_ * 32) * 2048 + 1024 + h * 128;
#pragma unroll
    for (int r = 0; r < 16; ++r) { const int orow = crow(r, hi);
#pragma unroll
        for (int d0 = 0; d0 < 4; ++d0) Ow[(size_t)orow * 2048 + d0 * 32 + r32] = (att::bf16)f2bf(o[d0][r] * ss[r] * g4[d0]); }
}
__device__ __forceinline__ void p2_attention(const Frame& F, KArgs a) {
    const float lam = __uint_as_float(__builtin_amdgcn_readfirstlane(__float_as_uint(expf(wave_sum(a->in[5][F.lane] * a->in[6][F.lane])) - expf(wave_sum(a->in[7][F.lane] * a->in[8][F.lane])) + LAM_INIT)));
#if ATT_DUMMY >= 0
#if ATT_DUMMY_B
    for (int L = F.vcu; L < 1024; L += F.G) { const int i = L >> 8, v = L & 255, x = v >> 5, qb = v & 31, b = x >> 1; attn_unit_B<ATT_DUMMY>(F, a, b, 4 * (x & 1) + i, qb, lam, (att::bf16*)a->out); }
#else
    for (int L = F.vcu; L < 1024; L += F.G) { const int i = L >> 8, v = L & 255, x = v >> 5, qb = v & 31, b = x >> 1; attn_unit_A<ATT_DUMMY>(F, a, b, 4 * (x & 1) + i, qb, (att::bf16*)a->out); }
#endif
#endif
    for (int L = F.vcu; L < 2048; L += F.G) {
#if PROBE_MASK
        if (L >> 8 == 4 && blockIdx.x == PROBE_BLOCK && F.tid == 0) { volatile LAS unsigned* M_ = (volatile LAS unsigned*)((LAS unsigned char*)F.lds + MISC_OFF); M_[21] = (unsigned)__builtin_amdgcn_s_memrealtime() - M_[20]; }
#endif
        const int i = L >> 8, v = L & 255, x = v >> 5, qb = v & 31, b = x >> 1;
#ifndef ATT_SKIP_A
        if (i < 4) attn_unit_A(F, a, b, 4 * (x & 1) + i, qb, (att::bf16*)(a->ws + WS_XN));
#endif
#ifndef ATT_SKIP_B
        if (i >= 4) attn_unit_B(F, a, b, 4 * (x & 1) + (i - 4), qb, lam, (att::bf16*)(a->ws + WS_XN));
#endif
    }
}

__device__ __forceinline__ void moe_table(const Frame& F, KArgs a) {
    LAS int* tab = (LAS int*)((LAS unsigned char*)F.lds + MOE_OFF);
    if (F.tid == 0) { const gu32* cnt = (const gu32*)(a->ws + WS_CTL) + CW_CNT; int acc = 0;
        for (int e = 0; e < NEXP; ++e) { const int c = (int)__hip_atomic_load(cnt + e, RLX_AGENT); tab[e] = c; tab[32 + e] = acc; acc += (c + 255) >> 8; }
        tab[64] = acc; }
    __syncthreads();
}

__device__ __forceinline__ void p4_router(const Frame& F, KArgs a) {
    typedef float f32x4v __attribute__((ext_vector_type(4)));
    unsigned char* ws = a->ws; const float* X1 = a->out; const float* SSQ = (const float*)(ws + WS_SSQ); const float* gf = a->in[15];
    bf16* H2 = (bf16*)(ws + WS_GT); const bf16* wh = (const bf16*)(ws + WS_WRT);
    gu32* cnt = (gu32*)(ws + WS_CTL) + CW_CNT; int* LENT = (int*)(ws + WS_LENT); float* LW = (float*)(ws + WS_LW); int* TOKES = (int*)(ws + WS_TOKROW);
    LAS float* LG = (LAS float*)((LAS unsigned char*)F.lds + SCR_OFF) + F.wave * (16 * 48);
    LAS int* lcnt = (LAS int*)((LAS unsigned char*)F.lds + SCR_OFF + 32768);
    const int row = F.lane & 15, kq = F.lane >> 4;
    const int NTASK = T / 16, rounds = (NTASK + F.NGW - 1) / F.NGW;
    for (int it = 0; it < rounds; ++it) {
        const int task = it * F.NGW + F.gw; const bool valid = task < NTASK; const int t0 = valid ? task * 16 : 0;
        if (F.tid < 64) lcnt[F.tid] = 0;
        __syncthreads();
        int e0 = 0, e1 = 0, r0 = 0, r1 = 0; float w0 = 0.f, w1 = 0.f;
        {
            const GAS f32x4v* sp = (const GAS f32x4v*)(SSQ + (size_t)(t0 + row) * 32); float s = 0.f;
#pragma unroll
            for (int j = 0; j < 8; ++j) { const f32x4v q = sp[j]; s += (q.x + q.y) + (q.z + q.w); }
            const float rstd = 1.0f / sqrtf(s * (1.0f / DM) + EPS);
            f32x4v acc[3] = {{0.f, 0.f, 0.f, 0.f}, {0.f, 0.f, 0.f, 0.f}, {0.f, 0.f, 0.f, 0.f}};
            const float* xrow = X1 + (size_t)(t0 + row) * DM + 8 * kq; bf16* hrow = H2 + (size_t)(t0 + row) * DM + 8 * kq;
            f32x4v xw[8][2];
#pragma unroll
            for (int i = 0; i < 8; ++i) { xw[i][0] = *(const GAS f32x4v*)(xrow + 32 * i); xw[i][1] = *(const GAS f32x4v*)(xrow + 32 * i + 4); }
            LAS unsigned char* RB = (LAS unsigned char*)F.lds + SCR_OFF + 36864;
            for (int c = 0; c < 4; ++c) {
                __syncthreads();
#pragma unroll
                for (int i = 0; i < 12; ++i) { const int idx = F.tid + 512 * i, arr = idx / 3072, rr = (idx % 3072) >> 6, seg = idx & 63;
                    *(LAS v4u*)(RB + arr * 49920 + rr * 1040 + seg * 16) = *(const GAS v4u*)(wh + (size_t)arr * 48 * 2048 + (size_t)rr * 2048 + c * 512 + seg * 8); }
                __syncthreads();
                const LAS unsigned char* rbh = RB + row * 1040 + kq * 16;
#pragma unroll 8
                for (int ksl = 0; ksl < 16; ++ksl) { const int ks = c * 16 + ksl;
                const f32x4v x0 = xw[ksl & 7][0], x1 = xw[ksl & 7][1];
                { const int kn = (ks + 8 < 64) ? ks + 8 : ks; xw[ksl & 7][0] = *(const GAS f32x4v*)(xrow + 32 * kn); xw[ksl & 7][1] = *(const GAS f32x4v*)(xrow + 32 * kn + 4); }
                const f32x4v g0 = *(const GAS f32x4v*)(gf + 32 * ks + 8 * kq), g1 = *(const GAS f32x4v*)(gf + 32 * ks + 8 * kq + 4);
                float h[8] = {x0.x * rstd * g0.x, x0.y * rstd * g0.y, x0.z * rstd * g0.z, x0.w * rstd * g0.w, x1.x * rstd * g1.x, x1.y * rstd * g1.y, x1.z * rstd * g1.z, x1.w * rstd * g1.w};
                unsigned hh[8], hl[8];
#pragma unroll
                for (int e = 0; e < 8; ++e) { hh[e] = f2bf(h[e]); hl[e] = f2bf(h[e] - __uint_as_float(hh[e] << 16)); }
                v4u ah, al; ah.x = hh[0] | (hh[1] << 16); ah.y = hh[2] | (hh[3] << 16); ah.z = hh[4] | (hh[5] << 16); ah.w = hh[6] | (hh[7] << 16);
                al.x = hl[0] | (hl[1] << 16); al.y = hl[2] | (hl[3] << 16); al.z = hl[4] | (hl[5] << 16); al.w = hl[6] | (hl[7] << 16);
                if (valid) *(GAS v4u*)(hrow + 32 * ks) = ah;
                const bf16x8 Ah = __builtin_bit_cast(bf16x8, ah), Al = __builtin_bit_cast(bf16x8, al);
#pragma unroll
                for (int blk = 0; blk < 3; ++blk) {
                    const bf16x8 Bh = *(const LAS bf16x8*)(rbh + blk * 16 * 1040 + ksl * 64), Bl = *(const LAS bf16x8*)(rbh + 49920 + blk * 16 * 1040 + ksl * 64);
                    acc[blk] = __builtin_amdgcn_mfma_f32_16x16x32_bf16(Ah, Bh, acc[blk], 0, 0, 0);
                    acc[blk] = __builtin_amdgcn_mfma_f32_16x16x32_bf16(Al, Bh, acc[blk], 0, 0, 0);
                    acc[blk] = __builtin_amdgcn_mfma_f32_16x16x32_bf16(Ah, Bl, acc[blk], 0, 0, 0);
                }
                }
            }
#pragma unroll
            for (int blk = 0; blk < 3; ++blk)
#pragma unroll
                for (int i = 0; i < 4; ++i) LG[(4 * kq + i) * 48 + 16 * blk + row] = acc[blk][i];
            LDS_WAIT();
            if (F.lane < 16) {
                const LAS float* lg = LG + F.lane * 48;
                float gl[4];
#pragma unroll
                for (int i = 0; i < 4; ++i) gl[i] = lg[i];
                int gi = 0; float gm = gl[0];
#pragma unroll
                for (int i = 1; i < 4; ++i) if (gl[i] > gm) { gm = gl[i]; gi = i; }
                float gs = 0.f;
#pragma unroll
                for (int i = 0; i < 4; ++i) gs += expf(gl[i] - gm);
                const float gw_ = 1.0f / gs;
                const LAS float* el = lg + 4 + gi * 8;
                float ev[8];
#pragma unroll
                for (int i = 0; i < 8; ++i) ev[i] = el[i];
                int i0 = 0; float v0 = ev[0];
#pragma unroll
                for (int i = 1; i < 8; ++i) if (ev[i] > v0) { v0 = ev[i]; i0 = i; }
                int i1 = -1; float v1 = -3.0e38f;
#pragma unroll
                for (int i = 0; i < 8; ++i) if (i != i0 && ev[i] > v1) { v1 = ev[i]; i1 = i; }
                const float ex = expf(v1 - v0), den = 1.0f / (1.0f + ex);
                w0 = den * gw_; w1 = ex * den * gw_; e0 = gi * 8 + i0; e1 = gi * 8 + i1;
                if (valid) { r0 = atomicAdd((int*)&lcnt[e0], 1); r1 = atomicAdd((int*)&lcnt[e1], 1); }
            }
        }
        __syncthreads();
        if (F.tid < 32) { const int c = lcnt[F.tid]; lcnt[32 + F.tid] = c ? (int)__hip_atomic_fetch_add(cnt + F.tid, (unsigned)c, RLX_AGENT) : 0; }
        __syncthreads();
        if (valid && F.lane < 16) { const int tok = t0 + F.lane;
            const int s0 = lcnt[32 + e0] + r0, s1 = lcnt[32 + e1] + r1;
            LENT[(size_t)e0 * LCAP + s0] = tok * 2; LW[(size_t)e0 * LCAP + s0] = w0; TOKES[2 * tok] = (e0 << 16) | s0;
            LENT[(size_t)e1 * LCAP + s1] = tok * 2 + 1; LW[(size_t)e1 * LCAP + s1] = w1; TOKES[2 * tok + 1] = (e1 << 16) | s1; }
        __syncthreads();
    }
}

__device__ __forceinline__ void p6_final(const Frame& F, KArgs a) {
    unsigned char* ws = a->ws; const bf16* YC = (const bf16*)(ws + WS_YC); const int* TOKES = (const int*)(ws + WS_TOKROW); const LAS int* tab = (const LAS int*)((LAS unsigned char*)F.lds + MOE_OFF);
    const GAS f32x4* g4 = (const GAS f32x4*)a->in[21] + F.lane;
    for (int t0 = F.gw; t0 < T; t0 += 2 * F.NGW) {
        const int t1 = (t0 + F.NGW < T) ? t0 + F.NGW : t0;
        const int ea0 = TOKES[2 * t0], ea1 = TOKES[2 * t0 + 1], eb0 = TOKES[2 * t1], eb1 = TOKES[2 * t1 + 1];
        GAS f32x4* xa = (GAS f32x4*)(a->out + (size_t)t0 * DM) + F.lane; GAS f32x4* xb = (GAS f32x4*)(a->out + (size_t)t1 * DM) + F.lane;
        f32x4 va[8], vb[8];
#pragma unroll
        for (int j = 0; j < 8; ++j) { va[j] = xa[64 * j]; vb[j] = xb[64 * j]; }
        const GAS v2u* ya0 = (const GAS v2u*)(YC + (size_t)(tab[32 + (ea0 >> 16)] * 256 + (ea0 & 0xffff)) * DM) + F.lane; const GAS v2u* ya1 = (const GAS v2u*)(YC + (size_t)(tab[32 + (ea1 >> 16)] * 256 + (ea1 & 0xffff)) * DM) + F.lane;
        const GAS v2u* yb0 = (const GAS v2u*)(YC + (size_t)(tab[32 + (eb0 >> 16)] * 256 + (eb0 & 0xffff)) * DM) + F.lane; const GAS v2u* yb1 = (const GAS v2u*)(YC + (size_t)(tab[32 + (eb1 >> 16)] * 256 + (eb1 & 0xffff)) * DM) + F.lane;
        v2u pa[8], qa[8], pb[8], qb[8];
#pragma unroll
        for (int j = 0; j < 8; ++j) { pa[j] = ya0[64 * j]; qa[j] = ya1[64 * j]; pb[j] = yb0[64 * j]; qb[j] = yb1[64 * j]; }
        float sa = 0.f, sb = 0.f;
#pragma unroll
        for (int j = 0; j < 8; ++j) {
            va[j].x += bflo(pa[j].x) + bflo(qa[j].x); va[j].y += bfhi(pa[j].x) + bfhi(qa[j].x); va[j].z += bflo(pa[j].y) + bflo(qa[j].y); va[j].w += bfhi(pa[j].y) + bfhi(qa[j].y);
            vb[j].x += bflo(pb[j].x) + bflo(qb[j].x); vb[j].y += bfhi(pb[j].x) + bfhi(qb[j].x); vb[j].z += bflo(pb[j].y) + bflo(qb[j].y); vb[j].w += bfhi(pb[j].y) + bfhi(qb[j].y);
            sa += (va[j].x * va[j].x + va[j].y * va[j].y) + (va[j].z * va[j].z + va[j].w * va[j].w); sb += (vb[j].x * vb[j].x + vb[j].y * vb[j].y) + (vb[j].z * vb[j].z + vb[j].w * vb[j].w); }
        const float ra = 1.0f / sqrtf(wave_sum(sa) * (1.0f / DM) + EPS), rb = 1.0f / sqrtf(wave_sum(sb) * (1.0f / DM) + EPS);
#pragma unroll
        for (int j = 0; j < 8; ++j) { const f32x4 g = g4[64 * j]; xa[64 * j] = (f32x4){va[j].x * ra * g.x, va[j].y * ra * g.y, va[j].z * ra * g.z, va[j].w * ra * g.w};
            if (t1 != t0) xb[64 * j] = (f32x4){vb[j].x * rb * g.x, vb[j].y * rb * g.y, vb[j].z * rb * g.z, vb[j].w * rb * g.w}; }
    }
}

__global__ void __launch_bounds__(NWAVES * 64, 2) fwd_kernel(Args args) {
    extern __shared__ __attribute__((aligned(16))) unsigned char lds[];
    Frame F;
    F.lds = lds; F.tid = threadIdx.x; F.lane = F.tid & 63; F.wave = __builtin_amdgcn_readfirstlane(F.tid >> 6);
    F.G = gridDim.x; { const int bx = blockIdx.x; F.vcu = (F.G % 8 == 0) ? (bx % 8) * (F.G / 8) + bx / 8 : bx; }
    F.gw = F.vcu * NWAVES + F.wave; F.NGW = F.G * NWAVES;
    LAS unsigned char* L = (LAS unsigned char*)lds;
    volatile LAS unsigned* MISC = (volatile LAS unsigned*)(L + MISC_OFF);
    for (int u = F.tid; u < (LDS_BYTES - MISC_OFF) / 4; u += NWAVES * 64) ((LAS unsigned*)(L + MISC_OFF))[u] = 0u;
    __syncthreads();
    int lo, hi, li; unsigned* ctl;
    { KArgs a = FRESH_ARGS(); lo = a->ph_lo; hi = a->ph_hi; li = a->li; ctl = (unsigned*)(a->ws + WS_CTL); }
    XcdBarrier bar; bar.bar = ctl + CW_BAR + li * XCD_BAR_WORDS; bar.x = 0; bar.st = nullptr;
    if (hi - lo > 1) bar = xcd_barrier_post(ctl + CW_BAR + li * XCD_BAR_WORDS, MISC + 8);
#ifndef PH_MASK
#define PH_MASK 0x3ff
#endif
#define IN(k) (((PH_MASK >> (k)) & 1) && lo <= (k) && (k) < hi)
#if PROBE_MASK
    if (blockIdx.x == PROBE_BLOCK && F.tid == 0) MISC[20] = (unsigned)__builtin_amdgcn_s_memrealtime();
#define STAMP(k) do { if (blockIdx.x == PROBE_BLOCK && F.tid == 0) { const unsigned now_ = (unsigned)__builtin_amdgcn_s_memrealtime(); MISC[10 + (k)] = now_ - MISC[20]; MISC[20] = now_; } } while (0)
#else
#define STAMP(k) do { } while (0)
#endif
#if PROBE_MASK
#define SEAM(k) do { if (IN(k) && IN((k) + 1)) { unsigned tb_ = 0; if (blockIdx.x == PROBE_BLOCK && F.tid == 0) tb_ = (unsigned)__builtin_amdgcn_s_memrealtime(); xcd_barrier(bar); \
    if (blockIdx.x == PROBE_BLOCK && F.tid == 0) { const unsigned dw_ = (unsigned)__builtin_amdgcn_s_memrealtime() - tb_; MISC[22] += dw_; MISC[23 + (k)] = dw_; } STAMP(k); } } while (0)
#else
#define SEAM(k) do { if (IN(k) && IN((k) + 1)) { xcd_barrier(bar); STAMP(k); } } while (0)
#endif

    if (IN(0)) { KArgs a = FRESH_ARGS(); p0_prologue(F, a); } SEAM(0);

    if (IN(1)) {
        KArgs a = FRESH_ARGS(); unsigned char* ws = a->ws;
        pg8::Gemm g{(const pg8::bf16_t*)(ws + WS_XN), (const pg8::bf16_t*)(ws + WS_WIN), T, NCOL1, DM}; pg8::StaticOrder S; S.init(T, NCOL1, F.G, (int)blockIdx.x);
        pg8::EpiP1 E{(pg8::bf16_t*)(ws + WS_QA), (pg8::bf16_t*)(ws + WS_KA), (pg8::bf16_t*)(ws + WS_VA), (pg8::bf16_t*)(ws + WS_QB), (pg8::bf16_t*)(ws + WS_KB), (pg8::bf16_t*)(ws + WS_VB), (pg8::bf16_t*)(ws + WS_GT), a->in[13]};
        pg8::gemm_phase<pg8::EpiP1, pg8::StaticOrder, true, true>(L + SCR_OFF, g, S, E);
    } SEAM(1);

    if (IN(2)) { KArgs a = FRESH_ARGS(); p1b_normrope(F, a); } SEAM(2);

    if (IN(3)) { KArgs a = FRESH_ARGS(); p2_attention(F, a); } SEAM(3);

    if (IN(4)) {
        KArgs a = FRESH_ARGS(); unsigned char* ws = a->ws;
        pg8::Gemm g{(const pg8::bf16_t*)(ws + WS_XN), (const pg8::bf16_t*)(ws + WS_WA), T, DM, DM}; pg8::StaticOrder S; S.init(T, DM, F.G, (int)blockIdx.x);
        pg8::EpiMerge E{(const pg8::bf16_t*)(ws + WS_GT), (pg8::bf16_t*)(ws + WS_KB)};
        pg8::gemm_phase<pg8::EpiMerge, pg8::StaticOrder, true, true>(L + SCR_OFF, g, S, E);
    } SEAM(4);

    if (IN(5)) {
        KArgs a = FRESH_ARGS(); unsigned char* ws = a->ws;
        pg8::Gemm g{(const pg8::bf16_t*)(ws + WS_KB), (const pg8::bf16_t*)(ws + WS_WO), T, DM, DM}; pg8::StaticOrder S; S.init(T, DM, F.G, (int)blockIdx.x);
        pg8::EpiOut E{a->in[0], a->out, (float*)(ws + WS_SSQ)};
        pg8::gemm_phase<pg8::EpiOut, pg8::StaticOrder, true, true>(L + SCR_OFF, g, S, E);
    } SEAM(5);

    if (IN(6)) { KArgs a = FRESH_ARGS(); p4_router(F, a); } SEAM(6);

    if (IN(7)) {
        KArgs a = FRESH_ARGS(); unsigned char* ws = a->ws;
        moe_table(F, a);
        typedef pg8::MoeOrder<4, (long)1024 * 2048 * 2, true> Ord;
        pg8::Gemm g{(const pg8::bf16_t*)(ws + WS_GT), (const pg8::bf16_t*)(ws + WS_W13), T, 1024, DM};
        Ord S{(const LAS int*)(L + MOE_OFF), F.G, (int)blockIdx.x, (const int*)(ws + WS_LENT)};
        pg8::EpiG1 E{(pg8::bf16_t*)(ws + WS_XN)};
        pg8::gemm_phase<pg8::EpiG1, Ord, true, true>(L + SCR_OFF, g, S, E);
    } SEAM(7);

    if (IN(8)) {
        KArgs a = FRESH_ARGS(); unsigned char* ws = a->ws;
        moe_table(F, a);
        typedef pg8::MoeOrder<8, (long)2048 * 512 * 2, false> Ord;
        pg8::Gemm g{(const pg8::bf16_t*)(ws + WS_XN), (const pg8::bf16_t*)(ws + WS_W2), PMAX * 256, DM, FF};
        Ord S{(const LAS int*)(L + MOE_OFF), F.G, (int)blockIdx.x, (const int*)(ws + WS_LENT)};
        pg8::EpiG2 E{(pg8::bf16_t*)(ws + WS_YC), (const float*)(ws + WS_LW), (const LAS int*)(L + MOE_OFF)};
        pg8::gemm_phase<pg8::EpiG2, Ord, true, true>(L + SCR_OFF, g, S, E);
    } SEAM(8);

    if (IN(9)) { KArgs a = FRESH_ARGS(); moe_table(F, a); p6_final(F, a); }
#if PROBE_MASK
    if (blockIdx.x == PROBE_BLOCK && F.tid == 0) { unsigned tot = 0;
        for (int k = 0; k < 22; ++k) if ((PROBE_MASK >> k) & 1) tot += MISC[10 + k];
        const unsigned long long t0 = __builtin_amdgcn_s_memrealtime(), span = (unsigned long long)tot * PROBE_MUL;
        while (__builtin_amdgcn_s_memrealtime() - t0 < span) __builtin_amdgcn_s_sleep(8); }
#endif
#undef IN
#undef SEAM
}

extern "C" void kernel_launch(void* const* d_in, const int* in_sizes, int n_in, void* d_out, int out_size, void* d_ws, size_t ws_size, hipStream_t stream) {
    static int grid = 0;
    if (grid == 0) {
        if (n_in != 22 || in_sizes[0] != T * DM || out_size != T * DM || ws_size < WS_END) { fprintf(stderr, "kernel_launch: shape mismatch (n_in %d, in0 %d, out %d, ws %zu)\n", n_in, n_in > 0 ? in_sizes[0] : -1, out_size, ws_size); grid = -1; return; }
        int dev = 0, cus = 0, per_cu = 0;
        if (hipGetDevice(&dev) != hipSuccess || hipDeviceGetAttribute(&cus, hipDeviceAttributeMultiprocessorCount, dev) != hipSuccess) { grid = -1; return; }
        if (hipFuncSetAttribute((const void*)fwd_kernel, hipFuncAttributeMaxDynamicSharedMemorySize, LDS_BYTES) != hipSuccess) { fprintf(stderr, "kernel_launch: hipFuncSetAttribute failed\n"); grid = -1; return; }
        if (hipOccupancyMaxActiveBlocksPerMultiprocessor(&per_cu, (const void*)fwd_kernel, NWAVES * 64, LDS_BYTES) != hipSuccess || per_cu < 1) fprintf(stderr, "kernel_launch: occupancy query says %d\n", per_cu);
        (void)hipGetLastError();
        grid = cus;
    }
    if (grid < 0) return;
    if (hipMemsetAsync((char*)d_ws + WS_CTL, 0, CTL_ZERO_BYTES, stream) != hipSuccess) return;
    Args a{};
    for (int i = 0; i < 22; ++i) a.in[i] = (const float*)d_in[i];
    a.out = (float*)d_out; a.ws = (unsigned char*)d_ws; a.pad = 0;
#if MK_ONE_LAUNCH
    a.ph_lo = 0; a.ph_hi = N_PHASES; a.li = 0;
    hipLaunchKernelGGL(fwd_kernel, dim3(grid), dim3(NWAVES * 64), LDS_BYTES, stream, a);
#else
    for (int li = 0; li < N_PHASES; ++li) { a.ph_lo = li; a.ph_hi = li + 1; a.li = li;
        hipLaunchKernelGGL(fwd_kernel, dim3(grid), dim3(NWAVES * 64), LDS_BYTES, stream, a); }
#endif
    const hipError_t le = hipPeekAtLastError();
    if (le != hipSuccess) fprintf(stderr, "kernel_launch: launch failed: %s\n", hipGetErrorName(le));
}
```

```cpp
#include <hip/hip_runtime.h>
#include <cstdio>
#include <cstdint>
#include <cmath>

namespace pg8 {
#define PG8_LAS __attribute__((address_space(3)))
typedef unsigned short bf16_t;
typedef short bf16x8 __attribute__((ext_vector_type(8)));
typedef float f32x4 __attribute__((ext_vector_type(4)));
typedef unsigned u32x4 __attribute__((ext_vector_type(4)));
constexpr int BM = 256, BK = 64, HALF = 128, HTB = HALF * BK * 2  , STAGE_BYTES = 8 * HTB, NXCD = 8, WGM = 8;

__host__ __device__ __forceinline__ int lds_byte(int r, int c) { const int st = (r >> 4) * 2 + (c >> 5), rr = r & 15, cc = c & 31, ob = rr * 64 + cc * 2; return st * 1024 + (ob ^ (((ob >> 9) & 1) << 5)); }
__host__ __device__ __forceinline__ void stage_rc(int b, int& R, int& C) { const int st = b / 1024, sb = b % 1024, swz = sb ^ (((sb >> 9) & 1) << 5); R = (st >> 1) * 16 + swz / 64; C = (st & 1) * 32 + (swz % 64) / 2; }
__host__ __device__ __forceinline__ int perm32(int rho) { const int n = rho >> 4, i = rho & 15; return 8 * (i >> 2) + 4 * n + (i & 3); }

struct Unit { int pm, pn; long bofs; int ex; };
struct Gemm { const bf16_t* A; const bf16_t* Bt; int M, N, K; };

struct StaticOrder {
    static constexpr bool GATHER = false;
    int nM, nN, nwg, G, c;
    __device__ __forceinline__ unsigned row_byteoff(const Unit&, int, int) const { return 0u; }
    __host__ __device__ void init(int M, int N, int G_, int c_) { nM = M / BM; nN = N / BM; nwg = nM * nN; G = G_; c = c_; }
    __host__ __device__ bool next(int i, Unit& u) const {
        const long L = (long)i * G + c; if (L >= nwg) return false;
        int wgid = (int)L; { const int q = nwg / NXCD, r = nwg % NXCD, xcd = wgid % NXCD, off = wgid / NXCD; wgid = (xcd < r ? xcd * (q + 1) : r * (q + 1) + (xcd - r) * q) + off; }
        const int nig = WGM * nN, gid = wgid / nig, fm = gid * WGM, gsz = (nM % WGM == 0) ? WGM : ((nM - fm) < WGM ? (nM - fm) : WGM);
        u.pm = fm + ((wgid % nig) % gsz); u.pn = (wgid % nig) / gsz; u.bofs = 0; u.ex = 0; return true;
    }
    __device__ __forceinline__ void a_ready(const Unit&) const {}
    __device__ __forceinline__ void done(const Unit&) const {}
};

typedef float f32x2v_ __attribute__((ext_vector_type(2))); typedef __bf16 bf16x2v_ __attribute__((ext_vector_type(2)));
__device__ __forceinline__ unsigned cvt_pk_bf16(float lo, float hi) { f32x2v_ v = {lo, hi}; bf16x2v_ b = __builtin_convertvector(v, bf16x2v_); return __builtin_bit_cast(unsigned, b); }
typedef float f32x2 __attribute__((ext_vector_type(2)));

__device__ __forceinline__ float bf_lo(unsigned w) { return __uint_as_float(w << 16); }
__device__ __forceinline__ float bf_hi(unsigned w) { return __uint_as_float(w & 0xffff0000u); }
__device__ __forceinline__ float sigmoid_f(float x) { return __builtin_amdgcn_rcpf(1.0f + __builtin_amdgcn_exp2f(-1.4426950408889634f * x)); }

struct EpiP1 {
    static constexpr bool PERM = true, AFTER_DRAIN = false, MIDK = false;
    unsigned char* ws; const float* bgate;
    static constexpr size_t OQA = (size_t)392 << 20, OKA = (size_t)456 << 20, OVA = (size_t)472 << 20, OQB = (size_t)488 << 20, OKB = (size_t)552 << 20, OVB = (size_t)616 << 20, OGT = (size_t)680 << 20;
    __device__ __forceinline__ void operator()(const f32x4 (&acc)[2][2][4][2], const Unit& u, int wr, int wc, int fr, int fq) const {
        const int pn = u.pn; size_t boff; int ld, colt; bool gate = false;
        if (pn < 4)       { boff = OQA; ld = 1024; colt = pn * 256; }
        else if (pn == 4) { boff = OKA; ld = 256;  colt = 0; }
        else if (pn == 5) { boff = OVA; ld = 256;  colt = 0; }
        else if (pn < 10) { boff = OQB; ld = 1024; colt = (pn - 6) * 256; }
        else if (pn < 14) { boff = OKB; ld = 1024; colt = (pn - 10) * 256; }
        else if (pn < 18) { boff = OVB; ld = 1024; colt = (pn - 14) * 256; }
        else              { boff = OGT; ld = 4096; colt = (pn - 18) * 256; gate = true; }
        bf16_t* const base = (bf16_t*)(ws + boff); bf16_t* const GT = (bf16_t*)(ws + OGT);
        const int row0 = u.pm * BM + wr * 64 + fr, col0 = colt + wc * 32 + 8 * fq;
        if (pn >= 10 && pn < 14) {
            const float* tab = (const float*)(ws + ((size_t)2 << 20));
            const int f0 = 16 * (wc & 1) + 4 * fq;
#pragma unroll
            for (int ai = 0; ai < 2; ++ai)
#pragma unroll
                for (int m = 0; m < 4; ++m) { const int r = row0 + ai * HALF + m * 16; const int pos = r & 8191;
                    const f32x4 t0 = *(const f32x4*)(tab + ((size_t)pos * 32 + f0) * 2), t1 = *(const f32x4*)(tab + ((size_t)pos * 32 + f0) * 2 + 4);
                    const float cs[4] = {t0[0], t0[2], t1[0], t1[2]}, sn[4] = {t0[1], t0[3], t1[1], t1[3]};
                    bf16_t* rowp = base + (size_t)r * ld + col0;
#pragma unroll
                    for (int bj = 0; bj < 2; ++bj) { f32x4 v0, v1;
#pragma unroll
                        for (int e = 0; e < 4; ++e) { const float x1 = acc[ai][bj][m][0][e], x2 = acc[ai][bj][m][1][e]; v0[e] = x1 * cs[e] - x2 * sn[e]; v1[e] = x2 * cs[e] + x1 * sn[e]; }
                        u32x4 w; w.x = cvt_pk_bf16(v0[0], v0[1]); w.y = cvt_pk_bf16(v0[2], v0[3]); w.z = cvt_pk_bf16(v1[0], v1[1]); w.w = cvt_pk_bf16(v1[2], v1[3]);
                        *(u32x4*)(rowp + bj * HALF) = w; } }
            return;
        }
        if (gate) {
            const int ch0 = (pn - 18) * HALF + wc * 32 + 8 * fq;
            f32x4 ba[2], bb[2];
#pragma unroll
            for (int n = 0; n < 2; ++n) { ba[n] = *(const f32x4*)(bgate + ch0 + 4 * n); bb[n] = *(const f32x4*)(bgate + 2048 + ch0 + 4 * n); }
#pragma unroll
            for (int ai = 0; ai < 2; ++ai)
#pragma unroll
                for (int m = 0; m < 4; ++m) { bf16_t* rowp = GT + (size_t)(row0 + ai * HALF + m * 16) * 4096 + ch0;
                    f32x4 a0 = acc[ai][0][m][0] + ba[0], a1 = acc[ai][0][m][1] + ba[1], b0 = acc[ai][1][m][0] + bb[0], b1 = acc[ai][1][m][1] + bb[1];
#pragma unroll
                    for (int e = 0; e < 4; ++e) { a0[e] = sigmoid_f(a0[e]); a1[e] = sigmoid_f(a1[e]); b0[e] = sigmoid_f(b0[e]); b1[e] = sigmoid_f(b1[e]); }
                    u32x4 wb; wb.x = cvt_pk_bf16(b0[0], b0[1]); wb.y = cvt_pk_bf16(b0[2], b0[3]); wb.z = cvt_pk_bf16(b1[0], b1[1]); wb.w = cvt_pk_bf16(b1[2], b1[3]);
                    const float q0 = __builtin_amdgcn_rcpf(fmaxf(bf_lo(wb.x), 1e-30f)), q1 = __builtin_amdgcn_rcpf(fmaxf(bf_hi(wb.x), 1e-30f)), q2 = __builtin_amdgcn_rcpf(fmaxf(bf_lo(wb.y), 1e-30f)), q3 = __builtin_amdgcn_rcpf(fmaxf(bf_hi(wb.y), 1e-30f));
                    const float q4 = __builtin_amdgcn_rcpf(fmaxf(bf_lo(wb.z), 1e-30f)), q5 = __builtin_amdgcn_rcpf(fmaxf(bf_hi(wb.z), 1e-30f)), q6 = __builtin_amdgcn_rcpf(fmaxf(bf_lo(wb.w), 1e-30f)), q7 = __builtin_amdgcn_rcpf(fmaxf(bf_hi(wb.w), 1e-30f));
                    u32x4 wr_; wr_.x = cvt_pk_bf16(a0[0] * q0, a0[1] * q1); wr_.y = cvt_pk_bf16(a0[2] * q2, a0[3] * q3); wr_.z = cvt_pk_bf16(a1[0] * q4, a1[1] * q5); wr_.w = cvt_pk_bf16(a1[2] * q6, a1[3] * q7);
                    *(u32x4*)rowp = wr_; *(u32x4*)(rowp + 2048) = wb; }
            return;
        }
#pragma unroll
        for (int ai = 0; ai < 2; ++ai)
#pragma unroll
            for (int m = 0; m < 4; ++m) { bf16_t* rowp = base + (size_t)(row0 + ai * HALF + m * 16) * ld + col0;
#pragma unroll
                for (int bj = 0; bj < 2; ++bj) { const f32x4 v0 = acc[ai][bj][m][0], v1 = acc[ai][bj][m][1];
                    u32x4 w; w.x = cvt_pk_bf16(v0[0], v0[1]); w.y = cvt_pk_bf16(v0[2], v0[3]); w.z = cvt_pk_bf16(v1[0], v1[1]); w.w = cvt_pk_bf16(v1[2], v1[3]);
                    *(u32x4*)(rowp + bj * HALF) = w; } }
    }
};

struct EpiMerge {
    static constexpr bool PERM = true, AFTER_DRAIN = false, MIDK = true;
    const bf16_t* GT; bf16_t* MG;
    __device__ __forceinline__ void mid(f32x4 (&acc)[2][2][4][2], const Unit& u, int wr, int wc, int fr, int fq) const {
        asm volatile("" : "+v"(fr), "+v"(fq));
        const int row0 = u.pm * BM + wr * 64 + fr, col0 = u.pn * BM + wc * 32 + 8 * fq;
#pragma unroll
        for (int ai = 0; ai < 2; ++ai)
#pragma unroll
            for (int m = 0; m < 4; ++m) { const size_t r = (size_t)(row0 + ai * HALF + m * 16);
#pragma unroll
                for (int bj = 0; bj < 2; ++bj) { const u32x4 ga = *(const u32x4*)(GT + r * 4096 + col0 + bj * HALF);
                    acc[ai][bj][m][0][0] *= bf_lo(ga.x); acc[ai][bj][m][0][1] *= bf_hi(ga.x); acc[ai][bj][m][0][2] *= bf_lo(ga.y); acc[ai][bj][m][0][3] *= bf_hi(ga.y);
                    acc[ai][bj][m][1][0] *= bf_lo(ga.z); acc[ai][bj][m][1][1] *= bf_hi(ga.z); acc[ai][bj][m][1][2] *= bf_lo(ga.w); acc[ai][bj][m][1][3] *= bf_hi(ga.w);
                }
                if (m == 3) asm volatile("" ::: "memory"); }
    }
    __device__ __forceinline__ void operator()(const f32x4 (&acc)[2][2][4][2], const Unit& u, int wr, int wc, int fr, int fq) const {
        asm volatile("" : "+v"(fr), "+v"(fq));
        const int row0 = u.pm * BM + wr * 64 + fr, col0 = u.pn * BM + wc * 32 + 8 * fq;
#pragma unroll
        for (int ai = 0; ai < 2; ++ai)
#pragma unroll
            for (int m = 0; m < 4; ++m) { const size_t r = (size_t)(row0 + ai * HALF + m * 16);
#pragma unroll
                for (int bj = 0; bj < 2; ++bj) { const u32x4 g = *(const u32x4*)(GT + r * 4096 + 2048 + col0 + bj * HALF);
                    f32x4 v0 = acc[ai][bj][m][0], v1 = acc[ai][bj][m][1];
                    v0[0] *= fmaxf(bf_lo(g.x), 1e-30f); v0[1] *= fmaxf(bf_hi(g.x), 1e-30f); v0[2] *= fmaxf(bf_lo(g.y), 1e-30f); v0[3] *= fmaxf(bf_hi(g.y), 1e-30f);
                    v1[0] *= fmaxf(bf_lo(g.z), 1e-30f); v1[1] *= fmaxf(bf_hi(g.z), 1e-30f); v1[2] *= fmaxf(bf_lo(g.w), 1e-30f); v1[3] *= fmaxf(bf_hi(g.w), 1e-30f);
                    u32x4 w; w.x = cvt_pk_bf16(v0[0], v0[1]); w.y = cvt_pk_bf16(v0[2], v0[3]); w.z = cvt_pk_bf16(v1[0], v1[1]); w.w = cvt_pk_bf16(v1[2], v1[3]);
                    *(u32x4*)(MG + r * 2048 + col0 + bj * HALF) = w; }
                if (m & 1) asm volatile("" ::: "memory"); }
    }
};
struct EpiOut {
    static constexpr bool PERM = true, AFTER_DRAIN = false, MIDK = false;
    const float* X; bf16_t* X1; float* SSQ;
    __device__ __forceinline__ void operator()(const f32x4 (&acc)[2][2][4][2], const Unit& u, int wr, int wc, int fr, int fq) const {
        const int row0 = u.pm * BM + wr * 64 + fr, col0 = u.pn * BM + wc * 32 + 8 * fq;
#pragma unroll
        for (int ai = 0; ai < 2; ++ai)
#pragma unroll
            for (int m = 0; m < 4; ++m) { const size_t r = (size_t)(row0 + ai * HALF + m * 16); float s = 0.f;
#pragma unroll
                for (int bj = 0; bj < 2; ++bj) { const size_t off = r * 2048 + col0 + bj * HALF;
                    const f32x4 v0 = *(const f32x4*)(X + off) + acc[ai][bj][m][0], v1 = *(const f32x4*)(X + off + 4) + acc[ai][bj][m][1];
                    u32x4 w; w.x = cvt_pk_bf16(v0[0], v0[1]); w.y = cvt_pk_bf16(v0[2], v0[3]); w.z = cvt_pk_bf16(v1[0], v1[1]); w.w = cvt_pk_bf16(v1[2], v1[3]);
                    *(u32x4*)(X1 + off) = w;
                    s += ((v0[0] * v0[0] + v0[1] * v0[1]) + (v0[2] * v0[2] + v0[3] * v0[3])) + ((v1[0] * v1[0] + v1[1] * v1[1]) + (v1[2] * v1[2] + v1[3] * v1[3])); }
                s += __shfl_xor(s, 16); s += __shfl_xor(s, 32);
                if (fq == 0) SSQ[r * 32 + u.pn * 4 + wc] = s;
                if (m & 1) asm volatile("" ::: "memory"); }
    }
};
struct EpiG1 {
    static constexpr bool PERM = true, AFTER_DRAIN = false, MIDK = false;
    bf16_t* U;
    const float* LR; const float* LW; const PG8_LAS int* tab;
    __device__ __forceinline__ void operator()(const f32x4 (&acc)[2][2][4][2], const Unit& u, int wr, int wc, int fr, int fq) const {
        const int row0 = u.pm * BM + wr * 64 + fr, col0 = u.pn * HALF + wc * 32 + 8 * fq;
        const int slot0 = (u.pm - tab[32 + u.ex]) * BM + wr * 64 + fr, cnt = tab[u.ex];
        float rs[2][4], wt[2][4];
#pragma unroll
        for (int ai = 0; ai < 2; ++ai)
#pragma unroll
            for (int m = 0; m < 4; ++m) { const int slot = slot0 + ai * HALF + m * 16; const bool ok = slot < cnt; const size_t ix = (size_t)u.ex * 32768 + (ok ? slot : 0);
                const float lr_ = LR[ix], lw_ = LW[ix];
                rs[ai][m] = ok ? lr_ : 0.f; wt[ai][m] = ok ? lw_ : 0.f; }
#pragma unroll
        for (int ai = 0; ai < 2; ++ai)
#pragma unroll
            for (int m = 0; m < 4; ++m) { f32x4 v0, v1; const float r_ = rs[ai][m], rw = r_ * wt[ai][m];
#pragma unroll
                for (int e = 0; e < 4; ++e) { const float g0 = acc[ai][0][m][0][e] * r_, g1 = acc[ai][0][m][1][e] * r_;
                    v0[e] = g0 * sigmoid_f(g0) * (acc[ai][1][m][0][e] * rw); v1[e] = g1 * sigmoid_f(g1) * (acc[ai][1][m][1][e] * rw); }
                u32x4 w; w.x = cvt_pk_bf16(v0[0], v0[1]); w.y = cvt_pk_bf16(v0[2], v0[3]); w.z = cvt_pk_bf16(v1[0], v1[1]); w.w = cvt_pk_bf16(v1[2], v1[3]);
                *(u32x4*)(U + (size_t)(row0 + ai * HALF + m * 16) * 512 + col0) = w; }
    }
};
constexpr int MOE_LCAP = 32768;
struct EpiG2 {
    static constexpr bool PERM = true, AFTER_DRAIN = false, MIDK = false;
    unsigned char* YC;
    __device__ __forceinline__ void operator()(const f32x4 (&acc)[2][2][4][2], const Unit& u, int wr, int wc, int fr, int fq) const {
        typedef int i32x2e __attribute__((ext_vector_type(2)));
        const int row0 = u.pm * BM + wr * 64 + fr, col0 = u.pn * BM + wc * 32 + 8 * fq;
#pragma unroll
        for (int ai = 0; ai < 2; ++ai)
#pragma unroll
            for (int m = 0; m < 4; ++m) { const size_t r = (size_t)(row0 + ai * HALF + m * 16);
#pragma unroll
                for (int bj = 0; bj < 2; ++bj) { const f32x4 v0 = acc[ai][bj][m][0] * 16.0f, v1 = acc[ai][bj][m][1] * 16.0f;
                    i32x2e w; w.x = __builtin_amdgcn_cvt_pk_fp8_f32(v0[0], v0[1], 0, false); w.x = __builtin_amdgcn_cvt_pk_fp8_f32(v0[2], v0[3], w.x, true);
                    w.y = __builtin_amdgcn_cvt_pk_fp8_f32(v1[0], v1[1], 0, false); w.y = __builtin_amdgcn_cvt_pk_fp8_f32(v1[2], v1[3], w.y, true);
                    *(i32x2e*)(YC + r * 2048 + col0 + bj * HALF) = w; } }
    }
};
template <int NT, long BSTRIDE  , bool GATHER_> struct MoeOrder {
    static constexpr bool GATHER = GATHER_;
    const PG8_LAS int* tab; int G, c; const int* LENT;
    __device__ __forceinline__ bool next(int i, Unit& u) const {
        const int P = tab[64]; const long L = (long)i * G + c; if (L >= (long)P * NT) return false;
        const int p = (int)(L / NT);
        const int ln_ = (int)(threadIdx.x & 63); const int pb_ = ln_ < 32 ? tab[32 + ln_] : 0x7fffffff;
        const int e = (int)__popcll(__ballot(pb_ <= p)) - 1;
        u.pm = p; u.pn = (int)(L % NT); u.bofs = (long)e * BSTRIDE; u.ex = e; return true;
    }
    __device__ __forceinline__ unsigned row_byteoff(const Unit& u, int row, int K) const {
        const int slot = (u.pm - tab[32 + u.ex]) * BM + row; const bool ok = slot < tab[u.ex];
        const int ent = LENT[(size_t)u.ex * MOE_LCAP + (ok ? slot : 0)];
        return (unsigned)(ok ? (ent >> 1) : 0) * (unsigned)(K * 2);
    }
    __device__ __forceinline__ void a_ready(const Unit&) const {}
    __device__ __forceinline__ void done(const Unit&) const {}
};

template <class Epi, class Sched, bool ALIGN_EPI = false, bool SP2 = false>
__device__ __forceinline__ void gemm_phase(PG8_LAS unsigned char* lds, const Gemm g, const Sched& S, const Epi& E) {
    const int tid = threadIdx.x, wid = __builtin_amdgcn_readfirstlane(tid >> 6), lane = tid & 63, wr = wid >> 2, wc = wid & 3, fr = lane & 15, fq = lane >> 4;
    const int K = g.K, nt = K / BK;
    unsigned voffA[2], voffB[2];
#pragma unroll
    for (int i = 0; i < 2; ++i) { int R, C; stage_rc(tid * 16 + i * 8192, R, C); const int Rb = Epi::PERM ? ((R & ~31) + perm32(R & 31)) : R;
        voffA[i] = (unsigned)(R * K + C) * 2u; voffB[i] = (unsigned)(Rb * K + C) * 2u; }
    const size_t kstep = (size_t)(BK * 2);
    const size_t hstep = (size_t)HALF * K * 2;
    const size_t tstep = 2 * hstep;
    const unsigned ldsw = (unsigned)wid * 1024u;
    const int aoff = lds_byte(wr * 64 + fr, fq * 8), boff = lds_byte(wc * 32 + fr, fq * 8);
#define PG8_SA(b, h) (((b) * 2 + (h)) * HTB)
#define PG8_SB(b, h) ((4 + (b) * 2 + (h)) * HTB)
#define PG8_STAGE(bufoff, gbase, voff) do { _Pragma("unroll") for (int _i = 0; _i < 2; ++_i) \
        __builtin_amdgcn_global_load_lds((const unsigned*)((const char*)(gbase) + (voff)[_i]), (PG8_LAS unsigned*)(lds + (bufoff) + ldsw + _i * 8192), 16, 0, 0); } while (0)
#define PG8_STAGEA(bufoff, gbase, h, nx) do { if constexpr (Sched::GATHER) { _Pragma("unroll") for (int _i = 0; _i < 2; ++_i) { const unsigned vo_ = (nx) ? voffAn[h][_i] : voffAc[h][_i]; \
        __builtin_amdgcn_global_load_lds((const unsigned*)((const char*)(gbase) + vo_), (PG8_LAS unsigned*)(lds + (bufoff) + ldsw + _i * 8192), 16, 0, 0); } } \
    else { PG8_STAGE(bufoff, (gbase) + (h) * hstep, voffA); } } while (0)
#define PG8_LDA(dst, b, h) do { _Pragma("unroll") for (int m = 0; m < 4; ++m) _Pragma("unroll") for (int k = 0; k < 2; ++k) dst[m][k] = *(const PG8_LAS bf16x8*)(lds + PG8_SA(b, h) + aoff + m * 2048 + k * 1024); } while (0)
#define PG8_LDB(dst, b, h) do { _Pragma("unroll") for (int n = 0; n < 2; ++n) _Pragma("unroll") for (int k = 0; k < 2; ++k) dst[n][k] = *(const PG8_LAS bf16x8*)(lds + PG8_SB(b, h) + boff + n * 2048 + k * 1024); } while (0)
#define PG8_MMA(ai, bj, At, Bt) do { __builtin_amdgcn_s_setprio(1); _Pragma("unroll") for (int m = 0; m < 4; ++m) _Pragma("unroll") for (int n = 0; n < 2; ++n) _Pragma("unroll") for (int k = 0; k < 2; ++k) \
        acc[ai][bj][m][n] = __builtin_amdgcn_mfma_f32_16x16x32_bf16(Bt[n][k], At[m][k], acc[ai][bj][m][n], 0, 0, 0); __builtin_amdgcn_s_setprio(0); } while (0)
#define PG8_WAIT_V(n) asm volatile("s_waitcnt vmcnt(" #n ")" ::: "memory")
#define PG8_WAIT_L(n) asm volatile("s_waitcnt lgkmcnt(" #n ")" ::: "memory")
#define PG8_BAR __builtin_amdgcn_s_barrier()
#define PG8_SCHED __builtin_amdgcn_sched_barrier(0)
    Unit cur, nxt; int ui = 0;
    if (!S.next(0, cur)) return;
    f32x4 acc[2][2][4][2];
#pragma unroll
    for (int a = 0; a < 2; ++a)
#pragma unroll
        for (int b = 0; b < 2; ++b)
#pragma unroll
            for (int m = 0; m < 4; ++m)
#pragma unroll
                for (int n = 0; n < 2; ++n) acc[a][b][m][n] = (f32x4){0.f, 0.f, 0.f, 0.f};
    bf16x8 At[4][2], B0[2][2], B1[2][2];
    const char* cA = (const char*)g.A + (Sched::GATHER ? (size_t)0 : (size_t)cur.pm * tstep); const char* cB = (const char*)g.Bt + (size_t)cur.pn * tstep + cur.bofs;
    unsigned voffAc[2][2] = {{0u, 0u}, {0u, 0u}}, voffAn[2][2] = {{0u, 0u}, {0u, 0u}};
    if constexpr (Sched::GATHER) {
#pragma unroll
        for (int h = 0; h < 2; ++h)
#pragma unroll
            for (int i = 0; i < 2; ++i) { int R, C; stage_rc(tid * 16 + i * 8192, R, C); voffAc[h][i] = S.row_byteoff(cur, h * HALF + R, K) + (unsigned)C * 2u; }
    }
    S.a_ready(cur);
    if constexpr (SP2) {
        PG8_STAGE(PG8_SB(0, 0), cB, voffB); PG8_STAGE(PG8_SB(0, 1), cB + hstep, voffB); PG8_STAGEA(PG8_SA(0, 0), cA, 0, false); PG8_STAGEA(PG8_SA(0, 1), cA, 1, false);
        if (wr == 1) PG8_BAR;
        PG8_WAIT_V(2); PG8_BAR;
        PG8_STAGE(PG8_SB(1, 0), cB + kstep, voffB); PG8_STAGEA(PG8_SA(1, 0), cA + kstep, 0, false); PG8_STAGE(PG8_SB(1, 1), cB + hstep + kstep, voffB);
        PG8_WAIT_V(6); PG8_BAR;
    } else {
        PG8_STAGE(PG8_SB(0, 0), cB, voffB); PG8_STAGE(PG8_SA(0, 0), cA, voffA); PG8_STAGE(PG8_SB(0, 1), cB + hstep, voffB); PG8_STAGE(PG8_SA(0, 1), cA + hstep, voffA);
        if (wr == 1) PG8_BAR;
        PG8_WAIT_V(4); PG8_BAR;
        PG8_STAGE(PG8_SB(1, 0), cB + kstep, voffB); PG8_STAGE(PG8_SA(1, 0), cA + kstep, voffA); PG8_STAGE(PG8_SB(1, 1), cB + hstep + kstep, voffB);
        PG8_WAIT_V(6); PG8_BAR;
    }
    for (;;) {
        const bool has_next = S.next(ui + 1, nxt);
        if constexpr (Sched::GATHER) { if (has_next) {
#pragma unroll
            for (int h = 0; h < 2; ++h)
#pragma unroll
                for (int i = 0; i < 2; ++i) { int R, C; stage_rc(tid * 16 + i * 8192, R, C); voffAn[h][i] = S.row_byteoff(nxt, h * HALF + R, K) + (unsigned)C * 2u; } }
            else {
#pragma unroll
            for (int h = 0; h < 2; ++h)
#pragma unroll
                for (int i = 0; i < 2; ++i) voffAn[h][i] = voffAc[h][i]; } }
        const char* nA = Sched::GATHER ? cA : (has_next ? (const char*)g.A + (size_t)nxt.pm * tstep : cA); const char* nB = has_next ? (const char*)g.Bt + (size_t)nxt.pn * tstep + nxt.bofs : cB;
        constexpr int NKH = Epi::MIDK ? 2 : 1;
        int t = 0;
#pragma unroll 1
        for (int kh = 0; kh < NKH; ++kh) {
        const int tend = (NKH == 2 && kh == 0) ? nt / 2 : nt;
#pragma unroll 1
        for (; t < tend; t += 2) {
            const bool last = (t == nt - 2);
            const char* a1 = cA + (size_t)(t + 1) * kstep;
            const char* a2 = last ? nA : cA + (size_t)(t + 2) * kstep; const char* b2 = last ? nB : cB + (size_t)(t + 2) * kstep;
            const char* a3 = a2 + kstep; const char* b3 = b2 + kstep;
            if (last && has_next) S.a_ready(nxt);
            if constexpr (SP2) {
            PG8_LDB(B0, 0, 0); PG8_LDB(B1, 0, 1); PG8_SCHED; PG8_LDA(At, 0, 0); PG8_STAGEA(PG8_SA(1, 1), a1, 1, false);
            PG8_WAIT_V(8); PG8_WAIT_L(0); PG8_BAR; PG8_MMA(0, 0, At, B0); PG8_MMA(0, 1, At, B1); PG8_BAR; PG8_SCHED;
            PG8_LDA(At, 0, 1); PG8_STAGE(PG8_SB(0, 0), b2, voffB); PG8_STAGE(PG8_SB(0, 1), b2 + hstep, voffB); PG8_STAGEA(PG8_SA(0, 0), a2, 0, last);
            PG8_WAIT_V(8); PG8_WAIT_L(0); PG8_BAR; PG8_MMA(1, 0, At, B0); PG8_MMA(1, 1, At, B1); PG8_BAR; PG8_SCHED;
            PG8_LDB(B0, 1, 0); PG8_LDB(B1, 1, 1); PG8_SCHED; PG8_LDA(At, 1, 0); PG8_STAGEA(PG8_SA(0, 1), a2, 1, last);
            PG8_WAIT_V(8); PG8_WAIT_L(0); PG8_BAR; PG8_MMA(0, 0, At, B0); PG8_MMA(0, 1, At, B1); PG8_BAR; PG8_SCHED;
            PG8_LDA(At, 1, 1); PG8_STAGE(PG8_SB(1, 0), b3, voffB); PG8_STAGE(PG8_SB(1, 1), b3 + hstep, voffB); PG8_STAGEA(PG8_SA(1, 0), a3, 0, last);
            PG8_WAIT_V(8); PG8_WAIT_L(0); PG8_BAR; PG8_MMA(1, 0, At, B0); PG8_MMA(1, 1, At, B1); PG8_BAR; PG8_SCHED;
            } else {
            PG8_LDB(B0, 0, 0); PG8_SCHED; PG8_LDA(At, 0, 0); PG8_STAGE(PG8_SA(1, 1), a1 + hstep, voffA);
            PG8_WAIT_L(8); PG8_BAR; PG8_WAIT_L(0); PG8_MMA(0, 0, At, B0); PG8_BAR; PG8_SCHED;
            PG8_LDB(B1, 0, 1); PG8_STAGE(PG8_SB(0, 0), b2, voffB);
            PG8_BAR; PG8_WAIT_L(0); PG8_MMA(0, 1, At, B1); PG8_BAR;
            PG8_LDA(At, 0, 1); PG8_STAGE(PG8_SA(0, 0), a2, voffA);
            PG8_BAR; PG8_WAIT_L(0); PG8_MMA(1, 0, At, B0); PG8_BAR; PG8_SCHED;
            PG8_STAGE(PG8_SB(0, 1), b2 + hstep, voffB);
            PG8_WAIT_V(6); PG8_BAR; PG8_MMA(1, 1, At, B1); PG8_BAR;
            PG8_LDB(B0, 1, 0); PG8_SCHED; PG8_LDA(At, 1, 0); PG8_STAGE(PG8_SA(0, 1), a2 + hstep, voffA);
            PG8_WAIT_L(8); PG8_BAR; PG8_WAIT_L(0); PG8_MMA(0, 0, At, B0); PG8_BAR; PG8_SCHED;
            PG8_LDB(B1, 1, 1); PG8_STAGE(PG8_SB(1, 0), b3, voffB);
            PG8_BAR; PG8_WAIT_L(0); PG8_MMA(0, 1, At, B1); PG8_BAR;
            PG8_LDA(At, 1, 1); PG8_STAGE(PG8_SA(1, 0), a3, voffA);
            PG8_BAR; PG8_WAIT_L(0); PG8_MMA(1, 0, At, B0); PG8_BAR; PG8_SCHED;
            PG8_STAGE(PG8_SB(1, 1), b3 + hstep, voffB);
            PG8_WAIT_V(6); PG8_BAR; PG8_MMA(1, 1, At, B1); PG8_BAR;
            }
        }
        if constexpr (Epi::MIDK) { if (kh == 0) E.mid(acc, cur, wr, wc, fr, fq); }
        }
        if constexpr (ALIGN_EPI) { if (wr == 0) PG8_BAR; }
        if constexpr (!Epi::AFTER_DRAIN) { E(acc, cur, wr, wc, fr, fq); S.done(cur); }
        if (!has_next) break;
#pragma unroll
        for (int a = 0; a < 2; ++a)
#pragma unroll
            for (int b = 0; b < 2; ++b)
#pragma unroll
                for (int m = 0; m < 4; ++m)
#pragma unroll
                    for (int n = 0; n < 2; ++n) { acc[a][b][m][n] = (f32x4){0.f, 0.f, 0.f, 0.f}; asm volatile("" : "+v"(acc[a][b][m][n])); }
        cur = nxt; cA = nA; cB = nB; ++ui;
        if constexpr (Sched::GATHER) {
#pragma unroll
            for (int h = 0; h < 2; ++h)
#pragma unroll
                for (int i = 0; i < 2; ++i) voffAc[h][i] = voffAn[h][i]; }
        if constexpr (ALIGN_EPI) { if (wr == 1) PG8_BAR; }
    }
    PG8_WAIT_V(0);
    if constexpr (!ALIGN_EPI) { if (wr == 0) PG8_BAR; }
    PG8_BAR;
    if constexpr (Epi::AFTER_DRAIN) { E.fused(acc, cur, wr, wc, fr, fq, lds, wid, lane); S.done(cur); }
#undef PG8_SA
#undef PG8_SB
#undef PG8_STAGE
#undef PG8_STAGEA
#undef PG8_LDA
#undef PG8_LDB
#undef PG8_MMA
#undef PG8_WAIT_V
#undef PG8_WAIT_L
#undef PG8_BAR
#undef PG8_SCHED
}
}

namespace att {
typedef unsigned short bf16;
using bf16x8 = __attribute__((ext_vector_type(8))) short;
using s16x4  = __attribute__((ext_vector_type(4))) short;
using f32x16 = __attribute__((ext_vector_type(16))) float;
using u32x4  = __attribute__((ext_vector_type(4))) unsigned;
constexpr int NW = 8, QBLK = 32, KVBLK = 64, DV = 128;
constexpr int SHM_V = KVBLK * DV * 2;
constexpr int OFF_V = 0, OFF_K = 3 * SHM_V, OFF_STASH = 76800;
constexpr float THR = 8.f;
#define ATT_SBAR() __builtin_amdgcn_sched_barrier(0)
template <int DQK> __device__ __forceinline__ int kswz(int row, int colB) { return row * (DQK * 2 + 16) + colB; }
__device__ __forceinline__ int crow(int r, int hi) { return (r & 3) + 8 * (r >> 2) + 4 * hi; }
typedef float f32x2_t __attribute__((ext_vector_type(2))); typedef __bf16 bf16x2_t __attribute__((ext_vector_type(2)));
__device__ __forceinline__ unsigned cvtpk(float lo, float hi) { f32x2_t v = {lo, hi}; bf16x2_t b = __builtin_convertvector(v, bf16x2_t); return __builtin_bit_cast(unsigned, b); }

template <int DQK> __device__ __forceinline__ void partialSM(f32x16& p0, f32x16& p1, float& m_reg, float& mn, float& alpha) {
  constexpr float SCALE = (DQK == 128) ? 0.088388347648318440f : 0.125f;
  constexpr float C = SCALE * 1.4426950408889634f;
  float pmax = p0[0];
#pragma unroll
  for (int r = 1; r < 16; ++r) pmax = fmaxf(pmax, p0[r]);
#pragma unroll
  for (int r = 0; r < 16; ++r) pmax = fmaxf(pmax, p1[r]);
  { auto rr = __builtin_amdgcn_permlane32_swap(__float_as_uint(pmax), __float_as_uint(pmax), false, false);
    pmax = fmaxf(__uint_as_float(rr[0]), __uint_as_float(rr[1])); }
  if (__builtin_expect(__all(pmax - m_reg <= THR / SCALE), 1)) { mn = m_reg; alpha = 1.f; }
  else { mn = fmaxf(m_reg, pmax); alpha = __builtin_amdgcn_exp2f((m_reg - mn) * C); m_reg = mn; }
  const float mnC = -mn * C;
#pragma unroll
  for (int r = 0; r < 16; ++r) p0[r] = fmaf(p0[r], C, mnC);
#pragma unroll
  for (int r = 0; r < 16; ++r) p1[r] = fmaf(p1[r], C, mnC);
#pragma unroll
  for (int r = 0; r < 16; ++r) p0[r] = __builtin_amdgcn_exp2f(p0[r]);
}
__device__ __forceinline__ void finishSM(f32x16& p0, f32x16& p1, float alpha, float& l_reg, bf16x8& pa0, bf16x8& pa1, bf16x8& pa2, bf16x8& pa3) {
#pragma unroll
  for (int r = 0; r < 16; ++r) p1[r] = __builtin_amdgcn_exp2f(p1[r]);
  float ps = 0;
#pragma unroll
  for (int r = 0; r < 16; ++r) ps += p0[r];
#pragma unroll
  for (int r = 0; r < 16; ++r) ps += p1[r];
  { auto rr = __builtin_amdgcn_permlane32_swap(__float_as_uint(ps), __float_as_uint(ps), false, false);
    ps = __uint_as_float(rr[0]) + __uint_as_float(rr[1]); }
  l_reg = l_reg * alpha + ps;
#define ATT_PK4(P, BASE, OUT) do { unsigned a0 = cvtpk(P[BASE + 0], P[BASE + 1]), a1 = cvtpk(P[BASE + 2], P[BASE + 3]);   \
    unsigned b0 = cvtpk(P[BASE + 4], P[BASE + 5]), b1 = cvtpk(P[BASE + 6], P[BASE + 7]);                              \
    auto r0 = __builtin_amdgcn_permlane32_swap(a0, b0, false, false); auto r1 = __builtin_amdgcn_permlane32_swap(a1, b1, false, false); \
    u32x4 w = {r0[0], r1[0], r0[1], r1[1]}; OUT = *reinterpret_cast<bf16x8*>(&w); } while (0)
  ATT_PK4(p0, 0, pa0); ATT_PK4(p0, 8, pa1); ATT_PK4(p1, 0, pa2); ATT_PK4(p1, 8, pa3);
#undef ATT_PK4
}
template <int DQK> __device__ __forceinline__ void qkt(f32x16& p0, f32x16& p1, const char* Ks, const bf16x8* qr, int r32, int hi) {
  p0 = f32x16{}; p1 = f32x16{};
#pragma unroll
  for (int d0 = 0; d0 < DQK / 16; ++d0) { const int cb = (d0 * 16 + hi * 8) * 2;
    const bf16x8 b0 = *reinterpret_cast<const bf16x8*>(Ks + kswz<DQK>(r32, cb));
    const bf16x8 b1 = *reinterpret_cast<const bf16x8*>(Ks + kswz<DQK>(32 + r32, cb));
    p0 = __builtin_amdgcn_mfma_f32_32x32x16_bf16(b0, qr[d0], p0, 0, 0, 0);
    p1 = __builtin_amdgcn_mfma_f32_32x32x16_bf16(b1, qr[d0], p1, 0, 0, 0); }
}
__device__ __forceinline__ int v_st(int k, int c) { const int kk = k; return ((kk >> 3) * 4 + (c >> 5)) * 512 + ((kk & 7) * 32 + (c & 31)) * 2; }
__device__ __forceinline__ int v_rd_base(int lane) { return ((lane & 3) << 3) | (((lane >> 2) & 3) << 6) | (((lane >> 4) & 1) << 5) | (((lane >> 5) & 1) << 8); }
constexpr int v_rd_off(int d0, int ks, int half) { return d0 * 512 + ks * 4096 + half * 2048; }
template <int OFF> __device__ __forceinline__ s16x4 tr_read(int vb) {
  s16x4 r; asm volatile("ds_read_b64_tr_b16 %0, %1 offset:%2" : "=&v"(r) : "v"(vb), "i"(OFF) : "memory"); return r;
}
typedef __attribute__((address_space(3))) const char* lds_cptr;
typedef short v4i16_t __attribute__((ext_vector_type(4)));
__device__ __forceinline__ s16x4 vtr(lds_cptr p) { return __builtin_bit_cast(s16x4, __builtin_amdgcn_ds_read_tr16_b64_v4i16((__attribute__((address_space(3))) v4i16_t*)p)); }
template <int D0> __device__ __forceinline__ void pv_one(f32x16& od, int vb, bf16x8 pa0, bf16x8 pa1, bf16x8 pa2, bf16x8 pa3) {
  const s16x4 l0 = tr_read<v_rd_off(D0, 0, 0)>(vb), h0 = tr_read<v_rd_off(D0, 0, 1)>(vb), l1 = tr_read<v_rd_off(D0, 1, 0)>(vb), h1 = tr_read<v_rd_off(D0, 1, 1)>(vb);
  const s16x4 l2 = tr_read<v_rd_off(D0, 2, 0)>(vb), h2 = tr_read<v_rd_off(D0, 2, 1)>(vb), l3 = tr_read<v_rd_off(D0, 3, 0)>(vb), h3 = tr_read<v_rd_off(D0, 3, 1)>(vb);
  asm volatile("s_waitcnt lgkmcnt(0)" ::: "memory"); ATT_SBAR();
#define ATT_PK(L, H) (bf16x8){L[0], L[1], L[2], L[3], H[0], H[1], H[2], H[3]}
  od = __builtin_amdgcn_mfma_f32_32x32x16_bf16(pa0, ATT_PK(l0, h0), od, 0, 0, 0);
  od = __builtin_amdgcn_mfma_f32_32x32x16_bf16(pa1, ATT_PK(l1, h1), od, 0, 0, 0);
  od = __builtin_amdgcn_mfma_f32_32x32x16_bf16(pa2, ATT_PK(l2, h2), od, 0, 0, 0);
  od = __builtin_amdgcn_mfma_f32_32x32x16_bf16(pa3, ATT_PK(l3, h3), od, 0, 0, 0);
#undef ATT_PK
}
__device__ __forceinline__ void pv_d0(f32x16* o, int vb, bf16x8 pa0, bf16x8 pa1, bf16x8 pa2, bf16x8 pa3) {
  pv_one<0>(o[0], vb, pa0, pa1, pa2, pa3); pv_one<1>(o[1], vb, pa0, pa1, pa2, pa3); pv_one<2>(o[2], vb, pa0, pa1, pa2, pa3); pv_one<3>(o[3], vb, pa0, pa1, pa2, pa3);
}

constexpr float THRL = 11.5f;
__device__ __forceinline__ float softmax_rowmax(const f32x16& p0, const f32x16& p1) {
  const float m0 = p1[0] + 0.0f; float a, b;
  asm("v_max3_f32 %0, %1, %2, %3\n\tv_max3_f32 %0, %0, %4, %5\n\tv_max3_f32 %0, %0, %6, %7\n\tv_max3_f32 %0, %0, %8, %9\n\t"
      "v_max3_f32 %0, %0, %10, %11\n\tv_max3_f32 %0, %0, %12, %13\n\tv_max3_f32 %0, %0, %14, %15\n\tv_max3_f32 %0, %0, %16, %17"
      : "=&v"(a) : "v"(m0), "v"(p0[0]), "v"(p0[1]), "v"(p0[2]), "v"(p0[3]), "v"(p0[4]), "v"(p0[5]), "v"(p0[6]), "v"(p0[7]), "v"(p0[8]), "v"(p0[9]), "v"(p0[10]), "v"(p0[11]), "v"(p0[12]), "v"(p0[13]), "v"(p0[14]), "v"(p0[15]));
  asm("v_max3_f32 %0, %1, %2, %3\n\tv_max3_f32 %0, %0, %4, %5\n\tv_max3_f32 %0, %0, %6, %7\n\tv_max3_f32 %0, %0, %8, %9\n\t"
      "v_max3_f32 %0, %0, %10, %11\n\tv_max3_f32 %0, %0, %12, %13\n\tv_max3_f32 %0, %0, %14, %15\n\tv_max_f32 %0, %0, %16"
      : "=&v"(b) : "v"(a), "v"(p1[1]), "v"(p1[2]), "v"(p1[3]), "v"(p1[4]), "v"(p1[5]), "v"(p1[6]), "v"(p1[7]), "v"(p1[8]), "v"(p1[9]), "v"(p1[10]), "v"(p1[11]), "v"(p1[12]), "v"(p1[13]), "v"(p1[14]), "v"(p1[15]));
  return b;
}
__device__ __forceinline__ float softmax_shift(f32x16& p0, f32x16& p1, f32x16& negm, float pmax, bool first) {
  asm volatile("s_nop 4" ::: "memory");
  { auto rr = __builtin_amdgcn_permlane32_swap(__float_as_uint(pmax), __float_as_uint(pmax), false, false);
    pmax = fmaxf(__uint_as_float(rr[0]), __uint_as_float(rr[1])); }
  const float delta = first ? pmax : fmaxf(pmax, 0.f);
#pragma unroll
  for (int r = 0; r < 16; ++r) { p0[r] -= delta; p1[r] -= delta; negm[r] -= delta; }
  return first ? 1.f : __builtin_amdgcn_exp2f(-delta);
}
__device__ __forceinline__ void softmax_exp_pack(f32x16& p0, f32x16& p1, bf16x8& pa0, bf16x8& pa1, bf16x8& pa2, bf16x8& pa3) {
#pragma unroll
  for (int r = 0; r < 16; ++r) { p0[r] = __builtin_amdgcn_exp2f(p0[r]); p1[r] = __builtin_amdgcn_exp2f(p1[r]); }
#define ATT_PK4(P, BASE, OUT) do { u32x4 w = {cvtpk(P[BASE + 0], P[BASE + 1]), cvtpk(P[BASE + 2], P[BASE + 3]), cvtpk(P[BASE + 4], P[BASE + 5]), cvtpk(P[BASE + 6], P[BASE + 7])}; \
    OUT = *reinterpret_cast<bf16x8*>(&w); } while (0)
  ATT_PK4(p0, 0, pa0); ATT_PK4(p0, 8, pa1); ATT_PK4(p1, 0, pa2); ATT_PK4(p1, 8, pa3);
#undef ATT_PK4
}

template <int DQK> __device__ __forceinline__ void q_prepare(bf16x8 (&qr)[DQK / 16], const float* rope, const float* gain, int s, int hi) {
  typedef float f32x4q __attribute__((ext_vector_type(4)));
  constexpr float CS = (DQK == 128) ? 0.12751743074602467f : 0.18033688011112042f;
  float v[DQK / 16][8];
#pragma unroll
  for (int d0 = 0; d0 < DQK / 16; ++d0) { const u32x4 w = *reinterpret_cast<const u32x4*>(&qr[d0]);
    v[d0][0] = __uint_as_float(w.x << 16); v[d0][1] = __uint_as_float(w.x & 0xffff0000u); v[d0][2] = __uint_as_float(w.y << 16); v[d0][3] = __uint_as_float(w.y & 0xffff0000u);
    v[d0][4] = __uint_as_float(w.z << 16); v[d0][5] = __uint_as_float(w.z & 0xffff0000u); v[d0][6] = __uint_as_float(w.w << 16); v[d0][7] = __uint_as_float(w.w & 0xffff0000u); }
  float mul = CS;
  if constexpr (DQK == 128) {
    float ss = 0.f;
#pragma unroll
    for (int d0 = 0; d0 < 8; ++d0)
#pragma unroll
      for (int j = 0; j < 8; ++j) ss += v[d0][j] * v[d0][j];
    ss += __shfl_xor(ss, 32);
    mul = CS / sqrtf(ss * (1.0f / 128.0f) + 1e-6f);
#pragma unroll
    for (int d0 = 0; d0 < 8; ++d0) { const f32x4q g0 = *(const f32x4q*)(gain + 16 * d0 + 8 * hi), g1 = *(const f32x4q*)(gain + 16 * d0 + 8 * hi + 4);
      v[d0][0] *= g0.x; v[d0][1] *= g0.y; v[d0][2] *= g0.z; v[d0][3] *= g0.w; v[d0][4] *= g1.x; v[d0][5] *= g1.y; v[d0][6] *= g1.z; v[d0][7] *= g1.w; }
  }
  if constexpr (DQK == 64) {
#pragma unroll
    for (int d0 = 0; d0 < 4; ++d0) {
      const f32x4q* tp = (const f32x4q*)(rope + ((size_t)s * 32 + 8 * d0 + 4 * hi) * 2);
      const f32x4q t0 = tp[0], t1 = tp[1];
      const float cs[4] = {t0.x, t0.z, t1.x, t1.z}, sn[4] = {t0.y, t0.w, t1.y, t1.w};
#pragma unroll
      for (int e = 0; e < 4; ++e) { const float x1 = v[d0][e], x2 = v[d0][4 + e]; v[d0][e] = x1 * cs[e] - x2 * sn[e]; v[d0][4 + e] = x2 * cs[e] + x1 * sn[e]; }
    }
  } else
#pragma unroll
  for (int blk = 0; blk < DQK / 64; ++blk) {
    const int pos = (DQK == 128) ? (blk == 0 ? (s >> 6) : (s & 63)) : s;
#pragma unroll
    for (int dd = 0; dd < 2; ++dd) {
      const f32x4q* tp = (const f32x4q*)(rope + ((size_t)pos * 32 + 16 * dd + 8 * hi) * 2);
      const f32x4q t0 = tp[0], t1 = tp[1], t2 = tp[2], t3 = tp[3];
      const float cs[8] = {t0.x, t0.z, t1.x, t1.z, t2.x, t2.z, t3.x, t3.z}, sn[8] = {t0.y, t0.w, t1.y, t1.w, t2.y, t2.w, t3.y, t3.w};
#pragma unroll
      for (int j = 0; j < 8; ++j) { const float x1 = v[4 * blk + dd][j], x2 = v[4 * blk + dd + 2][j];
        v[4 * blk + dd][j] = x1 * cs[j] - x2 * sn[j]; v[4 * blk + dd + 2][j] = x2 * cs[j] + x1 * sn[j]; }
    }
  }
#pragma unroll
  for (int d0 = 0; d0 < DQK / 16; ++d0) { u32x4 w = {cvtpk(v[d0][0] * mul, v[d0][1] * mul), cvtpk(v[d0][2] * mul, v[d0][3] * mul), cvtpk(v[d0][4] * mul, v[d0][5] * mul), cvtpk(v[d0][6] * mul, v[d0][7] * mul)};
    qr[d0] = *reinterpret_cast<bf16x8*>(&w); }
}

template <int DQK, int LDQ, int LDK, int LDV, int ABL = 0>
__device__ __forceinline__ void attn_pass(const bf16* __restrict__ Qb, const bf16* __restrict__ Kh, const bf16* __restrict__ Vh, int seq, char* lds, float* wsf, f32x16 (&o)[4], float (&rli)[16], const float* rope, const float* gain, int s0) {
  constexpr int SHM_K = KVBLK * (DQK * 2 + 16), NKF = DQK / 8;
  int tid_ = threadIdx.x; asm volatile("" : "+v"(tid_));
  const int tid = tid_, lane = tid & 63, r32 = lane & 31, hi = lane >> 5;
  const int wid = __builtin_amdgcn_readfirstlane(tid >> 6), grp = wid >> 2;
  char* V_lds = lds + OFF_V; char* K_lds = lds + OFF_K;
  float* al_l = wsf + 32;
  bf16x8 ek0, ev0, ev1, ek1;
  if constexpr (DQK == 64) {
    const unsigned koff_e = (unsigned)((tid >> 3) * LDK + (tid & 7) * 8) * 2u, voff_e = (unsigned)((tid >> 4) * LDV + (tid & 15) * 8) * 2u;
    const __amdgpu_buffer_rsrc_t krs_e = __builtin_amdgcn_make_buffer_rsrc((void*)Kh, 0, 0x7fffffff, 0x00020000), vrs_e = __builtin_amdgcn_make_buffer_rsrc((void*)Vh, 0, 0x7fffffff, 0x00020000);
    ek0 = __builtin_bit_cast(bf16x8, __builtin_amdgcn_raw_buffer_load_b128(krs_e, koff_e, 0, 0));
    ev0 = __builtin_bit_cast(bf16x8, __builtin_amdgcn_raw_buffer_load_b128(vrs_e, voff_e, 0, 0));
    ev1 = __builtin_bit_cast(bf16x8, __builtin_amdgcn_raw_buffer_load_b128(vrs_e, voff_e, (unsigned)(32 * LDV * 2), 0));
    ek1 = __builtin_bit_cast(bf16x8, __builtin_amdgcn_raw_buffer_load_b128(krs_e, koff_e, (unsigned)(KVBLK * LDK * 2), 0));
  }
  bf16x8 qr[DQK / 16];
  const bf16* Qw = Qb + (long)(wid * QBLK + r32) * LDQ + hi * 8;
#pragma unroll
  for (int d0 = 0; d0 < DQK / 16; ++d0) qr[d0] = *reinterpret_cast<const bf16x8*>(Qw + d0 * 16);
  q_prepare<DQK>(qr, rope, gain, s0 + wid * QBLK + r32, hi);
#pragma unroll
  for (int d0 = 0; d0 < DQK / 16; ++d0) asm volatile("" : "+v"(qr[d0]));
  f32x16 lacc = f32x16{}, negm = f32x16{}; asm volatile("" : "+v"(lacc));
#pragma unroll
  for (int d = 0; d < 4; ++d) o[d] = f32x16{};
  const int sr = tid >> 4, sc = (tid & 15) * 8, vst0 = v_st(sr, sc), vst1 = v_st(32 + sr, sc);
  const int kr = (DQK == 128) ? sr : (tid >> 3), kc = (DQK == 128) ? sc : (tid & 7) * 8;
  const int vb0 = (int)(uintptr_t)V_lds + v_rd_base(lane);
  bf16x8 sv0, sv1, sk0, sk1;
  const unsigned koff = (unsigned)(kr * LDK + kc) * 2u, voff = (unsigned)(sr * LDV + sc) * 2u;
  const __amdgpu_buffer_rsrc_t krs = __builtin_amdgcn_make_buffer_rsrc((void*)Kh, 0, 0x7fffffff, 0x00020000), vrs = __builtin_amdgcn_make_buffer_rsrc((void*)Vh, 0, 0x7fffffff, 0x00020000);
#define ATT_LOAD_K(t) do { const unsigned so_ = (unsigned)(t) * (unsigned)(KVBLK * LDK * 2); sk0 = __builtin_bit_cast(bf16x8, __builtin_amdgcn_raw_buffer_load_b128(krs, koff, so_, 0)); \
    if constexpr (DQK == 128) sk1 = __builtin_bit_cast(bf16x8, __builtin_amdgcn_raw_buffer_load_b128(krs, koff, so_ + (unsigned)(32 * LDK * 2), 0)); } while (0)
#define ATT_LOAD_V(t) do { const unsigned so_ = (unsigned)(t) * (unsigned)(KVBLK * LDV * 2); sv0 = __builtin_bit_cast(bf16x8, __builtin_amdgcn_raw_buffer_load_b128(vrs, voff, so_, 0)); \
    sv1 = __builtin_bit_cast(bf16x8, __builtin_amdgcn_raw_buffer_load_b128(vrs, voff, so_ + (unsigned)(32 * LDV * 2), 0)); } while (0)
#define ATT_WRITE_K(so) do { *(bf16x8*)(K_lds + (so) + kswz<DQK>(kr, kc * 2)) = sk0; if constexpr (DQK == 128) *(bf16x8*)(K_lds + (so) + kswz<DQK>(32 + kr, kc * 2)) = sk1; } while (0)
#define ATT_WRITE_V(so) do { *(bf16x8*)(V_lds + (so) + vst0) = sv0; *(bf16x8*)(V_lds + (so) + vst1) = sv1; } while (0)
#define ATT_BAR() do { ATT_SBAR(); asm volatile("s_barrier" ::: "memory"); ATT_SBAR(); } while (0)
#define ATT_RESC(a) do { if (__any((a) < 1.f)) { if (hi == 0) al_l[r32] = (a); asm volatile("s_waitcnt lgkmcnt(0)" ::: "memory"); \
    _Pragma("unroll") for (int r = 0; r < 16; ++r) { const float f_ = al_l[crow(r, hi)]; lacc[r] *= f_; _Pragma("unroll") for (int d = 0; d < 4; ++d) o[d][r] *= f_; } } } while (0)
#define ATT_SOFTMAX(first_) do { const float pm_ = softmax_rowmax(p0, p1); \
    if (__builtin_expect((first_) || !__all(pm_ <= THRL), 0)) { const float al_ = softmax_shift(p0, p1, negm, pm_, (first_)); ATT_RESC(al_); } \
    softmax_exp_pack(p0, p1, pa0, pa1, pa2, pa3); } while (0)
#define ATT_MF(A_, B_, C_) do { if constexpr (ABL & 2) { asm volatile("" :: "v"(A_), "v"(B_)); } else { C_ = __builtin_amdgcn_mfma_f32_32x32x16_bf16(A_, B_, C_, 0, 0, 0); } } while (0)
#define ATT_VF(buf, ks) (bf16x8){buf[2 * ks][0], buf[2 * ks][1], buf[2 * ks][2], buf[2 * ks][3], buf[2 * ks + 1][0], buf[2 * ks + 1][1], buf[2 * ks + 1][2], buf[2 * ks + 1][3]}
  const int NT = seq / KVBLK;
  f32x16 p0, p1; bf16x8 pa0, pa1, pa2, pa3;
  bf16x8 ones = {0x3F80, 0x3F80, 0x3F80, 0x3F80, 0x3F80, 0x3F80, 0x3F80, 0x3F80};
  asm volatile("" : "+v"(ones));
  if constexpr (DQK == 64) { sk0 = ek0; sv0 = ev0; sv1 = ev1; ATT_WRITE_K(0); ATT_WRITE_V(0); sk0 = ek1; ATT_WRITE_K(SHM_K); }
  else { ATT_LOAD_K(0); ATT_LOAD_V(0); ATT_WRITE_K(0); ATT_WRITE_V(0);
         ATT_LOAD_K(1); ATT_WRITE_K(SHM_K); }
  ATT_LOAD_K(2); ATT_LOAD_V(1);
  asm volatile("s_waitcnt lgkmcnt(0)" ::: "memory"); ATT_BAR();
  if (grp == 1) ATT_BAR();
  qkt<DQK>(p0, p1, K_lds, qr, r32, hi);
  ATT_BAR();
  int k1 = SHM_K, k2 = 2 * SHM_K, k0 = 0, v0 = 0, v1 = SHM_V, v2 = 2 * SHM_V;
  const lds_cptr kq0 = (lds_cptr)K_lds, vq0 = (lds_cptr)V_lds + v_rd_base(lane);
  bf16x8 kf[8]; s16x4 va[8], vc[8];
#define ATT_KFRAG(i, so) do { if constexpr (!(ABL & 8) && !(ABL & 16)) { const int d0_ = (i) >> 1, cb_ = (d0_ * 16 + hi * 8) * 2; kf[(i) & 7] = *(const __attribute__((address_space(3))) bf16x8*)(kq0 + (so) + kswz<DQK>(((i) & 1) * 32 + r32, cb_)); } } while (0)
#define ATT_VPAIR(buf, so, blk, ks) do { if constexpr (!(ABL & 8) && !(ABL & 32)) { buf[2 * (ks)] = vtr(vq0 + (so) + v_rd_off(blk, ks, 0)); buf[2 * (ks) + 1] = vtr(vq0 + (so) + v_rd_off(blk, ks, 1)); } } while (0)
#define ATT_PA(ks) ((ks) == 0 ? pa0 : (ks) == 1 ? pa1 : (ks) == 2 ? pa2 : pa3)
#define ATT_XSECTION(WITH_QK) do { __builtin_amdgcn_s_setprio(2); \
    _Pragma("unroll") for (int g = 0; g < 20; ++g) { const int blk = g >> 2, ks = g & 3; \
      if (blk == 4) { ATT_MF(ATT_PA(ks), ones, lacc); } \
      else if (blk == 0 || blk == 2) { ATT_MF(ATT_PA(ks), ATT_VF(va, ks), o[blk]); } \
      else { ATT_MF(ATT_PA(ks), ATT_VF(vc, ks), o[blk]); } \
      if (blk < 3) { if (blk == 0 || blk == 2) ATT_VPAIR(vc, v0, blk + 1, ks); else ATT_VPAIR(va, v0, blk + 1, ks); } \
      if (WITH_QK) { if (g >= 12 && g - 12 < NKF) ATT_KFRAG(g - 12, k1); } \
      ATT_SBAR(); } \
    if (WITH_QK) { _Pragma("unroll") for (int i = 0; i < NKF; ++i) { \
      if (i < 2) { if (i == 0) { if constexpr (ABL & 2) { asm volatile("" :: "v"(kf[0])); p0 = negm; } else p0 = __builtin_amdgcn_mfma_f32_32x32x16_bf16(kf[0], qr[0], negm, 0, 0, 0); } \
                   else        { if constexpr (ABL & 2) { asm volatile("" :: "v"(kf[1])); p1 = negm; } else p1 = __builtin_amdgcn_mfma_f32_32x32x16_bf16(kf[1], qr[0], negm, 0, 0, 0); } } \
      else if (i & 1) { ATT_MF(kf[i & 7], qr[i >> 1], p1); } else { ATT_MF(kf[i & 7], qr[i >> 1], p0); } \
      if (i + 8 < NKF) ATT_KFRAG(i + 8, k1); \
      ATT_SBAR(); } } __builtin_amdgcn_s_setprio(0); } while (0)
  for (int t = 0; t + 1 < NT; ++t) {
    if constexpr (ABL & 1) { u32x4 w0 = {cvtpk(p0[0], p0[1]), cvtpk(p0[2], p0[3]), cvtpk(p0[4], p0[5]), cvtpk(p0[6], p0[7])}, w1 = {cvtpk(p0[8], p0[9]), cvtpk(p0[10], p0[11]), cvtpk(p0[12], p0[13]), cvtpk(p0[14], p0[15])};
        u32x4 w2 = {cvtpk(p1[0], p1[1]), cvtpk(p1[2], p1[3]), cvtpk(p1[4], p1[5]), cvtpk(p1[6], p1[7])}, w3 = {cvtpk(p1[8], p1[9]), cvtpk(p1[10], p1[11]), cvtpk(p1[12], p1[13]), cvtpk(p1[14], p1[15])};
        pa0 = *reinterpret_cast<bf16x8*>(&w0); pa1 = *reinterpret_cast<bf16x8*>(&w1); pa2 = *reinterpret_cast<bf16x8*>(&w2); pa3 = *reinterpret_cast<bf16x8*>(&w3); }
    else { ATT_SOFTMAX(t == 0); }
    if constexpr (!(ABL & 4)) { ATT_WRITE_K(k2); ATT_WRITE_V(v1); }
    ATT_SBAR();
#pragma unroll
    for (int ks = 0; ks < 4; ++ks) ATT_VPAIR(va, v0, 0, ks);
    asm volatile("s_waitcnt lgkmcnt(8)" ::: "memory"); ATT_BAR();
    ATT_XSECTION(true);
    if constexpr (!(ABL & 4)) { const int tk = (t + 3 < NT) ? t + 3 : NT - 1, tv = (t + 2 < NT) ? t + 2 : NT - 1; ATT_LOAD_K(tk); ATT_LOAD_V(tv); }
    ATT_BAR();
    { const int tk_ = k0; k0 = k1; k1 = k2; k2 = tk_; const int tv_ = v0; v0 = v1; v1 = v2; v2 = tv_; }
  }
  ATT_SOFTMAX(false);
#pragma unroll
  for (int ks = 0; ks < 4; ++ks) ATT_VPAIR(va, v0, 0, ks);
  asm volatile("s_waitcnt lgkmcnt(0)" ::: "memory"); ATT_BAR();
  ATT_XSECTION(false);
  ATT_BAR();
  if (grp == 0) ATT_BAR();
#pragma unroll
  for (int r = 0; r < 16; ++r) rli[r] = __builtin_amdgcn_rcpf(lacc[r]);
#undef ATT_LOAD_K
#undef ATT_LOAD_V
#undef ATT_WRITE_K
#undef ATT_WRITE_V
#undef ATT_BAR
#undef ATT_RESC
#undef ATT_SOFTMAX
#undef ATT_MF
#undef ATT_VF
#undef ATT_KFRAG
#undef ATT_VPAIR
#undef ATT_PA
#undef ATT_XSECTION
}
}

constexpr int NWAVES = 8;
constexpr int DM = 2048, BATCH = 4, SEQ = 8192, T = BATCH * SEQ;
constexpr int NCOL1 = 4608 + 4096;
constexpr int NEXP = 32, FF = 512, LCAP = 32768;
constexpr int PMAX = 288;
constexpr float EPS = 1e-6f;
constexpr float LAM_INIT = 0.2f;
#ifndef MK_ONE_LAUNCH
#define MK_ONE_LAUNCH 1
#endif
constexpr int N_PHASES = 10;
#ifndef ATT_DUMMY
#define ATT_DUMMY -1
#define ATT_DUMMY_B 0
#endif
#ifndef PROBE_MASK
#define PROBE_MASK 0
#define PROBE_MUL 1
#define PROBE_BLOCK 0
#endif

constexpr size_t MiB = 1u << 20;
constexpr size_t WS_CTL = 0, CTL_ZERO_BYTES = 1 * MiB;
constexpr size_t WS_ROPE = 2 * MiB;
constexpr size_t WS_WRT = 4 * MiB;
constexpr size_t WS_TOKROW = 5 * MiB;
constexpr size_t WS_LR = 8 * MiB;
constexpr size_t WS_WIN = 8 * MiB;
constexpr size_t WS_WA = 42 * MiB, WS_WB = 46 * MiB, WS_WO = 50 * MiB;
constexpr size_t WS_W13 = 58 * MiB;
constexpr size_t WS_W2 = 186 * MiB;
constexpr size_t WS_SSQ = 250 * MiB;
constexpr size_t WS_LENT = 254 * MiB, WS_LW = 258 * MiB;
constexpr size_t WS_XN = 264 * MiB;
constexpr size_t WS_QA = 392 * MiB, WS_KA = 456 * MiB, WS_VA = 472 * MiB, WS_QB = 488 * MiB, WS_KB = 552 * MiB, WS_VB = 616 * MiB;
constexpr size_t WS_XG = 392 * MiB;
constexpr size_t WS_GT = 680 * MiB;
constexpr size_t WS_X1B = 264 * MiB;
constexpr size_t WS_U = 680 * MiB;
constexpr size_t WS_YC = WS_XG;
constexpr size_t WS_END = 936 * MiB;
constexpr int CW_CNT = 64;
constexpr int CW_CONV = 200;
constexpr int CW_TEAM = 1024;
constexpr int CW_BAR = 4096;

constexpr int SCR_OFF = 0, SCR_BYTES = 143360;
constexpr int AWS_OFF = 143360;
constexpr int MOE_OFF = AWS_OFF + 2048;
constexpr int MISC_OFF = MOE_OFF + 512;
constexpr int LDS_BYTES = 147456;
static_assert(MISC_OFF + 128 <= LDS_BYTES, "LDS map");

#define GAS __attribute__((address_space(1)))
#define LAS __attribute__((address_space(3)))
typedef unsigned short bf16;
typedef unsigned v4u __attribute__((ext_vector_type(4)));
typedef unsigned v2u __attribute__((ext_vector_type(2)));
typedef float f32x4 __attribute__((ext_vector_type(4)));
typedef short bf16x8 __attribute__((ext_vector_type(8)));
typedef GAS unsigned gu32;
#define RLX_AGENT __ATOMIC_RELAXED, __HIP_MEMORY_SCOPE_AGENT
#define LDS_WAIT() asm volatile("s_waitcnt lgkmcnt(0)" ::: "memory")
#define VM_WAIT() asm volatile("s_waitcnt vmcnt(0)" ::: "memory")
__device__ __forceinline__ unsigned f2bf(float f) { unsigned u = __builtin_bit_cast(unsigned, f); return (u + 0x7fffu + ((u >> 16) & 1u)) >> 16; }
__device__ __forceinline__ unsigned pk2(float lo, float hi) { return f2bf(lo) | (f2bf(hi) << 16); }
__device__ __forceinline__ float bflo(unsigned w) { return __uint_as_float(w << 16); }
__device__ __forceinline__ float bfhi(unsigned w) { return __uint_as_float(w & 0xffff0000u); }
__device__ __forceinline__ float wave_sum(float v) {
#pragma unroll
    for (int o = 1; o < 64; o <<= 1) v += __shfl_xor(v, o);
    return v;
}

#define XB_TMO      128
#define XB_XCNT(j)  (256  + 64 * (j))
#define XB_XSUB(j)  (1280 + 64 * (j))
#define XB_XGEN(j)  (2304 + 64 * (j))
#define XB_TOP      3328
#define XB_TOPGEN   3392
#define XCD_BAR_WORDS 3456
#define XB_SPIN_CAP (1u << 18)

__device__ __forceinline__ unsigned xb_ld(unsigned* p)              { return __hip_atomic_load(p, __ATOMIC_RELAXED, __HIP_MEMORY_SCOPE_AGENT); }
__device__ __forceinline__ unsigned xb_add(unsigned* p, unsigned v) { return __hip_atomic_fetch_add(p, v, __ATOMIC_RELAXED, __HIP_MEMORY_SCOPE_AGENT); }
__device__ __forceinline__ unsigned xb_xcc_id() { return (unsigned)__builtin_amdgcn_s_getreg((3 << 11) | 20) & 0xFu; }
#define XB_SPIN(cond, bar) do { unsigned _sp = 0; while (cond) { __builtin_amdgcn_s_sleep(1); \
    if ((++_sp & 255u) == 0u) { if (xb_ld(&(bar)[XB_TMO])) break; if (_sp > XB_SPIN_CAP) { atomicAdd(&(bar)[XB_TMO], 1u); break; } } } } while (0)

struct XcdBarrier {
    unsigned* bar; unsigned x;
    volatile LAS unsigned* st;
};

__device__ __forceinline__ XcdBarrier xcd_barrier_post(unsigned* bar, volatile LAS unsigned* st) {
    XcdBarrier b; b.bar = bar; b.x = xb_xcc_id(); b.st = st;
    if (threadIdx.x == 0) (void)xb_add(&bar[XB_XCNT(b.x)], 1u);
    return b;
}
__device__ __forceinline__ void xcd_barrier_complete(unsigned* bar, unsigned x, unsigned& nloc, unsigned& nx) {
    const unsigned G = gridDim.x * gridDim.y * gridDim.z;
    unsigned sum, cnt, mine, sp = 0u;
    for (;;) {
        sum = 0u; cnt = 0u; mine = 0u;
#pragma unroll
        for (unsigned j = 0; j < 16; ++j) { const unsigned c = xb_ld(&bar[XB_XCNT(j)]); sum += c; cnt += (c > 0u) ? 1u : 0u; mine = (j == x) ? c : mine; }
        if (sum == G) break;
        __builtin_amdgcn_s_sleep(1);
        if ((++sp & 255u) == 0u) { if (xb_ld(&bar[XB_TMO])) break; if (sp > XB_SPIN_CAP) { atomicAdd(&bar[XB_TMO], 1u); break; } }
    }
    nloc = mine > 0u ? mine : 1u; nx = cnt > 0u ? cnt : 1u;
}

__device__ __forceinline__ void xcd_barrier(const XcdBarrier& b) {
    asm volatile("s_waitcnt vmcnt(0)" ::: "memory");
    __syncthreads();
    if (threadIdx.x == 0) {
        unsigned* bar = b.bar;
        __builtin_amdgcn_s_waitcnt(0);
        unsigned nloc = b.st[0], nx = b.st[1];
        if (nloc == 0u) { xcd_barrier_complete(bar, b.x, nloc, nx); b.st[0] = nloc; b.st[1] = nx; }
        const unsigned old = xb_add(&bar[XB_XSUB(b.x)], 1u);
        const unsigned gen = old / nloc;
        if (old + 1u == (gen + 1u) * nloc) {
            __builtin_amdgcn_fence(__ATOMIC_RELEASE, "agent");
            asm volatile("s_waitcnt vmcnt(0)" ::: "memory");
            const unsigned og = xb_add(&bar[XB_TOP], 1u);
            const unsigned tg = og / nx;
            if (og + 1u == (tg + 1u) * nx) xb_add(&bar[XB_TOPGEN], 1u);
            else XB_SPIN(xb_ld(&bar[XB_TOPGEN]) == tg, bar);
            __builtin_amdgcn_fence(__ATOMIC_ACQUIRE, "agent");
            xb_add(&bar[XB_XGEN(b.x)], 1u);
            asm volatile("s_waitcnt vmcnt(0)" ::: "memory");
        } else {
            XB_SPIN(xb_ld(&bar[XB_XGEN(b.x)]) == gen, bar);
            __builtin_amdgcn_fence(__ATOMIC_ACQUIRE, "agent");
            asm volatile("s_waitcnt vmcnt(0)" ::: "memory");
        }
    }
    __syncthreads();
}

struct Args { const float* in[22]; float* out; unsigned char* ws; int ph_lo, ph_hi, li, pad; };
struct Frame { unsigned char* lds; int tid, lane, wave, vcu, G, gw, NGW; };
typedef const Args __attribute__((address_space(4)))* KArgs;
#define FRESH_ARGS() ({ KArgs p_ = (KArgs)__builtin_amdgcn_kernarg_segment_ptr(); asm volatile("" : "+s"(p_)); p_; })

__device__ __forceinline__ void p0_transpose_item(const float* W, int N, int k0, int n0, bf16* WT, int K, int dst_row0, LAS float* scr, int lane, const float* kscale = nullptr, int permhalf = -1) {
    typedef float f32x4t __attribute__((ext_vector_type(4)));
    const int c = lane & 7;
    float ks[8];
#pragma unroll
    for (int i = 0; i < 8; ++i) ks[i] = kscale ? kscale[k0 + 8 * c + i] : 1.0f;
#pragma unroll
    for (int i = 0; i < 8; ++i) { const int kk = 8 * i + (lane >> 3), nn = (lane & 7) * 4;
        *(LAS f32x4t*)(scr + kk * 36 + nn) = *(const GAS f32x4t*)(W + (size_t)(k0 + kk) * N + n0 + nn); }
    LDS_WAIT(); asm volatile("" ::: "memory");
#pragma unroll
    for (int j = 0; j < 4; ++j) { const int n = (lane >> 3) + 8 * j; const LAS float* s = scr + (8 * c) * 36 + n;
        v4u o; o.x = pk2(s[0 * 36] * ks[0], s[1 * 36] * ks[1]); o.y = pk2(s[2 * 36] * ks[2], s[3 * 36] * ks[3]); o.z = pk2(s[4 * 36] * ks[4], s[5 * 36] * ks[5]); o.w = pk2(s[6 * 36] * ks[6], s[7 * 36] * ks[7]);
        const int drow = permhalf < 0 ? n : (32 * (n >> 4) + 8 * ((n >> 2) & 3) + 4 * permhalf + (n & 3));
        *(GAS v4u*)(WT + (size_t)(dst_row0 + drow) * K + k0 + 8 * c) = o; }
    LDS_WAIT(); asm volatile("" ::: "memory");
}
constexpr int CONV_IE = 32 * 512, N_CONV = 3 * CONV_IE;
__device__ __forceinline__ void conv_item(KArgs a, int r, LAS float* scr, int lane) {
    unsigned char* ws = a->ws;
    if (r < CONV_IE) { const int e = r / 512, q = r % 512, kb = q / 16, nb = q % 16, n0 = 32 * nb;
        p0_transpose_item(a->in[18] + (size_t)e * 2048 * 512, 512, 64 * kb, n0, (bf16*)(ws + WS_W13), 2048, e * 1024 + (n0 >> 7) * 256 + (n0 & 127), scr, lane, a->in[15]); return; } r -= CONV_IE;
    if (r < CONV_IE) { const int e = r / 512, q = r % 512, kb = q / 16, nb = q % 16, n0 = 32 * nb;
        p0_transpose_item(a->in[19] + (size_t)e * 2048 * 512, 512, 64 * kb, n0, (bf16*)(ws + WS_W13), 2048, e * 1024 + (n0 >> 7) * 256 + 128 + (n0 & 127), scr, lane, a->in[15]); return; } r -= CONV_IE;
    { const int e = r / 512, q = r % 512, kb = q / 64, nb = q % 64;
      p0_transpose_item(a->in[20] + (size_t)e * 512 * 2048, 2048, 64 * kb, 32 * nb, (bf16*)(ws + WS_W2), 512, e * 2048 + 32 * nb, scr, lane); }
}
constexpr int CONV_CHUNK = 16;
__device__ __forceinline__ void conv_next_chunk(KArgs a, int lane, int& cur, int& end) {
    unsigned r = 0; if (lane == 0) r = __hip_atomic_fetch_add((unsigned*)(a->ws + WS_CTL) + CW_CONV, (unsigned)CONV_CHUNK, RLX_AGENT);
    r = (unsigned)__builtin_amdgcn_readfirstlane(r);
    cur = r < (unsigned)N_CONV ? (int)r : N_CONV; end = (cur + CONV_CHUNK < N_CONV) ? cur + CONV_CHUNK : N_CONV;
}
__device__ __forceinline__ void conv_drain(const Frame& F, KArgs a, volatile LAS unsigned* park, int limit) {
    LAS float* scr = (LAS float*)((LAS unsigned char*)F.lds + SCR_OFF + F.wave * 16384);
    int cur = (int)park[0], end = (int)park[1];
    for (;;) {
        if (cur >= end) {
            if ((int)__hip_atomic_load((unsigned*)(a->ws + WS_CTL) + CW_CONV, RLX_AGENT) >= limit) break;
            conv_next_chunk(a, F.lane, cur, end); if (cur >= end) break; }
        if (cur >= limit) break;
        conv_item(a, cur, scr, F.lane); ++cur; }
    if (F.lane == 0) { park[0] = (unsigned)cur; park[1] = (unsigned)end; }
}
__device__ __forceinline__ void xcd_barrier_working(const XcdBarrier& b, const Frame& F, KArgs a, volatile LAS unsigned* flag, volatile LAS unsigned* park) {
    asm volatile("s_waitcnt vmcnt(0)" ::: "memory");
    if (threadIdx.x == 0) flag[0] = 0u;
    __syncthreads();
    if (F.wave == 0) {
      if (threadIdx.x == 0) {
        unsigned* bar = b.bar;
        __builtin_amdgcn_s_waitcnt(0);
        unsigned nloc = b.st[0], nx = b.st[1];
        if (nloc == 0u) { xcd_barrier_complete(bar, b.x, nloc, nx); b.st[0] = nloc; b.st[1] = nx; }
        const unsigned old = xb_add(&bar[XB_XSUB(b.x)], 1u);
        const unsigned gen = old / nloc;
        if (old + 1u == (gen + 1u) * nloc) {
            __builtin_amdgcn_fence(__ATOMIC_RELEASE, "agent");
            asm volatile("s_waitcnt vmcnt(0)" ::: "memory");
            const unsigned og = xb_add(&bar[XB_TOP], 1u);
            const unsigned tg = og / nx;
            if (og + 1u == (tg + 1u) * nx) xb_add(&bar[XB_TOPGEN], 1u);
            else XB_SPIN(xb_ld(&bar[XB_TOPGEN]) == tg, bar);
            __builtin_amdgcn_fence(__ATOMIC_ACQUIRE, "agent");
            xb_add(&bar[XB_XGEN(b.x)], 1u);
            asm volatile("s_waitcnt vmcnt(0)" ::: "memory");
        } else {
            XB_SPIN(xb_ld(&bar[XB_XGEN(b.x)]) == gen, bar);
            __builtin_amdgcn_fence(__ATOMIC_ACQUIRE, "agent");
            asm volatile("s_waitcnt vmcnt(0)" ::: "memory");
        }
        *flag = 1u;
      }
    } else {
        LAS float* scr = (LAS float*)((LAS unsigned char*)F.lds + SCR_OFF + F.wave * 16384);
        int cur = 0, end = 0; bool more = true;
        for (;;) {
            if (flag[0] != 0u) break;
            if (more && cur >= end) { conv_next_chunk(a, F.lane, cur, end); more = cur < end; }
            if (more) { conv_item(a, cur, scr, F.lane); ++cur; }
            else __builtin_amdgcn_s_sleep(4);
        }
        if (F.lane == 0) { park[0] = (unsigned)cur; park[1] = (unsigned)end; }
    }
    if (F.wave == 0 && F.lane == 1) { park[0] = 0u; park[1] = 0u; }
    __syncthreads();
}

__device__ __forceinline__ void p0_prologue(const Frame& F, KArgs a) {
    unsigned char* ws = a->ws;
    LAS float* scr = (LAS float*)((LAS unsigned char*)F.lds + SCR_OFF + F.wave * 16384);
    constexpr int I_IN = 32 * 144, I_GT = 32 * 128, I_BA = 16 * 64, I_WO = 32 * 64;
    constexpr int NITEMS = I_IN + I_GT + 2 * I_BA + I_WO;
    for (int it = F.gw; it < NITEMS; it += F.NGW) {
        int r = it;
        if (r < I_IN) { const int kb = r / 144, nb = r % 144, n0 = 32 * nb; const bool pb = n0 >= 1536 && n0 < 3584;
                        p0_transpose_item(a->in[2], 4608, 64 * kb, n0, (bf16*)(ws + WS_WIN), 2048, pb ? (n0 & ~63) : n0, scr, F.lane, nullptr, pb ? ((n0 >> 5) & 1) : -1); continue; } r -= I_IN;
        if (r < I_GT) { const int kb = r / 128, nb = r % 128, n0 = 32 * nb;
                        p0_transpose_item(a->in[12], 4096, 64 * kb, n0, (bf16*)(ws + WS_WIN), 2048, 4608 + 256 * ((n0 & 2047) >> 7) + 128 * (n0 >> 11) + (n0 & 127), scr, F.lane); continue; } r -= I_GT;
        if (r < I_BA) { const int kb = r / 64, nb = r % 64; p0_transpose_item(a->in[10], 2048, 64 * kb, 32 * nb, (bf16*)(ws + WS_WA), 2048, 32 * nb, scr, F.lane); continue; } r -= I_BA;
        if (r < I_BA) { const int kb = r / 64, nb = r % 64; p0_transpose_item(a->in[11], 2048, 64 * kb, 32 * nb, (bf16*)(ws + WS_WA) + 1024, 2048, 32 * nb, scr, F.lane); continue; } r -= I_BA;
        { const int kb = r / 64, nb = r % 64; p0_transpose_item(a->in[14], 2048, 64 * kb, 32 * nb, (bf16*)(ws + WS_WO), 2048, 32 * nb, scr, F.lane); }
    }
    { float2* tab = (float2*)(ws + WS_ROPE);
      for (int idx = F.gw * 64 + F.lane; idx < SEQ * 32; idx += F.NGW * 64) { const int pos = idx >> 5, i = idx & 31;
          const float inv = powf(10000.0f, -(float)(2 * i) / 64.0f); const float ang = (float)pos * inv;
          double s, c; sincos((double)ang, &s, &c); tab[idx] = make_float2((float)c, (float)s); } }
    { bf16* wh = (bf16*)(ws + WS_WRT); bf16* wl = wh + 48 * 2048;
      for (int idx = F.gw * 64 + F.lane; idx < 48 * 2048; idx += F.NGW * 64) { const int c = idx >> 11, k = idx & 2047;
          const float v = (c < 4 ? a->in[16][k * 4 + c] : (c < 36 ? a->in[17][k * 32 + (c - 4)] : 0.f)) * a->in[15][k];
          const unsigned h = f2bf(v); const float hf = __uint_as_float(h << 16); wh[idx] = (bf16)h; wl[idx] = (bf16)f2bf(v - hf); } }
    { const float* x = a->in[0]; const GAS f32x4* g4 = (const GAS f32x4*)a->in[1] + F.lane; bf16* XN = (bf16*)(ws + WS_XN);
      for (int m = F.gw; m < T; m += F.NGW) {
          const GAS f32x4* xr = (const GAS f32x4*)(x + (size_t)m * DM) + F.lane; f32x4 v[8]; float s = 0.f;
#pragma unroll
          for (int j = 0; j < 8; ++j) { v[j] = xr[64 * j]; s += (v[j].x * v[j].x + v[j].y * v[j].y) + (v[j].z * v[j].z + v[j].w * v[j].w); }
          const float rstd = 1.0f / sqrtf(wave_sum(s) * (1.0f / DM) + EPS);
          GAS v2u* o8 = (GAS v2u*)(XN + (size_t)m * DM) + F.lane;
#pragma unroll
          for (int j = 0; j < 8; ++j) { const f32x4 g = g4[64 * j]; v2u w; w.x = pk2(v[j].x * rstd * g.x, v[j].y * rstd * g.y); w.y = pk2(v[j].z * rstd * g.z, v[j].w * rstd * g.w); o8[64 * j] = w; } } }
}

__device__ __forceinline__ void rope8(float (&v)[8], const float2* tab, int pos, int cc) {
    const GAS f32x4* tp = (const GAS f32x4*)(tab + (size_t)pos * 32 + 8 * (cc & 3));
    const f32x4 t0 = tp[0], t1 = tp[1], t2 = tp[2], t3 = tp[3];
    const float cs[8] = {t0.x, t0.z, t1.x, t1.z, t2.x, t2.z, t3.x, t3.z}, sn[8] = {t0.y, t0.w, t1.y, t1.w, t2.y, t2.w, t3.y, t3.w};
    const float sg = (cc & 4) ? 1.f : -1.f;
#pragma unroll
    for (int e = 0; e < 8; ++e) { const float p = __shfl_xor(v[e], 4); v[e] = v[e] * cs[e] + sg * p * sn[e]; }
}
__device__ __forceinline__ void unpack8(const v4u w, float (&v)[8]) { v[0] = bflo(w.x); v[1] = bfhi(w.x); v[2] = bflo(w.y); v[3] = bfhi(w.y); v[4] = bflo(w.z); v[5] = bfhi(w.z); v[6] = bflo(w.w); v[7] = bfhi(w.w); }
__device__ __forceinline__ v4u pack8(const float (&v)[8]) { v4u w; w.x = pk2(v[0], v[1]); w.y = pk2(v[2], v[3]); w.z = pk2(v[4], v[5]); w.w = pk2(v[6], v[7]); return w; }
__device__ __forceinline__ void p1b_normrope(const Frame& F, KArgs a) {
    unsigned char* ws = a->ws; const float2* tab = (const float2*)(ws + WS_ROPE);
    bf16* KA = (bf16*)(ws + WS_KA); bf16* KB = (bf16*)(ws + WS_KB);
    const float* kg = a->in[4];
    const int cc16 = F.lane & 15;
    float gk[8];
#pragma unroll
    for (int e = 0; e < 8; ++e) gk[e] = kg[cc16 * 8 + e];
    for (int tA = F.gw; tA < T; tA += 2 * F.NGW) {
        const int tB = (tA + F.NGW < T) ? tA + F.NGW : tA;
        v4u raw[2][3];
#pragma unroll
        for (int u = 0; u < 2; ++u) { const int t = u ? tB : tA;
            raw[u][0] = *(const GAS v4u*)(KA + (size_t)t * 256 + (F.lane & 31) * 8);
            }
#pragma unroll
        for (int u = 0; u < 2; ++u) { const int t = u ? tB : tA;
            if (u == 1 && tB == tA) break;
            const int s = t & (SEQ - 1), prow = s >> 6, pcol = s & 63;
            const int posA = (cc16 < 8) ? prow : pcol;
            {
                bf16* p = KA + (size_t)t * 256 + (F.lane & 31) * 8;
                float v[8]; unpack8(raw[u][0], v);
                float ss = 0.f;
#pragma unroll
                for (int e = 0; e < 8; ++e) ss += v[e] * v[e];
                ss += __shfl_xor(ss, 1); ss += __shfl_xor(ss, 2); ss += __shfl_xor(ss, 4); ss += __shfl_xor(ss, 8);
                const float rstd = 1.0f / sqrtf(ss * (1.0f / 128.0f) + EPS);
#pragma unroll
                for (int e = 0; e < 8; ++e) v[e] = v[e] * rstd * gk[e];
                rope8(v, tab, posA, cc16 & 7);
                if (F.lane < 32) *(GAS v4u*)p = pack8(v);
            }
        }
    }
}

template <int ABL = 0> __device__ __forceinline__ void attn_unit_A(const Frame& F, KArgs a, int b, int h, int qb, att::bf16* Obase) {
    using namespace att;
    int tid_ = threadIdx.x; asm volatile("" : "+v"(tid_));
    const int lane_ = tid_ & 63, wave_ = __builtin_amdgcn_readfirstlane(tid_ >> 6);
    unsigned char* ws = a->ws; char* lds = (char*)F.lds + SCR_OFF; float* wsf = (float*)((char*)F.lds + AWS_OFF) + wave_ * 64;
    const int r32 = lane_ & 31, hi = lane_ >> 5, kvh = h >> 2;
    const att::bf16* Qb = (const att::bf16*)(ws + WS_QA) + ((size_t)b * SEQ + (size_t)qb * 256) * 1024 + h * 128;
    const att::bf16* Kh = (const att::bf16*)(ws + WS_KA) + (size_t)b * SEQ * 256 + kvh * 128;
    const att::bf16* Vh = (const att::bf16*)(ws + WS_VA) + (size_t)b * SEQ * 256 + kvh * 128;
    f32x16 o[4]; float rli[16];
    attn_pass<128, 1024, 256, 256, ABL>(Qb, Kh, Vh, SEQ, lds, wsf, o, rli, (const float*)(ws + WS_ROPE), a->in[3], qb * 256);
    att::bf16* Ow = Obase + ((size_t)b * SEQ + (size_t)qb * 256 + wave_ * 32) * 2048 + h * 128;
#pragma unroll
    for (int r = 0; r < 16; ++r) { const int orow = crow(r, hi);
#pragma unroll
        for (int d0 = 0; d0 < 4; ++d0) Ow[(size_t)orow * 2048 + d0 * 32 + r32] = (att::bf16)f2bf(o[d0][r] * rli[r]); }
}
template <int ABL = 0> __device__ __forceinline__ void attn_unit_B(const Frame& F, KArgs a, int b, int h, int qb, float lam, att::bf16* Obase) {
    using namespace att;
    int tid_ = threadIdx.x; asm volatile("" : "+v"(tid_));
    const int lane_ = tid_ & 63, wave_ = __builtin_amdgcn_readfirstlane(tid_ >> 6);
    unsigned char* ws = a->ws; char* lds = (char*)F.lds + SCR_OFF; float* wsf = (float*)((char*)F.lds + AWS_OFF) + wave_ * 64;
    unsigned* stash = (unsigned*)(lds + OFF_STASH) + wave_ * 2048;
    const int r32 = lane_ & 31, hi = lane_ >> 5;
    const att::bf16* Qb = (const att::bf16*)(ws + WS_QB) + ((size_t)b * SEQ + (size_t)qb * 256) * 1024 + h * 128;
    const att::bf16* Kh = (const att::bf16*)(ws + WS_KB) + (size_t)b * SEQ * 1024 + h * 128;
    const att::bf16* Vh = (const att::bf16*)(ws + WS_VB) + (size_t)b * SEQ * 1024 + h * 128;
    f32x16 o[4]; float rli[16];
    attn_pass<64, 1024, 1024, 1024, ABL>(Qb, Kh, Vh, SEQ, lds, wsf, o, rli, (const float*)(ws + WS_ROPE), nullptr, qb * 256);
#pragma unroll
    for (int d0 = 0; d0 < 4; ++d0)
#pragma unroll
        for (int r = 0; r < 16; r += 2) stash[(d0 * 8 + (r >> 1)) * 64 + lane_] = att::cvtpk(o[d0][r] * rli[r], o[d0][r + 1] * rli[r + 1]);
    attn_pass<64, 1024, 1024, 1024, ABL>(Qb + 64, Kh + 64, Vh, SEQ, lds, wsf, o, rli, (const float*)(ws + WS_ROPE), nullptr, qb * 256);
    asm volatile("s_waitcnt lgkmcnt(0)" ::: "memory");
    float ss[16];
#pragma unroll
    for (int r = 0; r < 16; ++r) ss[r] = 0.f;
#pragma unroll
    for (int d0 = 0; d0 < 4; ++d0)
#pragma unroll
        for (int r = 0; r < 16; r += 2) { const unsigned w = stash[(d0 * 8 + (r >> 1)) * 64 + lane_];
            const float x0 = bflo(w) - lam * (o[d0][r] * rli[r]), x1 = bfhi(w) - lam * (o[d0][r + 1] * rli[r + 1]);
            o[d0][r] = x0; o[d0][r + 1] = x1; ss[r] += x0 * x0; ss[r + 1] += x1 * x1; }
#pragma unroll
    for (int r = 0; r < 16; ++r) { float s = ss[r]; s += __shfl_xor(s, 1); s += __shfl_xor(s, 2); s += __shfl_xor(s, 4); s += __shfl_xor(s, 8); s += __shfl_xor(s, 16);
        ss[r] = (1.0f - LAM_INIT) * __builtin_amdgcn_rsqf(s * (1.0f / 128.0f) + EPS); }
    const float* sg = a->in[9]; float g4[4];
#pragma unroll
    for (int d0 = 0; d0 < 4; ++d0) g4[d0] = sg[d0 * 32 + r32];
    att::bf16* Ow = Obase + ((size_t)b * SEQ + (size_t)qb * 256 + wave_ * 32) * 2048 + 1024 + h * 128;
#pragma unroll
    for (int r = 0; r < 16; ++r) { const int orow = crow(r, hi);
#pragma unroll
        for (int d0 = 0; d0 < 4; ++d0) Ow[(size_t)orow * 2048 + d0 * 32 + r32] = (att::bf16)f2bf(o[d0][r] * ss[r] * g4[d0]); }
}
__device__ __forceinline__ void p2_attention(const Frame& F, KArgs a) {
    const float lam = __uint_as_float(__builtin_amdgcn_readfirstlane(__float_as_uint(expf(wave_sum(a->in[5][F.lane] * a->in[6][F.lane])) - expf(wave_sum(a->in[7][F.lane] * a->in[8][F.lane])) + LAM_INIT)));
#if ATT_DUMMY >= 0
#if ATT_DUMMY_B
    for (int L = F.vcu; L < 1024; L += F.G) { const int i = L >> 8, v = L & 255, x = v >> 5, qb = v & 31, b = x >> 1; attn_unit_B<ATT_DUMMY>(F, a, b, 4 * (x & 1) + i, qb, lam, (att::bf16*)a->out); }
#else
    for (int L = F.vcu; L < 1024; L += F.G) { const int i = L >> 8, v = L & 255, x = v >> 5, qb = v & 31, b = x >> 1; attn_unit_A<ATT_DUMMY>(F, a, b, 4 * (x & 1) + i, qb, (att::bf16*)a->out); }
#endif
#endif
    for (int L = F.vcu; L < 2048; L += F.G) {
#if PROBE_MASK
        if (L >> 8 == 4 && blockIdx.x == PROBE_BLOCK && F.tid == 0) { volatile LAS unsigned* M_ = (volatile LAS unsigned*)((LAS unsigned char*)F.lds + MISC_OFF); M_[21] = (unsigned)__builtin_amdgcn_s_memrealtime() - M_[20]; }
#endif
        const int i = L >> 8, v = L & 255, x = v >> 5, qb = v & 31, b = x >> 1;
#ifndef ATT_SKIP_A
        if (i < 4) attn_unit_A(F, a, b, 4 * (x & 1) + i, qb, (att::bf16*)(a->ws + WS_XN));
#endif
#ifndef ATT_SKIP_B
        if (i >= 4) attn_unit_B(F, a, b, 4 * (x & 1) + (i - 4), qb, lam, (att::bf16*)(a->ws + WS_XN));
#endif
    }
}

__device__ __forceinline__ void moe_table(const Frame& F, KArgs a) {
    LAS int* tab = (LAS int*)((LAS unsigned char*)F.lds + MOE_OFF);
    if (F.wave == 0) { const gu32* cnt = (const gu32*)(a->ws + WS_CTL) + CW_CNT;
        const int c = F.lane < NEXP ? (int)__hip_atomic_load(cnt + F.lane, RLX_AGENT) : 0; const int np = (c + 255) >> 8;
        int inc = np;
#pragma unroll
        for (int o = 1; o < 32; o <<= 1) { const int v = __shfl_up(inc, o); if (F.lane >= o) inc += v; }
        if (F.lane < NEXP) { tab[F.lane] = c; tab[32 + F.lane] = inc - np; }
        if (F.lane == NEXP - 1) tab[64] = inc; }
    __syncthreads();
}

__device__ __forceinline__ void p4_router(const Frame& F, KArgs a) {
    typedef float f32x4v __attribute__((ext_vector_type(4)));
    unsigned char* ws = a->ws; const bf16* X1 = (const bf16*)(ws + WS_X1B); const float* SSQ = (const float*)(ws + WS_SSQ); float* LR = (float*)(ws + WS_LR);
    const bf16* wh = (const bf16*)(ws + WS_WRT);
    gu32* cnt = (gu32*)(ws + WS_CTL) + CW_CNT; int* LENT = (int*)(ws + WS_LENT); float* LW = (float*)(ws + WS_LW); int* TOKES = (int*)(ws + WS_TOKROW);
    LAS float* LG = (LAS float*)((LAS unsigned char*)F.lds + SCR_OFF) + F.wave * (16 * 48);
    LAS int* lcnt = (LAS int*)((LAS unsigned char*)F.lds + SCR_OFF + 32768);
    const int row = F.lane & 15, kq = F.lane >> 4;
    const int NTASK = T / 16, rounds = (NTASK + F.NGW - 1) / F.NGW;
    for (int it = 0; it < rounds; ++it) {
        const int task = it * F.NGW + F.gw; const bool valid = task < NTASK; const int t0 = valid ? task * 16 : 0;
        if (F.tid < 64) lcnt[F.tid] = 0;
        __syncthreads();
        int e0 = 0, e1 = 0, r0 = 0, r1 = 0; float w0 = 0.f, w1 = 0.f, rstd_tok = 0.f;
        {
            const GAS f32x4v* sp = (const GAS f32x4v*)(SSQ + (size_t)(t0 + row) * 32); float s = 0.f;
#pragma unroll
            for (int j = 0; j < 8; ++j) { const f32x4v q = sp[j]; s += (q.x + q.y) + (q.z + q.w); }
            const float rstd = 1.0f / sqrtf(s * (1.0f / DM) + EPS);
            rstd_tok = rstd;
            f32x4v acc[3] = {{0.f, 0.f, 0.f, 0.f}, {0.f, 0.f, 0.f, 0.f}, {0.f, 0.f, 0.f, 0.f}};
            const bf16* xrow = X1 + (size_t)(t0 + row) * DM + 8 * kq;
            v4u xw[8];
#pragma unroll
            for (int i = 0; i < 8; ++i) xw[i] = *(const GAS v4u*)(xrow + 32 * i);
            LAS unsigned char* RB = (LAS unsigned char*)F.lds + SCR_OFF + 36864;
            for (int c = 0; c < 4; ++c) {
                __syncthreads();
#pragma unroll
                for (int i = 0; i < 12; ++i) { const int idx = F.tid + 512 * i, arr = idx / 3072, rr = (idx % 3072) >> 6, seg = idx & 63;
                    *(LAS v4u*)(RB + arr * 49920 + rr * 1040 + seg * 16) = *(const GAS v4u*)(wh + (size_t)arr * 48 * 2048 + (size_t)rr * 2048 + c * 512 + seg * 8); }
                __syncthreads();
                const LAS unsigned char* rbh = RB + row * 1040 + kq * 16;
#pragma unroll 8
                for (int ksl = 0; ksl < 16; ++ksl) { const int ks = c * 16 + ksl;
                const v4u xq = xw[ksl & 7];
                { const int kn = (ks + 8 < 64) ? ks + 8 : ks; xw[ksl & 7] = *(const GAS v4u*)(xrow + 32 * kn); }
                const bf16x8 Ax = __builtin_bit_cast(bf16x8, xq);
#pragma unroll
                for (int blk = 0; blk < 3; ++blk) {
                    const bf16x8 Bh = *(const LAS bf16x8*)(rbh + blk * 16 * 1040 + ksl * 64), Bl = *(const LAS bf16x8*)(rbh + 49920 + blk * 16 * 1040 + ksl * 64);
                    acc[blk] = __builtin_amdgcn_mfma_f32_16x16x32_bf16(Ax, Bh, acc[blk], 0, 0, 0);
                    acc[blk] = __builtin_amdgcn_mfma_f32_16x16x32_bf16(Ax, Bl, acc[blk], 0, 0, 0);
                }
                }
            }
#pragma unroll
            for (int blk = 0; blk < 3; ++blk)
#pragma unroll
                for (int i = 0; i < 4; ++i) LG[(4 * kq + i) * 48 + 16 * blk + row] = acc[blk][i];
            LDS_WAIT();
            if (F.lane < 16) {
                const LAS float* lg = LG + F.lane * 48;
                float gl[4];
#pragma unroll
                for (int i = 0; i < 4; ++i) gl[i] = lg[i] * rstd;
                int gi = 0; float gm = gl[0];
#pragma unroll
                for (int i = 1; i < 4; ++i) if (gl[i] > gm) { gm = gl[i]; gi = i; }
                float gs = 0.f;
#pragma unroll
                for (int i = 0; i < 4; ++i) gs += expf(gl[i] - gm);
                const float gw_ = 1.0f / gs;
                const LAS float* el = lg + 4 + gi * 8;
                float ev[8];
#pragma unroll
                for (int i = 0; i < 8; ++i) ev[i] = el[i] * rstd;
                int i0 = 0; float v0 = ev[0];
#pragma unroll
                for (int i = 1; i < 8; ++i) if (ev[i] > v0) { v0 = ev[i]; i0 = i; }
                int i1 = -1; float v1 = -3.0e38f;
#pragma unroll
                for (int i = 0; i < 8; ++i) if (i != i0 && ev[i] > v1) { v1 = ev[i]; i1 = i; }
                const float ex = expf(v1 - v0), den = 1.0f / (1.0f + ex);
                w0 = den * gw_; w1 = ex * den * gw_; e0 = gi * 8 + i0; e1 = gi * 8 + i1;
                if (valid) { r0 = atomicAdd((int*)&lcnt[e0], 1); r1 = atomicAdd((int*)&lcnt[e1], 1); }
            }
        }
        __syncthreads();
        if (F.tid < 32) { const int c = lcnt[F.tid]; lcnt[32 + F.tid] = c ? (int)__hip_atomic_fetch_add(cnt + F.tid, (unsigned)c, RLX_AGENT) : 0; }
        __syncthreads();
        if (valid && F.lane < 16) { const int tok = t0 + F.lane;
            const int s0 = lcnt[32 + e0] + r0, s1 = lcnt[32 + e1] + r1;
            LENT[(size_t)e0 * LCAP + s0] = tok * 2; LW[(size_t)e0 * LCAP + s0] = w0; LR[(size_t)e0 * LCAP + s0] = rstd_tok; TOKES[2 * tok] = (e0 << 16) | s0;
            LENT[(size_t)e1 * LCAP + s1] = tok * 2 + 1; LW[(size_t)e1 * LCAP + s1] = w1; LR[(size_t)e1 * LCAP + s1] = rstd_tok; TOKES[2 * tok + 1] = (e1 << 16) | s1; }
        __syncthreads();
    }
}

__device__ __forceinline__ void p6_final(const Frame& F, KArgs a) {
    unsigned char* ws = a->ws; const unsigned char* YC = (const unsigned char*)(ws + WS_YC); const int* TOKES = (const int*)(ws + WS_TOKROW); const LAS int* tab = (const LAS int*)((LAS unsigned char*)F.lds + MOE_OFF);
    typedef float f32x2p __attribute__((ext_vector_type(2)));
    const GAS f32x4* g4 = (const GAS f32x4*)a->in[21] + F.lane;
    for (int t0 = F.gw; t0 < T; t0 += 2 * F.NGW) {
        const int t1 = (t0 + F.NGW < T) ? t0 + F.NGW : t0;
        const int ea0 = TOKES[2 * t0], ea1 = TOKES[2 * t0 + 1], eb0 = TOKES[2 * t1], eb1 = TOKES[2 * t1 + 1];
        GAS f32x4* xa = (GAS f32x4*)(a->out + (size_t)t0 * DM) + F.lane; GAS f32x4* xb = (GAS f32x4*)(a->out + (size_t)t1 * DM) + F.lane;
        const GAS v2u* x1a = (const GAS v2u*)((const bf16*)(ws + WS_X1B) + (size_t)t0 * DM) + F.lane; const GAS v2u* x1b = (const GAS v2u*)((const bf16*)(ws + WS_X1B) + (size_t)t1 * DM) + F.lane;
        f32x4 va[8], vb[8];
#pragma unroll
        for (int j = 0; j < 8; ++j) { const v2u wa = x1a[64 * j], wb = x1b[64 * j]; va[j] = (f32x4){bflo(wa.x), bfhi(wa.x), bflo(wa.y), bfhi(wa.y)}; vb[j] = (f32x4){bflo(wb.x), bfhi(wb.x), bflo(wb.y), bfhi(wb.y)}; }
        const GAS unsigned* ya0 = (const GAS unsigned*)(YC + (size_t)(tab[32 + (ea0 >> 16)] * 256 + (ea0 & 0xffff)) * DM) + F.lane; const GAS unsigned* ya1 = (const GAS unsigned*)(YC + (size_t)(tab[32 + (ea1 >> 16)] * 256 + (ea1 & 0xffff)) * DM) + F.lane;
        const GAS unsigned* yb0 = (const GAS unsigned*)(YC + (size_t)(tab[32 + (eb0 >> 16)] * 256 + (eb0 & 0xffff)) * DM) + F.lane; const GAS unsigned* yb1 = (const GAS unsigned*)(YC + (size_t)(tab[32 + (eb1 >> 16)] * 256 + (eb1 & 0xffff)) * DM) + F.lane;
        unsigned pa[8], qa[8], pb[8], qb[8];
#pragma unroll
        for (int j = 0; j < 8; ++j) { pa[j] = ya0[64 * j]; qa[j] = ya1[64 * j]; pb[j] = yb0[64 * j]; qb[j] = yb1[64 * j]; }
        float sa = 0.f, sb = 0.f;
#pragma unroll
        for (int j = 0; j < 8; ++j) {
            const f32x2p pal = __builtin_amdgcn_cvt_pk_f32_fp8((int)pa[j], false), pah = __builtin_amdgcn_cvt_pk_f32_fp8((int)pa[j], true), qal = __builtin_amdgcn_cvt_pk_f32_fp8((int)qa[j], false), qah = __builtin_amdgcn_cvt_pk_f32_fp8((int)qa[j], true);
            const f32x2p pbl = __builtin_amdgcn_cvt_pk_f32_fp8((int)pb[j], false), pbh = __builtin_amdgcn_cvt_pk_f32_fp8((int)pb[j], true), qbl = __builtin_amdgcn_cvt_pk_f32_fp8((int)qb[j], false), qbh = __builtin_amdgcn_cvt_pk_f32_fp8((int)qb[j], true);
            va[j].x += (pal[0] + qal[0]) * 0.0625f; va[j].y += (pal[1] + qal[1]) * 0.0625f; va[j].z += (pah[0] + qah[0]) * 0.0625f; va[j].w += (pah[1] + qah[1]) * 0.0625f;
            vb[j].x += (pbl[0] + qbl[0]) * 0.0625f; vb[j].y += (pbl[1] + qbl[1]) * 0.0625f; vb[j].z += (pbh[0] + qbh[0]) * 0.0625f; vb[j].w += (pbh[1] + qbh[1]) * 0.0625f;
            sa += (va[j].x * va[j].x + va[j].y * va[j].y) + (va[j].z * va[j].z + va[j].w * va[j].w); sb += (vb[j].x * vb[j].x + vb[j].y * vb[j].y) + (vb[j].z * vb[j].z + vb[j].w * vb[j].w); }
        const float ra = 1.0f / sqrtf(wave_sum(sa) * (1.0f / DM) + EPS), rb = 1.0f / sqrtf(wave_sum(sb) * (1.0f / DM) + EPS);
#pragma unroll
        for (int j = 0; j < 8; ++j) { const f32x4 g = g4[64 * j]; xa[64 * j] = (f32x4){va[j].x * ra * g.x, va[j].y * ra * g.y, va[j].z * ra * g.z, va[j].w * ra * g.w};
            if (t1 != t0) xb[64 * j] = (f32x4){vb[j].x * rb * g.x, vb[j].y * rb * g.y, vb[j].z * rb * g.z, vb[j].w * rb * g.w}; }
    }
}

__device__ __forceinline__ void team_barrier(unsigned* ctl, int team, unsigned nblocks) {
    asm volatile("s_waitcnt vmcnt(0)" ::: "memory");
    __syncthreads();
    if (threadIdx.x == 0) {
        unsigned* w = ctl + CW_TEAM + 64 * team;
        __builtin_amdgcn_fence(__ATOMIC_RELEASE, "agent");
        asm volatile("s_waitcnt vmcnt(0)" ::: "memory");
        (void)__hip_atomic_fetch_add(w, 1u, __ATOMIC_RELAXED, __HIP_MEMORY_SCOPE_AGENT);
        unsigned sp = 0;
        while (__hip_atomic_load(w, __ATOMIC_RELAXED, __HIP_MEMORY_SCOPE_AGENT) < nblocks) { __builtin_amdgcn_s_sleep(1); if (++sp > (1u << 22)) break; }
        __builtin_amdgcn_fence(__ATOMIC_ACQUIRE, "agent");
        asm volatile("s_waitcnt vmcnt(0)" ::: "memory");
    }
    __syncthreads();
}

__global__ void __launch_bounds__(NWAVES * 64, 2) fwd_kernel(Args args) {
    extern __shared__ __attribute__((aligned(16))) unsigned char lds[];
    Frame F;
    F.lds = lds; F.tid = threadIdx.x; F.lane = F.tid & 63; F.wave = __builtin_amdgcn_readfirstlane(F.tid >> 6);
    F.G = gridDim.x; { const int bx = blockIdx.x; F.vcu = (F.G % 8 == 0) ? (bx % 8) * (F.G / 8) + bx / 8 : bx; }
    F.gw = F.vcu * NWAVES + F.wave; F.NGW = F.G * NWAVES;
    LAS unsigned char* L = (LAS unsigned char*)lds;
    volatile LAS unsigned* MISC = (volatile LAS unsigned*)(L + MISC_OFF);
    for (int u = F.tid; u < (LDS_BYTES - MISC_OFF) / 4; u += NWAVES * 64) ((LAS unsigned*)(L + MISC_OFF))[u] = 0u;
    __syncthreads();
    int lo, hi, li; unsigned* ctl;
    { KArgs a = FRESH_ARGS(); lo = a->ph_lo; hi = a->ph_hi; li = a->li; ctl = (unsigned*)(a->ws + WS_CTL); }
    XcdBarrier bar; bar.bar = ctl + CW_BAR + li * XCD_BAR_WORDS; bar.x = 0; bar.st = nullptr;
    if (hi - lo > 1) bar = xcd_barrier_post(ctl + CW_BAR + li * XCD_BAR_WORDS, MISC + 8);
#ifndef PH_MASK
#define PH_MASK 0x3ff
#endif
#define IN(k) (((PH_MASK >> (k)) & 1) && lo <= (k) && (k) < hi)
#if PROBE_MASK
    if (blockIdx.x == PROBE_BLOCK && F.tid == 0) MISC[20] = (unsigned)__builtin_amdgcn_s_memrealtime();
#define STAMP(k) do { if (blockIdx.x == PROBE_BLOCK && F.tid == 0) { const unsigned now_ = (unsigned)__builtin_amdgcn_s_memrealtime(); MISC[10 + (k)] = now_ - MISC[20]; MISC[20] = now_; } } while (0)
#else
#define STAMP(k) do { } while (0)
#endif
#if PROBE_MASK
#define SEAM(k) do { if (IN(k) && IN((k) + 1)) { unsigned tb_ = 0; if (blockIdx.x == PROBE_BLOCK && F.tid == 0) tb_ = (unsigned)__builtin_amdgcn_s_memrealtime(); if ((k) == 3) { KArgs a_ = FRESH_ARGS(); xcd_barrier_working(bar, F, a_, MISC + 6, (volatile LAS unsigned*)(L + AWS_OFF) + F.wave * 64); } else { if ((k) == 6 || (k) == 7) { KArgs a_ = FRESH_ARGS(); __syncthreads(); conv_drain(F, a_, (volatile LAS unsigned*)(L + AWS_OFF) + F.wave * 64, (k) == 6 ? 2 * CONV_IE : N_CONV); } xcd_barrier(bar); } \
    if (blockIdx.x == PROBE_BLOCK && F.tid == 0) { const unsigned dw_ = (unsigned)__builtin_amdgcn_s_memrealtime() - tb_; MISC[22] += dw_; MISC[23 + (k)] = dw_; } STAMP(k); } } while (0)
#else
#define SEAM(k) do { if (IN(k) && IN((k) + 1)) { \
    if ((k) == 3) { KArgs a_ = FRESH_ARGS(); xcd_barrier_working(bar, F, a_, MISC + 6, (volatile LAS unsigned*)(L + AWS_OFF) + F.wave * 64); } \
    else if ((k) == 4 && (F.G % 8) == 0) { team_barrier(ctl, (int)(blockIdx.x % 8), (unsigned)(F.G / 8)); } \
    else { if ((k) == 6 || (k) == 7) { KArgs a_ = FRESH_ARGS(); __syncthreads(); conv_drain(F, a_, (volatile LAS unsigned*)(L + AWS_OFF) + F.wave * 64, (k) == 6 ? 2 * CONV_IE : N_CONV); } xcd_barrier(bar); } \
    STAMP(k); } } while (0)
#endif

    if (IN(0)) { KArgs a = FRESH_ARGS(); p0_prologue(F, a); } SEAM(0);

    if (IN(1)) {
        KArgs a = FRESH_ARGS(); unsigned char* ws = a->ws;
        pg8::Gemm g{(const pg8::bf16_t*)(ws + WS_XN), (const pg8::bf16_t*)(ws + WS_WIN), T, NCOL1, DM}; pg8::StaticOrder S; S.init(T, NCOL1, F.G, (int)blockIdx.x);
        static_assert(WS_QA == pg8::EpiP1::OQA && WS_KA == pg8::EpiP1::OKA && WS_VA == pg8::EpiP1::OVA && WS_QB == pg8::EpiP1::OQB && WS_KB == pg8::EpiP1::OKB && WS_VB == pg8::EpiP1::OVB && WS_GT == pg8::EpiP1::OGT, "EpiP1 offsets");
        pg8::EpiP1 E{ws, a->in[13]};
        pg8::gemm_phase<pg8::EpiP1, pg8::StaticOrder, true, true>(L + SCR_OFF, g, S, E);
    } SEAM(1);

    if (IN(2)) { KArgs a = FRESH_ARGS(); p1b_normrope(F, a); } SEAM(2);

    if (IN(3)) { KArgs a = FRESH_ARGS(); p2_attention(F, a); } SEAM(3);

    if (IN(4)) {
        KArgs a = FRESH_ARGS(); unsigned char* ws = a->ws;
        pg8::Gemm g{(const pg8::bf16_t*)(ws + WS_XN), (const pg8::bf16_t*)(ws + WS_WA), T, DM, DM}; pg8::StaticOrder S; S.init(T, DM, F.G, (int)blockIdx.x);
        pg8::EpiMerge E{(const pg8::bf16_t*)(ws + WS_GT), (pg8::bf16_t*)(ws + WS_KB)};
        pg8::gemm_phase<pg8::EpiMerge, pg8::StaticOrder, true, true>(L + SCR_OFF, g, S, E);
    } SEAM(4);

    if (IN(5)) {
        KArgs a = FRESH_ARGS(); unsigned char* ws = a->ws;
        pg8::Gemm g{(const pg8::bf16_t*)(ws + WS_KB), (const pg8::bf16_t*)(ws + WS_WO), T, DM, DM}; pg8::StaticOrder S; S.init(T, DM, F.G, (int)blockIdx.x);
        pg8::EpiOut E{a->in[0], (pg8::bf16_t*)(ws + WS_X1B), (float*)(ws + WS_SSQ)};
        pg8::gemm_phase<pg8::EpiOut, pg8::StaticOrder, true, true>(L + SCR_OFF, g, S, E);
    } SEAM(5);

    if (IN(6)) { KArgs a = FRESH_ARGS(); p4_router(F, a); } SEAM(6);

    if (IN(7)) {
        KArgs a = FRESH_ARGS(); unsigned char* ws = a->ws;
        moe_table(F, a);
        typedef pg8::MoeOrder<4, (long)1024 * 2048 * 2, true> Ord;
        pg8::Gemm g{(const pg8::bf16_t*)(ws + WS_X1B), (const pg8::bf16_t*)(ws + WS_W13), T, 1024, DM};
        Ord S{(const LAS int*)(L + MOE_OFF), F.G, F.vcu, (const int*)(ws + WS_LENT)};
        pg8::EpiG1 E{(pg8::bf16_t*)(ws + WS_U), (const float*)(ws + WS_LR), (const float*)(ws + WS_LW), (const LAS int*)(L + MOE_OFF)};
        pg8::gemm_phase<pg8::EpiG1, Ord, true, true>(L + SCR_OFF, g, S, E);
    } SEAM(7);

    if (IN(8)) {
        KArgs a = FRESH_ARGS(); unsigned char* ws = a->ws;
        if (!IN(7)) moe_table(F, a);
        typedef pg8::MoeOrder<8, (long)2048 * 512 * 2, false> Ord;
        pg8::Gemm g{(const pg8::bf16_t*)(ws + WS_U), (const pg8::bf16_t*)(ws + WS_W2), PMAX * 256, DM, FF};
        Ord S{(const LAS int*)(L + MOE_OFF), F.G, F.vcu, (const int*)(ws + WS_LENT)};
        pg8::EpiG2 E{(unsigned char*)(ws + WS_YC)};
        pg8::gemm_phase<pg8::EpiG2, Ord, true, true>(L + SCR_OFF, g, S, E);
    } SEAM(8);

    if (IN(9)) { KArgs a = FRESH_ARGS(); if (!IN(7)) moe_table(F, a); p6_final(F, a); }
#if PROBE_MASK
    if (blockIdx.x == PROBE_BLOCK && F.tid == 0) { unsigned tot = 0;
        for (int k = 0; k < 22; ++k) if ((PROBE_MASK >> k) & 1) tot += MISC[10 + k];
        const unsigned long long t0 = __builtin_amdgcn_s_memrealtime(), span = (unsigned long long)tot * PROBE_MUL;
        while (__builtin_amdgcn_s_memrealtime() - t0 < span) __builtin_amdgcn_s_sleep(8); }
#endif
#undef IN
#undef SEAM
}

extern "C" void kernel_launch(void* const* d_in, const int* in_sizes, int n_in, void* d_out, int out_size, void* d_ws, size_t ws_size, hipStream_t stream) {
    static int grid = 0;
    if (grid == 0) {
        if (n_in != 22 || in_sizes[0] != T * DM || out_size != T * DM || ws_size < WS_END) { fprintf(stderr, "kernel_launch: shape mismatch (n_in %d, in0 %d, out %d, ws %zu)\n", n_in, n_in > 0 ? in_sizes[0] : -1, out_size, ws_size); grid = -1; return; }
        int dev = 0, cus = 0, per_cu = 0;
        if (hipGetDevice(&dev) != hipSuccess || hipDeviceGetAttribute(&cus, hipDeviceAttributeMultiprocessorCount, dev) != hipSuccess) { grid = -1; return; }
        if (hipFuncSetAttribute((const void*)fwd_kernel, hipFuncAttributeMaxDynamicSharedMemorySize, LDS_BYTES) != hipSuccess) { fprintf(stderr, "kernel_launch: hipFuncSetAttribute failed\n"); grid = -1; return; }
        if (hipOccupancyMaxActiveBlocksPerMultiprocessor(&per_cu, (const void*)fwd_kernel, NWAVES * 64, LDS_BYTES) != hipSuccess || per_cu < 1) fprintf(stderr, "kernel_launch: occupancy query says %d\n", per_cu);
        (void)hipGetLastError();
        grid = cus;
    }
    if (grid < 0) return;
    if (hipMemsetAsync((char*)d_ws + WS_CTL, 0, CTL_ZERO_BYTES, stream) != hipSuccess) return;
    Args a{};
    for (int i = 0; i < 22; ++i) a.in[i] = (const float*)d_in[i];
    a.out = (float*)d_out; a.ws = (unsigned char*)d_ws; a.pad = 0;
#if MK_ONE_LAUNCH
    a.ph_lo = 0; a.ph_hi = N_PHASES; a.li = 0;
    hipLaunchKernelGGL(fwd_kernel, dim3(grid), dim3(NWAVES * 64), LDS_BYTES, stream, a);
#else
    for (int li = 0; li < N_PHASES; ++li) { a.ph_lo = li; a.ph_hi = li + 1; a.li = li;
        hipLaunchKernelGGL(fwd_kernel, dim3(grid), dim3(NWAVES * 64), LDS_BYTES, stream, a); }
#endif
    const hipError_t le = hipPeekAtLastError();
    if (le != hipSuccess) fprintf(stderr, "kernel_launch: launch failed: %s\n", hipGetErrorName(le));
}
```
